# Optimizing an MI355X kernel written in HIP

```python
import jax, jax.numpy as jnp
from jax import lax
import numpy as np

D_MODEL = 2048
BATCH = 2
SEQ = 8192
DEPTH = 2

D_MIX = D_MODEL
D_SGU = D_MIX // 2
D_NA = D_MIX - D_SGU
SGU_CHUNK = 128
SGU_GROUP = 128
SGU_GROUPS = D_SGU // SGU_GROUP
NA_HEAD_DIM = 64
NA_HEADS = D_NA // NA_HEAD_DIM
GRID_W = 64
NA_KH_MAX = 8
NA_KW = 16
NA_QC = 16
NA_KC = NA_QC + NA_KW
IN_SPLITS = (D_SGU, 2 * D_SGU, 3 * D_SGU, 3 * D_SGU + D_NA, 3 * D_SGU + 2 * D_NA, 3 * D_SGU + 3 * D_NA)
D_IN = 3 * D_SGU + 4 * D_NA
DEEPNORM_ALPHA = (2 * DEPTH) ** 0.25
DEEPNORM_BETA = (8 * DEPTH) ** -0.25
ADA_SCALE = 0.1
LN_EPS = 1e-5

kernel_name = "hybrid_sgu_natten_deepnorm_adaln"


def _layernorm(x, g=None, b=None):
    xf = x.astype(jnp.float32)
    mu = jnp.mean(xf, axis=-1, keepdims=True)
    var = jnp.mean(jnp.square(xf - mu), axis=-1, keepdims=True)
    y = (xf - mu) * lax.rsqrt(var + LN_EPS)
    if g is not None:
        y = y * g.astype(jnp.float32) + b.astype(jnp.float32)
    return y.astype(x.dtype)


def _spatial_gating(u, v, z, norm_g, norm_b, w_s, b_s):
    B, T, _ = u.shape
    n_chunks = T // SGU_CHUNK
    vg = v.reshape(B, T, SGU_GROUPS, SGU_GROUP)
    vg = _layernorm(vg, norm_g.reshape(SGU_GROUPS, SGU_GROUP), norm_b.reshape(SGU_GROUPS, SGU_GROUP))
    vc = vg.reshape(B, n_chunks, SGU_CHUNK, SGU_GROUPS, SGU_GROUP)
    sv = jnp.einsum('gpq,bnqgc->bnpgc', w_s, vc) + b_s.T[None, None, :, :, None]
    return u * sv.reshape(B, T, D_SGU) * jax.nn.silu(z)


def _na_tables(rows):
    kh = min(NA_KH_MAX, rows)
    r = np.arange(rows)
    row_start = np.clip(r - kh // 2, 0, rows - kh)
    row_bias_idx = row_start[:, None] + np.arange(kh)[None, :] - r[:, None] + NA_KH_MAX - 1
    ncb = GRID_W // NA_QC
    qc0 = np.arange(ncb) * NA_QC
    band_start = np.clip(qc0 - NA_KW // 2, 0, GRID_W - NA_KC)
    band_cols = band_start[:, None] + np.arange(NA_KC)[None, :]
    q_cols = qc0[:, None] + np.arange(NA_QC)[None, :]
    win_start = np.clip(q_cols - NA_KW // 2, 0, GRID_W - NA_KW)
    col_valid = ((band_cols[:, None, :] >= win_start[:, :, None])
                 & (band_cols[:, None, :] < win_start[:, :, None] + NA_KW))
    col_bias_idx = np.clip(band_cols[:, None, :] - q_cols[:, :, None] + NA_KW - 1, 0, 2 * NA_KW - 2)
    return (kh, row_start.astype(np.int32), row_bias_idx.astype(np.int32),
            band_cols.astype(np.int32), col_valid, col_bias_idx.astype(np.int32))


def _neighbourhood_attention(q, k, v, rpb):
    B, T, H, dh = q.shape
    rows = T // GRID_W
    kh, row_start, row_bias_idx, band_cols, col_valid, col_bias_idx = _na_tables(rows)
    ncb = GRID_W // NA_QC
    to_grid = lambda a: a.reshape(B, rows, GRID_W, H, dh).transpose(0, 3, 1, 2, 4)
    kg, vg = to_grid(k), to_grid(v)
    q_rows = to_grid(q).reshape(B, H, rows, ncb, NA_QC, dh).transpose(2, 0, 1, 3, 4, 5)
    valid = jnp.asarray(col_valid)[None, None, :, :, None, :]
    col_bias_idx = jnp.asarray(col_bias_idx)[:, :, None, :]
    band_cols = jnp.asarray(band_cols)
    scale = dh ** -0.5

    def one_row(args):
        q_r, rs, rbi = args
        k_r = lax.dynamic_slice_in_dim(kg, rs, kh, axis=2)
        v_r = lax.dynamic_slice_in_dim(vg, rs, kh, axis=2)
        k_b = jnp.take(k_r, band_cols, axis=3)
        v_b = jnp.take(v_r, band_cols, axis=3)
        s = jnp.einsum('bhcqd,bhicxd->bhcqix', q_r, k_b).astype(jnp.float32) * scale
        bias = rpb[:, rbi[None, None, :, None], col_bias_idx]
        s = jnp.where(valid, s + bias[None].astype(jnp.float32), -1e30)
        p = jax.nn.softmax(s.reshape(B, H, ncb, NA_QC, kh * NA_KC), axis=-1)
        p = p.reshape(s.shape).astype(v.dtype)
        return jnp.einsum('bhcqix,bhicxd->bhcqd', p, v_b)

    out = lax.map(one_row, (q_rows, jnp.asarray(row_start), jnp.asarray(row_bias_idx)))
    out = out.reshape(rows, B, H, GRID_W, dh).transpose(1, 0, 3, 2, 4)
    return out.reshape(B, T, H * dh)


def setup_inputs(seed: int = 0) -> dict:
    key = jax.random.key(seed)
    ks = jax.random.split(key, 14)
    f32 = jnp.float32
    n = lambda k, s: jax.random.normal(k, s, f32)
    return {
        "x": n(ks[0], (BATCH, SEQ, D_MODEL)),
        "c": n(ks[1], (BATCH, D_MODEL)),
        "w_ada": n(ks[2], (DEPTH, D_MODEL, 3 * D_MODEL)) * (D_MODEL ** -0.5) * ADA_SCALE,
        "b_ada": n(ks[3], (DEPTH, 3 * D_MODEL)) * 0.01,
        "w_in": n(ks[4], (DEPTH, D_MODEL, D_IN)) * (D_MODEL ** -0.5),
        "sgu_norm_g": 1.0 + 0.02 * n(ks[5], (DEPTH, D_SGU)),
        "sgu_norm_b": 0.02 * n(ks[6], (DEPTH, D_SGU)),
        "w_spatial": n(ks[7], (DEPTH, SGU_GROUPS, SGU_CHUNK, SGU_CHUNK)) * (SGU_CHUNK ** -0.5),
        "b_spatial": 1.0 + 0.02 * n(ks[8], (DEPTH, SGU_GROUPS, SGU_CHUNK)),
        "rpb": 0.1 * n(ks[9], (DEPTH, NA_HEADS, 2 * NA_KH_MAX - 1, 2 * NA_KW - 1)),
        "w_out": n(ks[10], (DEPTH, D_MIX, D_MODEL)) * (D_MIX ** -0.5) * DEEPNORM_BETA,
        "ln_g": 1.0 + 0.02 * n(ks[11], (DEPTH, D_MODEL)),
        "ln_b": 0.02 * n(ks[12], (DEPTH, D_MODEL)),
    }


def reference(x, c, w_ada, b_ada, w_in, sgu_norm_g, sgu_norm_b, w_spatial, b_spatial, rpb, w_out, ln_g, ln_b):
    B, T, _ = x.shape
    for l in range(DEPTH):
        mod = jax.nn.silu(c) @ w_ada[l] + b_ada[l]
        shift, scale, gate = jnp.split(mod[:, None, :], 3, axis=-1)
        h = _layernorm(x) * (1.0 + scale) + shift
        proj = h @ w_in[l]
        u, v, z_a, q, k, v_b, z_b = jnp.split(proj, IN_SPLITS, axis=-1)
        y_a = _spatial_gating(jax.nn.gelu(u, approximate=False), jax.nn.gelu(v, approximate=False), z_a,
                              sgu_norm_g[l], sgu_norm_b[l], w_spatial[l], b_spatial[l])
        hs = (B, T, NA_HEADS, NA_HEAD_DIM)
        y_b = _neighbourhood_attention(q.reshape(hs), k.reshape(hs), v_b.reshape(hs), rpb[l]) * jax.nn.silu(z_b)
        y = jnp.concatenate([y_a, y_b], axis=-1) @ w_out[l]
        x = _layernorm(DEEPNORM_ALPHA * x + (1.0 + gate) * y, ln_g[l], ln_b[l])
    return x
```

```cpp
#include <hip/hip_runtime.h>
#include <cstdio>
#include <cstdint>

#ifndef MK_N_LAUNCHES
#define MK_N_LAUNCHES 1
#endif

#define LAS __attribute__((address_space(3)))
#define GAS __attribute__((address_space(1)))
typedef unsigned short bf16_t;
typedef short bf16x8 __attribute__((ext_vector_type(8)));
typedef float f32x4 __attribute__((ext_vector_type(4)));
typedef float f32x2 __attribute__((ext_vector_type(2)));
typedef unsigned u32x4 __attribute__((ext_vector_type(4)));
typedef unsigned u32x2 __attribute__((ext_vector_type(2)));

constexpr int BATCH = 2, T = 8192, D = 2048, M = BATCH * T, DIN = 7168, DS = 1024, NG = 8, NH = 16, DEPTH = 2;
constexpr int NMOD = 3 * D;
constexpr float LN_EPS = 1e-5f;
constexpr float DN_ALPHA = 1.4142135623730951f;

typedef __bf16 bf16v2 __attribute__((ext_vector_type(2)));
__device__ __forceinline__ unsigned cvt_pk_bf16(float lo, float hi) { const f32x2 v = {lo, hi}; const bf16v2 r = __builtin_convertvector(v, bf16v2); return __builtin_bit_cast(unsigned, r); }
__device__ __forceinline__ float bf_lo(unsigned w) { return __builtin_bit_cast(float, w << 16); }
__device__ __forceinline__ float bf_hi(unsigned w) { return __builtin_bit_cast(float, w & 0xffff0000u); }
__device__ __forceinline__ float silu_f(float x) { return x * __builtin_amdgcn_rcpf(1.0f + __builtin_amdgcn_exp2f(-1.4426950408889634f * x)); }
__device__ __forceinline__ f32x2 gelu_pk(f32x2 v) {
    f32x2 c; c.x = __builtin_amdgcn_fmed3f(v.x, -4.0f, 4.0f); c.y = __builtin_amdgcn_fmed3f(v.y, -4.0f, 4.0f);
    const f32x2 s = c * c;
    f32x2 r = s * 7.0374646370e-11f + (-6.2872893160e-09f);
    r = r * s + 2.5093203053e-07f; r = r * s + (-5.9760889818e-06f); r = r * s + 9.6085055597e-05f; r = r * s + (-1.1195942566e-03f);
    r = r * s + 9.8383713455e-03f; r = r * s + (-6.6361911043e-02f); r = r * s + 3.9890514886e-01f;
    return v * (c * r + 0.5f);
}
__device__ __forceinline__ f32x4 gelu4(f32x4 v) { f32x2 a = gelu_pk((f32x2){v[0], v[1]}), b = gelu_pk((f32x2){v[2], v[3]}); return (f32x4){a.x, a.y, b.x, b.y}; }
__device__ __forceinline__ f32x2 silu_pk(f32x2 v) { const f32x2 a = v * (-1.4426950408889634f); f32x2 e; e.x = __builtin_amdgcn_exp2f(a.x); e.y = __builtin_amdgcn_exp2f(a.y);
    const f32x2 d = e + 1.0f; f32x2 r; r.x = __builtin_amdgcn_rcpf(d.x); r.y = __builtin_amdgcn_rcpf(d.y); return v * r; }
__device__ __forceinline__ f32x4 silu4(f32x4 v) { const f32x2 a = silu_pk((f32x2){v[0], v[1]}), b = silu_pk((f32x2){v[2], v[3]}); return (f32x4){a.x, a.y, b.x, b.y}; }
#ifndef MK_REP
#define MK_REP 0
#endif
__device__ __forceinline__ void store8(bf16_t* p, f32x4 a, f32x4 b) { u32x4 w; w.x = cvt_pk_bf16(a[0], a[1]); w.y = cvt_pk_bf16(a[2], a[3]); w.z = cvt_pk_bf16(b[0], b[1]); w.w = cvt_pk_bf16(b[2], b[3]); *(u32x4*)p = w;
    if (MK_REP & 128) { asm volatile("" ::: "memory"); *(u32x4*)p = w; asm volatile("" ::: "memory"); } }

namespace pg8 {
constexpr int BM = 256, BK = 64, HALF = 128, HTB = HALF * BK * 2, STAGE_BYTES = 8 * HTB, NXCD = 8, WGM = 2;
__host__ __device__ __forceinline__ int lds_byte(int r, int c) { const int st = (r >> 4) * 2 + (c >> 5), rr = r & 15, cc = c & 31, ob = rr * 64 + cc * 2; return st * 1024 + (ob ^ (((ob >> 9) & 1) << 5)); }
__host__ __device__ __forceinline__ void stage_rc(int b, int& R, int& C) { const int st = b / 1024, sb = b % 1024, swz = sb ^ (((sb >> 9) & 1) << 5); R = (st >> 1) * 16 + swz / 64; C = (st & 1) * 32 + (swz % 64) / 2; }
__host__ __device__ __forceinline__ int perm32(int rho) { const int n = rho >> 4, i = rho & 15; return 8 * (i >> 2) + 4 * n + (i & 3); }

struct Unit { int pm, pn, kind; };
struct Gemm { const bf16_t* A0; const bf16_t* B0; const bf16_t* A1; const bf16_t* B1; int K; };

struct StaticOrder {
    int nM, nN, nwg, G, c;
    __device__ void init(int M_, int N_, int G_, int c_) { nM = M_ / BM; nN = N_ / BM; nwg = nM * nN; G = G_; c = c_; }
    __device__ __forceinline__ void map(int wgid, Unit& u) const {
        { const int q = nwg / NXCD, r = nwg % NXCD, xcd = wgid % NXCD, off = wgid / NXCD; wgid = (xcd < r ? xcd * (q + 1) : r * (q + 1) + (xcd - r) * q) + off; }
        const int nig = WGM * nN, gid = wgid / nig, fm = gid * WGM, gsz = (nM - fm) < WGM ? (nM - fm) : WGM;
        u.pm = fm + ((wgid % nig) % gsz); u.pn = (wgid % nig) / gsz; u.kind = 0;
    }
    __device__ __forceinline__ bool next(int i, Unit& u) const { const long L = (long)i * G + c; if (L >= nwg) return false; map((int)L, u); return true; }
};
struct ProjOrder {
    StaticOrder S; int nswap;
    __device__ void init(int G_, int c_) { S.init(M, 5120, G_, c_); nswap = 512; }
    __device__ __forceinline__ bool next(int i, Unit& u) const {
        const long L = (long)i * S.G + S.c;
        if (L < S.nwg) { S.map((int)L, u); return true; }
        const int idx = (int)(L - S.nwg); if (idx >= nswap) return false;
        const int x = idx % 8, t = idx / 8, rnd = t >> 5, j = t & 31;
        u.pm = (j + 4 * rnd) & 7; u.pn = 8 * x + 4 * rnd + (j >> 3); u.kind = 1; return true;
    }
};

struct EpiProj {
    static constexpr bool PERM = true;
    bf16_t *GA, *VGT, *Qb, *VT;
    __device__ __forceinline__ void operator()(const f32x4 (&acc)[2][2][4][2], const Unit& u, int wr, int wc, int fr, int fq) const {
        const int rl = wr * 64 + fr, cl = wc * 32 + 8 * fq;
        if (u.kind == 1) {
            const int tok0 = u.pn * 256 + cl;
            if (u.pm < 4) {
#pragma unroll
                for (int ai = 0; ai < 2; ++ai)
#pragma unroll
                    for (int m = 0; m < 4; ++m) { const int ch = u.pm * 256 + rl + ai * HALF + m * 16;
#pragma unroll
                        for (int bj = 0; bj < 2; ++bj) { const int tk = tok0 + bj * HALF;
                            store8(VGT + ((size_t)(tk >> 7) * DS + ch) * 128 + (tk & 127), gelu4(acc[ai][bj][m][0]), gelu4(acc[ai][bj][m][1])); } }
            } else {
                const int bb = tok0 >> 13;
#pragma unroll
                for (int ai = 0; ai < 2; ++ai)
#pragma unroll
                    for (int m = 0; m < 4; ++m) { const int ch = (u.pm - 4) * 256 + rl + ai * HALF + m * 16;
                        bf16_t* rowp = VT + ((size_t)(bb * NH + (ch >> 6)) * (T / 8) * 64 + (ch & 63)) * 8;
#pragma unroll
                        for (int bj = 0; bj < 2; ++bj) store8(rowp + (size_t)(((tok0 + bj * HALF) & (T - 1)) >> 3) * 512, acc[ai][bj][m][0], acc[ai][bj][m][1]); }
            }
        } else if (u.pn < 8) {
            bf16_t* base = GA + (size_t)(u.pm * 256 + rl) * DS + u.pn * 128 + cl;
#pragma unroll
            for (int ai = 0; ai < 2; ++ai)
#pragma unroll
                for (int m = 0; m < 4; ++m) {
                    const f32x4 r0 = gelu4(acc[ai][0][m][0]) * silu4(acc[ai][1][m][0]), r1 = gelu4(acc[ai][0][m][1]) * silu4(acc[ai][1][m][1]);
                    store8(base + (size_t)(ai * HALF + m * 16) * DS, r0, r1); }
        } else {
            const int t = (u.pn - 8) >> 2, colt = ((u.pn - 8) & 3) * 256;
            bf16_t* out = Qb + (size_t)t * ((size_t)M * DS);
            const int row0 = u.pm * 256 + rl;
            const int bb = row0 >> 13, t0 = row0 & (T - 1);
#define EPI_QKZ(XFORM) _Pragma("unroll") for (int bj = 0; bj < 2; ++bj) { const int col = colt + bj * HALF + cl; \
                bf16_t* base = out + ((size_t)(bb * NH + (col >> 6)) * T + t0) * 64 + (col & 63); \
                _Pragma("unroll") for (int ai = 0; ai < 2; ++ai) _Pragma("unroll") for (int m = 0; m < 4; ++m) { f32x4 v0 = acc[ai][bj][m][0], v1 = acc[ai][bj][m][1]; XFORM; \
                        store8(base + (size_t)(ai * HALF + m * 16) * 64, v0, v1); } }
            if (t == 0) { EPI_QKZ(v0 = v0 * 0.18033688011112042f; v1 = v1 * 0.18033688011112042f) }
            else if (t == 2) { EPI_QKZ(v0 = silu4(v0); v1 = silu4(v1)) }
            else { EPI_QKZ((void)0) }
#undef EPI_QKZ
        }
    }
};
struct EpiOut {
    static constexpr bool PERM = true;
    const LAS float* gate1; bf16_t* Y;
    __device__ __forceinline__ void operator()(const f32x4 (&acc)[2][2][4][2], const Unit& u, int wr, int wc, int fr, int fq) const {
        const int row0 = u.pm * BM + wr * 64 + fr, col0 = u.pn * BM + wc * 32 + 8 * fq;
        const LAS float* gp = gate1 + (u.pm >= (T / BM) ? D : 0) + col0;
        f32x4 g4[2][2];
#pragma unroll
        for (int bj = 0; bj < 2; ++bj)
#pragma unroll
            for (int n = 0; n < 2; ++n) g4[bj][n] = *(const LAS f32x4*)(gp + bj * HALF + n * 4);
#pragma unroll
        for (int ai = 0; ai < 2; ++ai)
#pragma unroll
            for (int m = 0; m < 4; ++m) { bf16_t* rowp = Y + (size_t)(row0 + ai * HALF + m * 16) * D + col0;
#pragma unroll
                for (int bj = 0; bj < 2; ++bj) store8(rowp + bj * HALF, g4[bj][0] * acc[ai][bj][m][0], g4[bj][1] * acc[ai][bj][m][1]); }
    }
};

template <class Epi, class Sched>
__device__ __forceinline__ void gemm_phase(LAS unsigned char* lds, const int tid, const Gemm g, const Sched& S, const Epi& E) {
    const int wid = __builtin_amdgcn_readfirstlane(tid >> 6), lane = tid & 63, wr = wid >> 2, wc = wid & 3, fr = lane & 15, fq = lane >> 4;
    const int K = g.K, nt = K / BK;
    unsigned voffA[2], voffB[2];
#pragma unroll
    for (int i = 0; i < 2; ++i) { int R, C; stage_rc(tid * 16 + i * 8192, R, C); const int Rb = Epi::PERM ? ((R & ~31) + perm32(R & 31)) : R;
        voffA[i] = (unsigned)(R * K + C) * 2u; voffB[i] = (unsigned)(Rb * K + C) * 2u; }
    const size_t kstep = (size_t)(BK * 2);
    const size_t hstep = (size_t)HALF * K * 2;
    const size_t tstep = 2 * hstep;
    const unsigned ldsw = (unsigned)wid * 1024u;
    const int aoff = lds_byte(wr * 64 + fr, fq * 8), boff = lds_byte(wc * 32 + fr, fq * 8);
#define PG8_SA(b, h) (((b) * 2 + (h)) * HTB)
#define PG8_SB(b, h) ((4 + (b) * 2 + (h)) * HTB)
#define PG8_STAGE(bufoff, gbase, voff) do { _Pragma("unroll") for (int _i = 0; _i < 2; ++_i) \
        __builtin_amdgcn_global_load_lds((const unsigned*)((const char*)(gbase) + (voff)[_i]), (LAS unsigned*)(lds + (bufoff) + ldsw + _i * 8192), 16, 0, 0); } while (0)
#define PG8_LDA(dst, b, h) do { _Pragma("unroll") for (int m = 0; m < 4; ++m) _Pragma("unroll") for (int k = 0; k < 2; ++k) dst[m][k] = *(const LAS bf16x8*)(lds + PG8_SA(b, h) + aoff + m * 2048 + k * 1024); } while (0)
#define PG8_LDB(dst, b, h) do { _Pragma("unroll") for (int n = 0; n < 2; ++n) _Pragma("unroll") for (int k = 0; k < 2; ++k) dst[n][k] = *(const LAS bf16x8*)(lds + PG8_SB(b, h) + boff + n * 2048 + k * 1024); } while (0)
#define PG8_MMA(ai, bj, At, Bt) do { __builtin_amdgcn_sched_barrier(0); _Pragma("unroll") for (int m = 0; m < 4; ++m) _Pragma("unroll") for (int n = 0; n < 2; ++n) _Pragma("unroll") for (int k = 0; k < 2; ++k) \
        acc[ai][bj][m][n] = __builtin_amdgcn_mfma_f32_16x16x32_bf16(Bt[n][k], At[m][k], acc[ai][bj][m][n], 0, 0, 0); __builtin_amdgcn_sched_barrier(0); } while (0)
#define PG8_WAIT_V(n) asm volatile("s_waitcnt vmcnt(" #n ")" ::: "memory")
#define PG8_WAIT_L(n) asm volatile("s_waitcnt lgkmcnt(" #n ")" ::: "memory")
#define PG8_BAR __builtin_amdgcn_s_barrier()
#define PG8_SCHED __builtin_amdgcn_sched_barrier(0)
#define PG8_UA(u) ((const char*)((u).kind ? g.A1 : g.A0) + (size_t)(u).pm * tstep)
#define PG8_UB(u) ((const char*)((u).kind ? g.B1 : g.B0) + (size_t)(u).pn * tstep)
    Unit cur, nxt; int ui = 0;
    if (!S.next(0, cur)) return;
    f32x4 acc[2][2][4][2];
#pragma unroll
    for (int a = 0; a < 2; ++a)
#pragma unroll
        for (int b = 0; b < 2; ++b)
#pragma unroll
            for (int m = 0; m < 4; ++m)
#pragma unroll
                for (int n = 0; n < 2; ++n) acc[a][b][m][n] = (f32x4){0.f, 0.f, 0.f, 0.f};
    bf16x8 At[4][2], B0[2][2], B1[2][2];
    const char* cA = PG8_UA(cur); const char* cB = PG8_UB(cur);
    PG8_STAGE(PG8_SB(0, 0), cB, voffB); PG8_STAGE(PG8_SB(0, 1), cB + hstep, voffB); PG8_STAGE(PG8_SA(0, 0), cA, voffA); PG8_STAGE(PG8_SA(0, 1), cA + hstep, voffA);
    if (wr == 1) PG8_BAR;
    PG8_WAIT_V(2); PG8_BAR;
    PG8_STAGE(PG8_SB(1, 0), cB + kstep, voffB); PG8_STAGE(PG8_SA(1, 0), cA + kstep, voffA); PG8_STAGE(PG8_SB(1, 1), cB + hstep + kstep, voffB);
    PG8_WAIT_V(6); PG8_BAR;
    for (;;) {
        const bool has_next = S.next(ui + 1, nxt);
        const char* nA = has_next ? PG8_UA(nxt) : cA; const char* nB = has_next ? PG8_UB(nxt) : cB;
        for (int t = 0; t < nt; t += 2) {
            const bool last = (t == nt - 2);
            const char* a1 = cA + (size_t)(t + 1) * kstep;
            const char* a2 = last ? nA : cA + (size_t)(t + 2) * kstep; const char* b2 = last ? nB : cB + (size_t)(t + 2) * kstep;
            const char* a3 = a2 + kstep; const char* b3 = b2 + kstep;
            PG8_LDB(B0, 0, 0); PG8_LDB(B1, 0, 1); PG8_SCHED; PG8_LDA(At, 0, 0); PG8_STAGE(PG8_SA(1, 1), a1 + hstep, voffA);
            PG8_WAIT_V(8); PG8_WAIT_L(0); PG8_BAR; PG8_MMA(0, 0, At, B0); PG8_MMA(0, 1, At, B1); PG8_BAR; PG8_SCHED;
            PG8_LDA(At, 0, 1); PG8_STAGE(PG8_SB(0, 0), b2, voffB); PG8_STAGE(PG8_SB(0, 1), b2 + hstep, voffB); PG8_STAGE(PG8_SA(0, 0), a2, voffA);
            PG8_WAIT_V(8); PG8_WAIT_L(0); PG8_BAR; PG8_MMA(1, 0, At, B0); PG8_MMA(1, 1, At, B1); PG8_BAR; PG8_SCHED;
            PG8_LDB(B0, 1, 0); PG8_LDB(B1, 1, 1); PG8_SCHED; PG8_LDA(At, 1, 0); PG8_STAGE(PG8_SA(0, 1), a2 + hstep, voffA);
            PG8_WAIT_V(8); PG8_WAIT_L(0); PG8_BAR; PG8_MMA(0, 0, At, B0); PG8_MMA(0, 1, At, B1); PG8_BAR; PG8_SCHED;
            PG8_LDA(At, 1, 1); PG8_STAGE(PG8_SB(1, 0), b3, voffB); PG8_STAGE(PG8_SB(1, 1), b3 + hstep, voffB); PG8_STAGE(PG8_SA(1, 0), a3, voffA);
            PG8_WAIT_V(8); PG8_WAIT_L(0); PG8_BAR; PG8_MMA(1, 0, At, B0); PG8_MMA(1, 1, At, B1); PG8_BAR; PG8_SCHED;
        }
        if (wr == 0) PG8_BAR;
        E(acc, cur, wr, wc, fr, fq);
        if (!has_next) break;
#pragma unroll
        for (int a = 0; a < 2; ++a)
#pragma unroll
            for (int b = 0; b < 2; ++b)
#pragma unroll
                for (int m = 0; m < 4; ++m)
#pragma unroll
                    for (int n = 0; n < 2; ++n) acc[a][b][m][n] = (f32x4){0.f, 0.f, 0.f, 0.f};
        cur = nxt; cA = nA; cB = nB; ++ui;
        if (wr == 1) PG8_BAR;
    }
    PG8_WAIT_V(0);
    PG8_BAR;
#undef PG8_SA
#undef PG8_SB
#undef PG8_STAGE
#undef PG8_LDA
#undef PG8_LDB
#undef PG8_MMA
#undef PG8_WAIT_V
#undef PG8_WAIT_L
#undef PG8_BAR
#undef PG8_SCHED
#undef PG8_UA
#undef PG8_UB
}
}

constexpr size_t MiB = 1u << 20;
constexpr size_t WS_CTL = 0, CTL_ZERO_BYTES = 64 * 1024;
constexpr size_t WS_MOD = 1 * MiB;
constexpr size_t WS_WSB = 1 * MiB + 512 * 1024;
constexpr size_t WS_WIN = 2 * MiB;
constexpr size_t WS_WOUT = 58 * MiB;
constexpr size_t WS_H = 80 * MiB;
constexpr size_t WS_GA = 144 * MiB, WS_VG = 176 * MiB, WS_Q = 208 * MiB, WS_K = 240 * MiB, WS_ZB = 272 * MiB, WS_VT = 304 * MiB;
constexpr size_t WS_Y = 144 * MiB;
constexpr size_t WS_Y0 = 336 * MiB;
constexpr size_t WS_END = 400 * MiB;
static_assert(WS_K - WS_Q == (size_t)M * DS * 2 && WS_ZB - WS_K == (size_t)M * DS * 2, "EpiProj indexes Q|K|ZB as one array");
static_assert((4096 + 3 * 3456) * 4 <= 64 * 1024, "control words inside the memset region");
constexpr int CW_BAR = 4096, CW_HANDOFF = 64;

constexpr int RING_BYTES = 131072, LDS_BYTES = 163840, LDSCTL_OFF = LDS_BYTES - 1024, MISC_OFF = LDSCTL_OFF + 320;

typedef GAS unsigned gu32;
#define RLX_AGENT __ATOMIC_RELAXED, __HIP_MEMORY_SCOPE_AGENT
#define LDS_WAIT() asm volatile("s_waitcnt lgkmcnt(0)" ::: "memory")

#define XB_TMO      128
#define XB_XCNT(j)  (256  + 64 * (j))
#define XB_XSUB(j)  (1280 + 64 * (j))
#define XB_XGEN(j)  (2304 + 64 * (j))
#define XB_TOP      3328
#define XB_TOPGEN   3392
#define XCD_BAR_WORDS 3456
#define XB_SPIN_CAP (1u << 18)
__device__ __forceinline__ unsigned xb_ld(unsigned* p)              { return __hip_atomic_load(p, __ATOMIC_RELAXED, __HIP_MEMORY_SCOPE_AGENT); }
__device__ __forceinline__ unsigned xb_add(unsigned* p, unsigned v) { return __hip_atomic_fetch_add(p, v, __ATOMIC_RELAXED, __HIP_MEMORY_SCOPE_AGENT); }
__device__ __forceinline__ unsigned xb_xcc_id() { return (unsigned)__builtin_amdgcn_s_getreg((3 << 11) | 20) & 0xFu; }
#define XB_SPIN(cond, bar) do { unsigned _sp = 0; while (cond) { __builtin_amdgcn_s_sleep(1); \
    if ((++_sp & 255u) == 0u) { if (xb_ld(&(bar)[XB_TMO])) break; if (_sp > XB_SPIN_CAP) { atomicAdd(&(bar)[XB_TMO], 1u); break; } } } } while (0)
struct XcdBarrier { unsigned* bar; unsigned x; volatile LAS unsigned* st; unsigned expect; };
__device__ __forceinline__ XcdBarrier xcd_barrier_post(unsigned* bar, volatile LAS unsigned* st, unsigned expect) {
    XcdBarrier b; b.bar = bar; b.x = xb_xcc_id(); b.st = st; b.expect = expect;
    if (threadIdx.x == 0) (void)xb_add(&bar[XB_XCNT(b.x)], 1u);
    return b;
}
__device__ __forceinline__ void xcd_barrier_complete(unsigned* bar, unsigned x, unsigned G, unsigned& nloc, unsigned& nx) {
    unsigned sum, cnt, mine, sp = 0u;
    for (;;) {
        sum = 0u; cnt = 0u; mine = 0u;
#pragma unroll
        for (unsigned j = 0; j < 16; ++j) { const unsigned c = xb_ld(&bar[XB_XCNT(j)]); sum += c; cnt += (c > 0u) ? 1u : 0u; mine = (j == x) ? c : mine; }
        if (sum == G) break;
        __builtin_amdgcn_s_sleep(1);
        if ((++sp & 255u) == 0u) { if (xb_ld(&bar[XB_TMO])) break; if (sp > XB_SPIN_CAP) { atomicAdd(&bar[XB_TMO], 1u); break; } }
    }
    nloc = mine > 0u ? mine : 1u; nx = cnt > 0u ? cnt : 1u;
}
__device__ __forceinline__ void xcd_barrier(const XcdBarrier& b) {
    asm volatile("s_waitcnt vmcnt(0)" ::: "memory");
    __syncthreads();
    if (threadIdx.x == 0) {
        unsigned* bar = b.bar;
        __builtin_amdgcn_s_waitcnt(0);
        unsigned nloc = b.st[0], nx = b.st[1];
        if (nloc == 0u) { xcd_barrier_complete(bar, b.x, b.expect, nloc, nx); b.st[0] = nloc; b.st[1] = nx; }
        const unsigned old = xb_add(&bar[XB_XSUB(b.x)], 1u);
        const unsigned gen = old / nloc;
        if (old + 1u == (gen + 1u) * nloc) {
            __builtin_amdgcn_fence(__ATOMIC_RELEASE, "agent");
            asm volatile("s_waitcnt vmcnt(0)" ::: "memory");
            const unsigned og = xb_add(&bar[XB_TOP], 1u);
            const unsigned tg = og / nx;
            if (og + 1u == (tg + 1u) * nx) xb_add(&bar[XB_TOPGEN], 1u);
            else XB_SPIN(xb_ld(&bar[XB_TOPGEN]) == tg, bar);
            __builtin_amdgcn_fence(__ATOMIC_ACQUIRE, "agent");
            xb_add(&bar[XB_XGEN(b.x)], 1u);
            asm volatile("s_waitcnt vmcnt(0)" ::: "memory");
        } else {
            XB_SPIN(xb_ld(&bar[XB_XGEN(b.x)]) == gen, bar);
            __builtin_amdgcn_fence(__ATOMIC_ACQUIRE, "agent");
            asm volatile("s_waitcnt vmcnt(0)" ::: "memory");
        }
    }
    __syncthreads();
}

struct Frame {
    LAS unsigned char* lds;
    int tid, lane, wave, vcu, G;
};

#define DPP_ADD(v, ctrl) ((v) + __builtin_bit_cast(float, __builtin_amdgcn_update_dpp(0, __builtin_bit_cast(int, (v)), (ctrl), 0xf, 0xf, true)))
__device__ __forceinline__ float wave_sum(float v) {
    v = DPP_ADD(v, 0xB1);
    v = DPP_ADD(v, 0x4E);
    v = DPP_ADD(v, 0x141);
    v = DPP_ADD(v, 0x140);
    const int vi = __builtin_bit_cast(int, v);
    const float r0 = __builtin_bit_cast(float, __builtin_amdgcn_readlane(vi, 0)), r1 = __builtin_bit_cast(float, __builtin_amdgcn_readlane(vi, 16));
    const float r2 = __builtin_bit_cast(float, __builtin_amdgcn_readlane(vi, 32)), r3 = __builtin_bit_cast(float, __builtin_amdgcn_readlane(vi, 48));
    return (r0 + r1) + (r2 + r3);
}

__device__ __forceinline__ void p0_transpose_item(const float* W, int N, bf16_t* WT, int K, int k0, int n0, int drow0, LAS float* scr, int lane) {
#pragma unroll 8
    for (int i = 0; i < 32; ++i) { const int kk = 2 * i + (lane >> 5); scr[kk * 33 + (lane & 31)] = __builtin_nontemporal_load(W + (size_t)(k0 + kk) * N + n0 + (lane & 31)); }
    LDS_WAIT(); asm volatile("" ::: "memory");
    const int c = lane & 7;
#pragma unroll
    for (int j = 0; j < 4; ++j) { const int n = (lane >> 3) + 8 * j; const LAS float* s = scr + (8 * c) * 33 + n;
        u32x4 o; o.x = cvt_pk_bf16(s[0 * 33], s[1 * 33]); o.y = cvt_pk_bf16(s[2 * 33], s[3 * 33]); o.z = cvt_pk_bf16(s[4 * 33], s[5 * 33]); o.w = cvt_pk_bf16(s[6 * 33], s[7 * 33]);
        *(u32x4*)(WT + (size_t)(drow0 + n) * K + k0 + 8 * c) = o; }
    LDS_WAIT(); asm volatile("" ::: "memory");
}
__device__ __forceinline__ int win_dest_row(int n0) {
    const int s = n0 >> 10, ch = n0 & 1023;
    switch (s) {
        case 0: return 256 * (ch >> 7) + (ch & 127);
        case 1: return 5120 + ch;
        case 2: return 256 * (ch >> 7) + 128 + (ch & 127);
        case 3: return 2048 + ch;
        case 4: return 3072 + ch;
        case 5: return 6144 + ch;
        default: return 4096 + ch;
    }
}
__device__ __forceinline__ void p0_weights(const Frame& F, const float* w_in, const float* w_out, bf16_t* WIN, bf16_t* WOUT, int l, int gw, int NGW) {
    LAS float* scr = (LAS float*)(F.lds + F.wave * 16384);
    constexpr int I_IN = (D / 64) * (DIN / 32), I_OUT = (D / 64) * (D / 32), I_L = I_IN + I_OUT;
    for (int it = gw; it < I_L; it += NGW) {
        int r = it;
        if (r < I_IN) { const int kb = r / (DIN / 32), nb = r % (DIN / 32);
            p0_transpose_item(w_in + (size_t)l * D * DIN, DIN, WIN + (size_t)l * DIN * D, D, 64 * kb, 32 * nb, win_dest_row(32 * nb), scr, F.lane); }
        else { r -= I_IN; const int kb = r / (D / 32), nb = r % (D / 32);
            p0_transpose_item(w_out + (size_t)l * D * D, D, WOUT + (size_t)l * D * D, D, 64 * kb, 32 * nb, 32 * nb, scr, F.lane); }
    }
}
__device__ __forceinline__ void p0_prologue(const Frame& F, const float* c_in, const float* w_ada, const float* b_ada, const float* w_in, const float* w_out, const float* w_sp,
                                            float* MOD, bf16_t* WIN, bf16_t* WOUT, bf16_t* WSB) {
    LAS float* sc = (LAS float*)F.lds;
    LAS float* red = (LAS float*)(F.lds + 16384);
    constexpr int NCH = 48, NIT = NMOD / NCH;
    for (int it = F.vcu; it < DEPTH * NIT; it += F.G) {
        for (int i = F.tid; i < BATCH * D; i += 512) sc[i] = silu_f(c_in[i]);
        __syncthreads();
        const int l = it / NIT, n0 = (it % NIT) * NCH;
        const int ln = F.lane < NCH ? F.lane : NCH - 1;
        const float* W = w_ada + (size_t)l * D * NMOD + n0 + ln;
        const int k0 = F.wave * 256;
        float a0 = 0.f, a1 = 0.f;
#pragma unroll 16
        for (int k = 0; k < 256; ++k) { const float w = __builtin_nontemporal_load(W + (size_t)(k0 + k) * NMOD); a0 += sc[k0 + k] * w; a1 += sc[D + k0 + k] * w; }
        red[(F.wave * 2 + 0) * 64 + F.lane] = a0; red[(F.wave * 2 + 1) * 64 + F.lane] = a1;
        __syncthreads();
        if (F.tid < 128 && (F.tid & 63) < NCH) { const int b = F.tid >> 6, lc = F.tid & 63; float s = 0.f;
#pragma unroll
            for (int w = 0; w < 8; ++w) s += red[(w * 2 + b) * 64 + lc];
            MOD[(size_t)(l * BATCH + b) * NMOD + n0 + lc] = s + b_ada[(size_t)l * NMOD + n0 + lc]; }
        __syncthreads();
    }
    p0_weights(F, w_in, w_out, WIN, WOUT, 0, F.vcu * 8 + F.wave, F.G * 8);
    const int gw = F.vcu * 8 + F.wave, NGW = F.G * 8;
    for (int i = (gw * 64 + F.lane) * 4; i < DEPTH * NG * 128 * 128; i += NGW * 64 * 4) { const f32x4 v = *(const f32x4*)(w_sp + i); u32x2 o; o.x = cvt_pk_bf16(v[0], v[1]); o.y = cvt_pk_bf16(v[2], v[3]); *(u32x2*)(WSB + i) = o; }
}

struct LnStage { const bf16_t* y; const float* g; const float* b; };
__device__ __forceinline__ void ln_row_norm(f32x4 (&v)[8], float& rstd) {
    float s = 0.f;
#pragma unroll
    for (int j = 0; j < 8; ++j) s += (v[j][0] + v[j][1]) + (v[j][2] + v[j][3]);
    const float mean = wave_sum(s) * (1.f / D); float s2 = 0.f;
#pragma unroll
    for (int j = 0; j < 8; ++j) { v[j] = v[j] - mean; s2 += (v[j][0] * v[j][0] + v[j][1] * v[j][1]) + (v[j][2] * v[j][2] + v[j][3] * v[j][3]); }
    rstd = __builtin_amdgcn_rsqf(wave_sum(s2) * (1.f / D) + LN_EPS);
}
__device__ __forceinline__ void ln_phase(const Frame& F, const float* src, const LnStage sa, const LnStage sb, float* xout, bool has_h, const float* modn, bf16_t* H) {
    LAS float* tga = (LAS float*)F.lds;
    LAS float* tba = tga + D; LAS float* tgb = tba + D; LAS float* tbb = tgb + D; LAS float* ts = tbb + D; LAS float* th = ts + D;
    for (int rb = F.vcu; rb < M / 64; rb += F.G) {
        const int bat = (rb * 64) / T;
        __syncthreads();
        for (int i = F.tid; i < D; i += 512) {
            if (sa.y) { tga[i] = sa.g[i]; tba[i] = sa.b[i]; }
            if (sb.y) { tgb[i] = sb.g[i]; tbb[i] = sb.b[i]; }
            if (has_h) { th[i] = modn[(size_t)bat * NMOD + i]; ts[i] = 1.0f + modn[(size_t)bat * NMOD + D + i]; }
        }
        __syncthreads();
        for (int i = 0; i < 8; ++i) {
            const size_t row = (size_t)rb * 64 + F.wave * 8 + i;
            const f32x4* xr = (const f32x4*)(src + row * D) + F.lane;
            f32x4 v[8]; u32x2 ya[8], yb[8];
#pragma unroll
            for (int j = 0; j < 8; ++j) v[j] = __builtin_nontemporal_load(xr + 64 * j);
            if (sa.y) { const u32x2* yr = (const u32x2*)(sa.y + row * D) + F.lane;
#pragma unroll
                for (int j = 0; j < 8; ++j) ya[j] = yr[64 * j]; }
            if (sb.y) { const u32x2* yr = (const u32x2*)(sb.y + row * D) + F.lane;
#pragma unroll
                for (int j = 0; j < 8; ++j) yb[j] = yr[64 * j]; }
            if (sa.y) {
#pragma unroll
                for (int j = 0; j < 8; ++j) v[j] = v[j] * DN_ALPHA + (f32x4){bf_lo(ya[j].x), bf_hi(ya[j].x), bf_lo(ya[j].y), bf_hi(ya[j].y)};
                float rstd; ln_row_norm(v, rstd);
#pragma unroll
                for (int j = 0; j < 8; ++j) v[j] = v[j] * rstd * *(const LAS f32x4*)(tga + 4 * F.lane + 256 * j) + *(const LAS f32x4*)(tba + 4 * F.lane + 256 * j);
            }
            if (sb.y) {
#pragma unroll
                for (int j = 0; j < 8; ++j) v[j] = v[j] * DN_ALPHA + (f32x4){bf_lo(yb[j].x), bf_hi(yb[j].x), bf_lo(yb[j].y), bf_hi(yb[j].y)};
                float rstd; ln_row_norm(v, rstd);
#pragma unroll
                for (int j = 0; j < 8; ++j) v[j] = v[j] * rstd * *(const LAS f32x4*)(tgb + 4 * F.lane + 256 * j) + *(const LAS f32x4*)(tbb + 4 * F.lane + 256 * j);
            }
            if (xout) { f32x4* xo = (f32x4*)(xout + row * D) + F.lane;
#pragma unroll
                for (int j = 0; j < 8; ++j) __builtin_nontemporal_store(v[j], xo + 64 * j); }
            if (has_h) {
                float rstd; ln_row_norm(v, rstd);
                u32x2* ho = (u32x2*)(H + row * D) + F.lane;
#pragma unroll
                for (int j = 0; j < 8; ++j) { const f32x4 o = v[j] * rstd * *(const LAS f32x4*)(ts + 4 * F.lane + 256 * j) + *(const LAS f32x4*)(th + 4 * F.lane + 256 * j);
                    u32x2 w; w.x = cvt_pk_bf16(o[0], o[1]); w.y = cvt_pk_bf16(o[2], o[3]); ho[64 * j] = w; }
            }
        }
    }
    __syncthreads();
}

constexpr int SG_LDP = 136;
constexpr int SG_W_OFF = 0, SG_VT_OFF = 34816, SG_GY_OFF = 69632, SG_RED_OFF = 104448, SG_STAT_OFF = SG_RED_OFF + 8192;
__device__ __forceinline__ void sgu_phase(const Frame& F, int l, const float* sgu_g, const float* sgu_b, const float* b_sp, const bf16_t* WSB, const bf16_t* VGT, const bf16_t* GA, bf16_t* YC) {
    LAS bf16_t* wl = (LAS bf16_t*)(F.lds + SG_W_OFF);
    LAS bf16_t* vt = (LAS bf16_t*)(F.lds + SG_VT_OFF);
    LAS bf16_t* gy = (LAS bf16_t*)(F.lds + SG_GY_OFF);
    LAS float* red = (LAS float*)(F.lds + SG_RED_OFF);
    LAS float* stat = (LAS float*)(F.lds + SG_STAT_OFF);
    const int fr = F.lane & 15, fq = F.lane >> 4;
    const int chunk = F.tid & 15, rq = F.tid >> 4;
    const int hG = F.G / 2, hf = F.vcu / hG, vl = F.vcu % hG, nitems = NG * (T / 128);
    const int per = (nitems + hG - 1) / hG;
    int g_loaded = -1;
    for (int ii = 0; ii < per; ++ii) {
        const int s = vl * per + ii; if (s >= nitems) break;
        const int g = s / (T / 128), bn = hf * (T / 128) + s % (T / 128);
        const size_t m0 = (size_t)bn * 128;
        __syncthreads();
        if (g != g_loaded) {
            const bf16_t* Wg = WSB + ((size_t)l * NG + g) * 128 * 128;
            u32x4 wv[4];
#pragma unroll
            for (int j = 0; j < 4; ++j) wv[j] = *(const u32x4*)(Wg + (rq + 32 * j) * 128 + 8 * chunk);
#pragma unroll
            for (int j = 0; j < 4; ++j) *(LAS u32x4*)(wl + (rq + 32 * j) * SG_LDP + 8 * chunk) = wv[j];
            g_loaded = g;
        }
        u32x4 vw[4];
#pragma unroll
        for (int j = 0; j < 4; ++j) vw[j] = *(const u32x4*)(VGT + ((size_t)bn * DS + g * 128 + rq + 32 * j) * 128 + 8 * chunk);
        { u32x4 gv[4];
#pragma unroll
            for (int j = 0; j < 4; ++j) gv[j] = *(const u32x4*)(GA + (m0 + rq + 32 * j) * DS + g * 128 + 8 * chunk);
#pragma unroll
            for (int j = 0; j < 4; ++j) *(LAS u32x4*)(gy + (rq + 32 * j) * SG_LDP + 8 * chunk) = gv[j]; }
        float gam[4], bet[4];
#pragma unroll
        for (int j = 0; j < 4; ++j) { gam[j] = sgu_g[(size_t)l * DS + g * 128 + rq + 32 * j]; bet[j] = sgu_b[(size_t)l * DS + g * 128 + rq + 32 * j]; }
        float x[4][8], s1[8], s2[8];
#pragma unroll
        for (int j = 0; j < 4; ++j) { x[j][0] = bf_lo(vw[j].x); x[j][1] = bf_hi(vw[j].x); x[j][2] = bf_lo(vw[j].y); x[j][3] = bf_hi(vw[j].y); x[j][4] = bf_lo(vw[j].z); x[j][5] = bf_hi(vw[j].z); x[j][6] = bf_lo(vw[j].w); x[j][7] = bf_hi(vw[j].w); }
#pragma unroll
        for (int e = 0; e < 8; ++e) { s1[e] = (x[0][e] + x[1][e]) + (x[2][e] + x[3][e]); s2[e] = (x[0][e] * x[0][e] + x[1][e] * x[1][e]) + (x[2][e] * x[2][e] + x[3][e] * x[3][e]);
            s1[e] += __shfl_xor(s1[e], 16); s1[e] += __shfl_xor(s1[e], 32); s2[e] += __shfl_xor(s2[e], 16); s2[e] += __shfl_xor(s2[e], 32); }
        if (fq == 0) {
            *(LAS f32x4*)(red + (F.wave * 2 + 0) * 128 + 8 * chunk) = (f32x4){s1[0], s1[1], s1[2], s1[3]}; *(LAS f32x4*)(red + (F.wave * 2 + 0) * 128 + 8 * chunk + 4) = (f32x4){s1[4], s1[5], s1[6], s1[7]};
            *(LAS f32x4*)(red + (F.wave * 2 + 1) * 128 + 8 * chunk) = (f32x4){s2[0], s2[1], s2[2], s2[3]}; *(LAS f32x4*)(red + (F.wave * 2 + 1) * 128 + 8 * chunk + 4) = (f32x4){s2[4], s2[5], s2[6], s2[7]};
        }
        __syncthreads();
        if (F.tid < 128) { float a1 = 0.f, a2 = 0.f;
#pragma unroll
            for (int w = 0; w < 8; ++w) { a1 += red[(w * 2 + 0) * 128 + F.tid]; a2 += red[(w * 2 + 1) * 128 + F.tid]; }
            const float mean = a1 * (1.f / 128.f); const float var = fmaxf(a2 * (1.f / 128.f) - mean * mean, 0.f);
            stat[2 * F.tid] = mean; stat[2 * F.tid + 1] = __builtin_amdgcn_rsqf(var + LN_EPS); }
        __syncthreads();
        {
            float mu[8], rs[8];
#pragma unroll
            for (int e = 0; e < 8; e += 2) { const f32x4 st4 = *(const LAS f32x4*)(stat + 2 * (8 * chunk + e)); mu[e] = st4[0]; rs[e] = st4[1]; mu[e + 1] = st4[2]; rs[e + 1] = st4[3]; }
#pragma unroll
            for (int j = 0; j < 4; ++j) { u32x4 o;
                o.x = cvt_pk_bf16((x[j][0] - mu[0]) * rs[0] * gam[j] + bet[j], (x[j][1] - mu[1]) * rs[1] * gam[j] + bet[j]);
                o.y = cvt_pk_bf16((x[j][2] - mu[2]) * rs[2] * gam[j] + bet[j], (x[j][3] - mu[3]) * rs[3] * gam[j] + bet[j]);
                o.z = cvt_pk_bf16((x[j][4] - mu[4]) * rs[4] * gam[j] + bet[j], (x[j][5] - mu[5]) * rs[5] * gam[j] + bet[j]);
                o.w = cvt_pk_bf16((x[j][6] - mu[6]) * rs[6] * gam[j] + bet[j], (x[j][7] - mu[7]) * rs[7] * gam[j] + bet[j]);
                *(LAS u32x4*)(vt + (rq + 32 * j) * SG_LDP + 8 * chunk) = o; }
        }
        __syncthreads();
        {
            bf16x8 af[4];
#pragma unroll
            for (int ks = 0; ks < 4; ++ks) af[ks] = *(const LAS bf16x8*)(vt + (16 * F.wave + fr) * SG_LDP + 32 * ks + 8 * fq);
#pragma unroll
            for (int nt = 0; nt < 8; ++nt) {
                f32x4 acc = {0.f, 0.f, 0.f, 0.f};
#pragma unroll
                for (int ks = 0; ks < 4; ++ks) { const bf16x8 bfrag = *(const LAS bf16x8*)(wl + (16 * nt + fr) * SG_LDP + 32 * ks + 8 * fq);
                    acc = __builtin_amdgcn_mfma_f32_16x16x32_bf16(af[ks], bfrag, acc, 0, 0, 0); }
                const int p = 16 * nt + fr;
                const float bs = b_sp[((size_t)l * NG + g) * 128 + p];
                LAS u32x2* gp = (LAS u32x2*)(gy + p * SG_LDP + 16 * F.wave + 4 * fq);
                const u32x2 gaw = *gp;
                u32x2 o; o.x = cvt_pk_bf16(bf_lo(gaw.x) * (acc[0] + bs), bf_hi(gaw.x) * (acc[1] + bs)); o.y = cvt_pk_bf16(bf_lo(gaw.y) * (acc[2] + bs), bf_hi(gaw.y) * (acc[3] + bs));
                *gp = o;
            }
        }
        __syncthreads();
#pragma unroll
        for (int j = 0; j < 4; ++j) { const int p = rq + 32 * j; *(u32x4*)(YC + (m0 + p) * D + g * 128 + 8 * chunk) = *(const LAS u32x4*)(gy + p * SG_LDP + 8 * chunk); }
    }
    __syncthreads();
}

struct AttnPtrs { const float* rpb; const bf16_t *Qb, *Kb, *VT, *ZB; bf16_t* YC; };
constexpr int AK_OFF = 0, AV_OFF = 73728, ATT_BIAS_OFF = 147456;
static_assert(ATT_BIAS_OFF + 15 * 32 * 4 <= LDSCTL_OFF, "attention LDS map");
static_assert(DEPTH == 2, "the LN phases chain exactly two DeepNorm stages");
__device__ __forceinline__ int kswz(int key) { return ((key >> 1) & 1) | (((key >> 3) & 3) << 1); }
__device__ __forceinline__ int rstart(int r) { return min(max(r - 4, 0), 120); }
__device__ __forceinline__ void attn_phase(const Frame& F, const AttnPtrs& P, int l) {
    const int fr = F.lane & 15, fq = F.lane >> 4, cb = F.wave & 3, rsel = F.wave >> 2;
    const int bs = min(max(16 * cb - 8, 0), 32);
    const int qcol = 16 * cb + fr;
    const int wst = min(max(qcol - 8, 0), 48);
    int ci[2][4];
#pragma unroll
    for (int X = 0; X < 2; ++X)
#pragma unroll
        for (int e = 0; e < 4; ++e) { const int kc = bs + 8 * fq + 4 * X + e; ci[X][e] = ((kc >= wst) && (kc < wst + 16)) ? min(max(kc - qcol + 15, 0), 30) : 31; }
    int koff[2][2];
#pragma unroll
    for (int X = 0; X < 2; ++X) { const int key = bs + 8 * (fr >> 2) + 4 * X + (fr & 3);
#pragma unroll
        for (int ks = 0; ks < 2; ++ks) koff[X][ks] = key * 128 + (((ks * 4 + fq) ^ kswz(key)) << 4); }
    const int voff = (((bs >> 3) + fq) * 64 + fr) * 16;
    const int kwr = (F.tid >> 3) * 128 + (((F.tid & 7) ^ kswz(F.tid >> 3)) << 4);
    const LAS float* rp = (const LAS float*)(F.lds + ATT_BIAS_OFF);
    for (int item = F.vcu; item < BATCH * NH * 8; item += F.G) {
        const int bh = item >> 3, r0 = 16 * (item & 7), b = bh >> 4, h = bh & 15;
        const size_t hb = (size_t)bh * T;
        const bf16_t* Kg = P.Kb + hb * 64 + F.tid * 8;
        const bf16_t* Vg = P.VT + hb * 64 + F.tid * 8;
        bf16_t* yb = P.YC + ((size_t)b * T + qcol) * D + DS + h * 64 + 4 * fq;
        __syncthreads();
        for (int i = F.tid; i < 15 * 32; i += 512) ((LAS float*)(F.lds + ATT_BIAS_OFF))[i] = (i & 31) == 31 ? -1.0e30f : P.rpb[((size_t)l * NH + h) * 15 * 31 + (i >> 5) * 31 + (i & 31)] * 1.4426950408889634f;
        { const int lo = rstart(r0), hi = rstart(r0 + 1) + 8;
            u32x4 kv[9], vv[9];
#pragma unroll
            for (int i = 0; i < 9; ++i) { const int kr = min(lo + i, T / 64 - 1); kv[i] = *(const u32x4*)(Kg + (size_t)kr * 4096); vv[i] = *(const u32x4*)(Vg + (size_t)kr * 4096); }
#pragma unroll
            for (int i = 0; i < 9; ++i) if (lo + i < hi) { const int slot = (lo + i) % 9;
                *(LAS u32x4*)(F.lds + AK_OFF + slot * 8192 + kwr) = kv[i]; *(LAS u32x4*)(F.lds + AV_OFF + slot * 8192 + F.tid * 16) = vv[i]; } }
        bf16x8 qf[2]; u32x2 zw[4];
        { const size_t tk = hb + (r0 + rsel) * 64 + qcol;
#pragma unroll
            for (int ks = 0; ks < 2; ++ks) qf[ks] = *(const bf16x8*)(P.Qb + tk * 64 + 32 * ks + 8 * fq);
#pragma unroll
            for (int d = 0; d < 4; ++d) zw[d] = *(const u32x2*)(P.ZB + tk * 64 + 16 * d + 4 * fq); }
        u32x2 yw[4];
        __syncthreads();
        for (int st = 0; st < 8; ++st) {
            const int ra = r0 + 2 * st, r = ra + rsel, rs = rstart(r);
            if (st > 0) {
#pragma unroll
                for (int d = 0; d < 4; ++d) *(u32x2*)(yb + (size_t)(r - 2) * 64 * D + 16 * d) = yw[d]; }
            const int nlo = rstart(ra + 1) + 8, nhi = (st < 7) ? rstart(ra + 3) + 7 : -1;
            const int kr0 = min(nlo, T / 64 - 1), kr1 = min(nlo + 1, T / 64 - 1);
            const u32x4 pk0 = *(const u32x4*)(Kg + (size_t)kr0 * 4096), pv0 = *(const u32x4*)(Vg + (size_t)kr0 * 4096);
            const u32x4 pk1 = *(const u32x4*)(Kg + (size_t)kr1 * 4096), pv1 = *(const u32x4*)(Vg + (size_t)kr1 * 4096);
            const size_t tkn = hb + min(r + 2, T / 64 - 1) * 64 + qcol;
            bf16x8 qn[2]; u32x2 zn[4];
#pragma unroll
            for (int ks = 0; ks < 2; ++ks) qn[ks] = *(const bf16x8*)(P.Qb + tkn * 64 + 32 * ks + 8 * fq);
#pragma unroll
            for (int d = 0; d < 4; ++d) zn[d] = *(const u32x2*)(P.ZB + tkn * 64 + 16 * d + 4 * fq);
            float s[8][2][4];
            float mx = -3.0e38f;
#pragma unroll
            for (int i = 0; i < 8; ++i) {
                const LAS float* rpi = rp + (rs + i - r + 7) * 32;
                const LAS unsigned char* kb = F.lds + AK_OFF + ((rs + i) % 9) * 8192;
#pragma unroll
                for (int X = 0; X < 2; ++X) {
                    f32x4 c = {rpi[ci[X][0]], rpi[ci[X][1]], rpi[ci[X][2]], rpi[ci[X][3]]};
#pragma unroll
                    for (int ks = 0; ks < 2; ++ks) c = __builtin_amdgcn_mfma_f32_16x16x32_bf16(*(const LAS bf16x8*)(kb + koff[X][ks]), qf[ks], c, 0, 0, 0);
                    s[i][X][0] = c[0]; s[i][X][1] = c[1]; s[i][X][2] = c[2]; s[i][X][3] = c[3];
                    mx = fmaxf(fmaxf(mx, c[0]), c[1]); mx = fmaxf(fmaxf(mx, c[2]), c[3]);
                }
            }
            mx = fmaxf(mx, __shfl_xor(mx, 16)); mx = fmaxf(mx, __shfl_xor(mx, 32));
#pragma unroll
            for (int i = 0; i < 8; ++i)
#pragma unroll
                for (int X = 0; X < 2; ++X)
#pragma unroll
                    for (int e = 0; e < 4; ++e) s[i][X][e] = __builtin_amdgcn_exp2f(s[i][X][e] - mx);
            f32x4 o[4], osum = {0.f, 0.f, 0.f, 0.f};
#pragma unroll
            for (int d = 0; d < 4; ++d) o[d] = (f32x4){0.f, 0.f, 0.f, 0.f};
            const bf16x8 ones = {0x3F80, 0x3F80, 0x3F80, 0x3F80, 0x3F80, 0x3F80, 0x3F80, 0x3F80};
#pragma unroll
            for (int i = 0; i < 8; ++i) {
                union { u32x4 u; bf16x8 v; } pb;
                pb.u.x = cvt_pk_bf16(s[i][0][0], s[i][0][1]); pb.u.y = cvt_pk_bf16(s[i][0][2], s[i][0][3]); pb.u.z = cvt_pk_bf16(s[i][1][0], s[i][1][1]); pb.u.w = cvt_pk_bf16(s[i][1][2], s[i][1][3]);
                const LAS unsigned char* vb = F.lds + AV_OFF + ((rs + i) % 9) * 8192 + voff;
#pragma unroll
                for (int d = 0; d < 4; ++d) o[d] = __builtin_amdgcn_mfma_f32_16x16x32_bf16(*(const LAS bf16x8*)(vb + d * 256), pb.v, o[d], 0, 0, 0);
                osum = __builtin_amdgcn_mfma_f32_16x16x32_bf16(ones, pb.v, osum, 0, 0, 0);
            }
            const float sum = osum[0];
            const float inv = 1.0f / sum;
#pragma unroll
            for (int d = 0; d < 4; ++d) {
                yw[d].x = cvt_pk_bf16(o[d][0] * inv * bf_lo(zw[d].x), o[d][1] * inv * bf_hi(zw[d].x)); yw[d].y = cvt_pk_bf16(o[d][2] * inv * bf_lo(zw[d].y), o[d][3] * inv * bf_hi(zw[d].y)); }
            __syncthreads();
            if (nlo <= nhi) { const int slot = nlo % 9; *(LAS u32x4*)(F.lds + AK_OFF + slot * 8192 + kwr) = pk0; *(LAS u32x4*)(F.lds + AV_OFF + slot * 8192 + F.tid * 16) = pv0; }
            if (nlo + 1 <= nhi) { const int slot = (nlo + 1) % 9; *(LAS u32x4*)(F.lds + AK_OFF + slot * 8192 + kwr) = pk1; *(LAS u32x4*)(F.lds + AV_OFF + slot * 8192 + F.tid * 16) = pv1; }
            __syncthreads();
            qf[0] = qn[0]; qf[1] = qn[1];
#pragma unroll
            for (int d = 0; d < 4; ++d) zw[d] = zn[d];
        }
#pragma unroll
        for (int d = 0; d < 4; ++d) *(u32x2*)(yb + (size_t)(r0 + 14 + rsel) * 64 * D + 16 * d) = yw[d];
    }
    __syncthreads();
}

struct Args { const float* in[13]; float* out; unsigned char* ws; int ph_lo, ph_hi; };
constexpr int N_PHASES = 2 + 4 * DEPTH;

typedef const __attribute__((address_space(4))) Args* ArgsP;
__device__ __forceinline__ ArgsP fresh_args() { ArgsP p = (ArgsP)__builtin_amdgcn_kernarg_segment_ptr(); asm volatile("" : "+s"(p)); return p; }
#ifndef MK_MASK
#define MK_MASK 63
#endif
#ifndef MK_REP
#define MK_REP 0
#endif
__global__ void __launch_bounds__(512, 2) mk_fwd(Args args) {
    extern __shared__ __attribute__((aligned(16))) unsigned char lds[];
    { LAS unsigned* z = (LAS unsigned*)((LAS unsigned char*)lds + LDSCTL_OFF); for (int u = threadIdx.x; u < (LDS_BYTES - LDSCTL_OFF) / 4; u += 512) z[u] = 0u; }
    __syncthreads();
    const int lo = args.ph_lo, hi = args.ph_hi;
    const unsigned half_ = ((blockIdx.x & 7u) >> 2) & 1u;
    XcdBarrier bar, barh; bar.bar = (unsigned*)(args.ws + WS_CTL) + CW_BAR; bar.x = 0; bar.st = nullptr; bar.expect = gridDim.x; barh = bar;
    if (hi - lo > 1) {
        bar = xcd_barrier_post((unsigned*)(args.ws + WS_CTL) + CW_BAR, (volatile LAS unsigned*)((LAS unsigned char*)lds + MISC_OFF) + 8, gridDim.x);
        barh = xcd_barrier_post((unsigned*)(args.ws + WS_CTL) + CW_BAR + (1 + half_) * XCD_BAR_WORDS, (volatile LAS unsigned*)((LAS unsigned char*)lds + MISC_OFF) + 10, gridDim.x / 2);
    }
    const bool split_ok = (gridDim.x % 16) == 0;

    for (int ph = lo; ph < hi; ++ph) {
      const int kind_ = ph == 0 ? 1 : (ph == 1 ? 2 : (((ph - 2) & 3) == 0 ? 4 : (((ph - 2) & 3) == 1 ? 64 : (((ph - 2) & 3) == 2 ? 32 : 2))));
      const int nrep_ = (MK_REP & kind_) ? 2 : 1;
      for (int rep_ = 0; rep_ < nrep_; ++rep_) {
        ArgsP ap = fresh_args();
        unsigned char* ws = ap->ws;
        int tid_ = threadIdx.x, bx = blockIdx.x, G_ = gridDim.x;
        asm volatile("" : "+v"(tid_)); asm volatile("" : "+s"(bx), "+s"(G_));
        Frame F; F.lds = (LAS unsigned char*)lds; F.tid = tid_; F.lane = tid_ & 63; F.wave = __builtin_amdgcn_readfirstlane(tid_ >> 6);
        F.G = G_; F.vcu = (G_ % 8 == 0) ? (bx % 8) * (G_ / 8) + bx / 8 : bx;
        if (ph == 0) {
            if (MK_MASK & 1) p0_prologue(F, ap->in[1], ap->in[2], ap->in[3], ap->in[4], ap->in[10], ap->in[7], (float*)(ws + WS_MOD), (bf16_t*)(ws + WS_WIN), (bf16_t*)(ws + WS_WOUT), (bf16_t*)(ws + WS_WSB));
        } else if (ph == 1) {
            if (split_ok && half_ == 1u) {
                __syncthreads();
                p0_weights(F, ap->in[4], ap->in[10], (bf16_t*)(ws + WS_WIN), (bf16_t*)(ws + WS_WOUT), 1, (F.vcu - F.G / 2) * 8 + F.wave, (F.G / 2) * 8);
                __syncthreads();
            } else if (!split_ok) { __syncthreads(); p0_weights(F, ap->in[4], ap->in[10], (bf16_t*)(ws + WS_WIN), (bf16_t*)(ws + WS_WOUT), 1, F.vcu * 8 + F.wave, F.G * 8); __syncthreads(); }
            if (MK_MASK & 2) ln_phase(F, ap->in[0], LnStage{nullptr, nullptr, nullptr}, LnStage{nullptr, nullptr, nullptr}, nullptr, true, (const float*)(ws + WS_MOD), (bf16_t*)(ws + WS_H));
        } else {
            const int l = (ph - 2) >> 2, k = (ph - 2) & 3;
            if (k == 0) { if (MK_MASK & 4) {
                const bf16_t* H = (const bf16_t*)(ws + WS_H); const bf16_t* W = (const bf16_t*)(ws + WS_WIN) + (size_t)l * DIN * D;
                pg8::Gemm g{H, W, W + (size_t)5120 * D, H, D};
                pg8::ProjOrder S; S.init(F.G, bx);
                pg8::EpiProj E{(bf16_t*)(ws + WS_GA), (bf16_t*)(ws + WS_VG), (bf16_t*)(ws + WS_Q), (bf16_t*)(ws + WS_VT)};
                pg8::gemm_phase<pg8::EpiProj, pg8::ProjOrder>(F.lds, F.tid, g, S, E); }
            } else if (k == 1) {
                for (int q_ = 0; q_ < ((MK_REP & 8) ? 2 : 1); ++q_) if (MK_MASK & 8) sgu_phase(F, l, ap->in[5], ap->in[6], ap->in[8], (const bf16_t*)(ws + WS_WSB), (const bf16_t*)(ws + WS_VG), (const bf16_t*)(ws + WS_GA), (bf16_t*)(ws + WS_H));
                for (int q_ = 0; q_ < ((MK_REP & 16) ? 2 : 1); ++q_) if (MK_MASK & 16) { const AttnPtrs P{ap->in[9], (const bf16_t*)(ws + WS_Q), (const bf16_t*)(ws + WS_K), (const bf16_t*)(ws + WS_VT), (const bf16_t*)(ws + WS_ZB), (bf16_t*)(ws + WS_H)};
                    attn_phase(F, P, l); }
            } else if (k == 2) { if (MK_MASK & 32) {
                pg8::Gemm g{(const bf16_t*)(ws + WS_H), (const bf16_t*)(ws + WS_WOUT) + (size_t)l * D * D, nullptr, nullptr, D};
                pg8::StaticOrder S; S.init(M, D, F.G, bx);
                LAS float* g1 = (LAS float*)(F.lds + pg8::STAGE_BYTES);
                { const float* gsrc = (const float*)(ws + WS_MOD) + (size_t)l * BATCH * NMOD + 2 * D;
                  for (int i = F.tid; i < BATCH * D / 4; i += 512) { const int b = i / (D / 4), c4 = i % (D / 4); *(LAS f32x4*)(g1 + b * D + c4 * 4) = *(const f32x4*)(gsrc + (size_t)b * NMOD + c4 * 4) + 1.0f; }
                  __syncthreads(); }
                pg8::EpiOut E{g1, (bf16_t*)(ws + (l == 0 ? WS_Y0 : WS_Y))};
                pg8::gemm_phase<pg8::EpiOut, pg8::StaticOrder>(F.lds, F.tid, g, S, E); }
            } else {
                const LnStage s0{(const bf16_t*)(ws + WS_Y0), ap->in[11], ap->in[12]};
                if (l == 0) { if (MK_MASK & 2) ln_phase(F, ap->in[0], s0, LnStage{nullptr, nullptr, nullptr}, nullptr, true, (const float*)(ws + WS_MOD) + (size_t)BATCH * NMOD, (bf16_t*)(ws + WS_H)); }
                else { const LnStage s1{(const bf16_t*)(ws + WS_Y), ap->in[11] + D, ap->in[12] + D};
                    if (MK_MASK & 2) ln_phase(F, ap->in[0], s0, s1, ap->out, false, nullptr, nullptr); }
            }
        }
        if (ph + 1 < hi || rep_ + 1 < nrep_) {
            if (ph == 0 || !split_ok) xcd_barrier(bar);
            else {
                if (ph == 5 && half_ == 0u && threadIdx.x == 0) {
                    unsigned* hc = (unsigned*)(ws + WS_CTL) + CW_HANDOFF; unsigned sp = 0;
                    while (xb_ld(hc) < gridDim.x / 2) { __builtin_amdgcn_s_sleep(2); if (++sp > (1u << 22)) break; }
                }
                xcd_barrier(barh);
                if (ph == 1 && half_ == 1u && threadIdx.x == 0 && rep_ == 0) xb_add((unsigned*)(ws + WS_CTL) + CW_HANDOFF, 1u);
            }
        }
      }
    }
}

extern "C" void kernel_launch(void* const* d_in, const int* in_sizes, int n_in, void* d_out, int out_size, void* d_ws, size_t ws_size, hipStream_t stream) {
    static int grid = 0;
    if (grid == 0) {
        if (n_in != 13 || out_size != M * D || ws_size < WS_END) { fprintf(stderr, "kernel_launch: unexpected shapes (n_in %d, out %d, ws %zu)\n", n_in, out_size, ws_size); grid = -1; return; }
        int dev = 0, cus = 0, per_cu = 0;
        if (hipGetDevice(&dev) != hipSuccess || hipDeviceGetAttribute(&cus, hipDeviceAttributeMultiprocessorCount, dev) != hipSuccess) { grid = -1; return; }
        if (hipFuncSetAttribute((const void*)mk_fwd, hipFuncAttributeMaxDynamicSharedMemorySize, LDS_BYTES) != hipSuccess) { fprintf(stderr, "kernel_launch: hipFuncSetAttribute failed\n"); grid = -1; return; }
        if (hipOccupancyMaxActiveBlocksPerMultiprocessor(&per_cu, (const void*)mk_fwd, 512, LDS_BYTES) != hipSuccess || per_cu < 1) { fprintf(stderr, "kernel_launch: occupancy query reports %d blocks per CU\n", per_cu); per_cu = 1; }
        (void)hipGetLastError();
        grid = cus;
    }
    if (grid < 0) return;
    (void)hipMemsetAsync((char*)d_ws + WS_CTL, 0, CTL_ZERO_BYTES, stream);
    Args a{};
    for (int i = 0; i < 13; ++i) a.in[i] = (const float*)d_in[i];
    a.out = (float*)d_out; a.ws = (unsigned char*)d_ws;
    if (MK_N_LAUNCHES == 1) { a.ph_lo = 0; a.ph_hi = N_PHASES; hipLaunchKernelGGL(mk_fwd, dim3(grid), dim3(512), LDS_BYTES, stream, a); }
    else { for (int p = 0; p < N_PHASES; ++p) { a.ph_lo = p; a.ph_hi = p + 1; hipLaunchKernelGGL(mk_fwd, dim3(grid), dim3(512), LDS_BYTES, stream, a); } }
}
```

```cpp
#include <hip/hip_runtime.h>
#include <cstdio>
#include <cstdint>

#ifndef MK_N_LAUNCHES
#define MK_N_LAUNCHES 1
#endif

#define LAS __attribute__((address_space(3)))
#define GAS __attribute__((address_space(1)))
typedef unsigned short bf16_t;
typedef short bf16x8 __attribute__((ext_vector_type(8)));
typedef float f32x4 __attribute__((ext_vector_type(4)));
typedef float f32x2 __attribute__((ext_vector_type(2)));
typedef unsigned u32x4 __attribute__((ext_vector_type(4)));
typedef unsigned u32x2 __attribute__((ext_vector_type(2)));

constexpr int BATCH = 2, T = 8192, D = 2048, M = BATCH * T, DIN = 7168, DS = 1024, NG = 8, NH = 16, DEPTH = 2;
constexpr int NMOD = 3 * D;
constexpr float LN_EPS = 1e-5f;
constexpr float DN_ALPHA = 1.4142135623730951f;

typedef __bf16 bf16v2 __attribute__((ext_vector_type(2)));
__device__ __forceinline__ unsigned cvt_pk_bf16(float lo, float hi) { const f32x2 v = {lo, hi}; const bf16v2 r = __builtin_convertvector(v, bf16v2); return __builtin_bit_cast(unsigned, r); }
__device__ __forceinline__ float bf_lo(unsigned w) { return __builtin_bit_cast(float, w << 16); }
__device__ __forceinline__ float bf_hi(unsigned w) { return __builtin_bit_cast(float, w & 0xffff0000u); }
__device__ __forceinline__ float silu_f(float x) { return x * __builtin_amdgcn_rcpf(1.0f + __builtin_amdgcn_exp2f(-1.4426950408889634f * x)); }
__device__ __forceinline__ f32x2 gelu_pk(f32x2 v) {
    f32x2 c; c.x = __builtin_amdgcn_fmed3f(v.x, -4.0f, 4.0f); c.y = __builtin_amdgcn_fmed3f(v.y, -4.0f, 4.0f);
    const f32x2 s = c * c;
    f32x2 r = s * 7.0374646370e-11f + (-6.2872893160e-09f);
    r = r * s + 2.5093203053e-07f; r = r * s + (-5.9760889818e-06f); r = r * s + 9.6085055597e-05f; r = r * s + (-1.1195942566e-03f);
    r = r * s + 9.8383713455e-03f; r = r * s + (-6.6361911043e-02f); r = r * s + 3.9890514886e-01f;
    return v * (c * r + 0.5f);
}
__device__ __forceinline__ f32x4 gelu4(f32x4 v) { f32x2 a = gelu_pk((f32x2){v[0], v[1]}), b = gelu_pk((f32x2){v[2], v[3]}); return (f32x4){a.x, a.y, b.x, b.y}; }
__device__ __forceinline__ f32x2 silu_pk(f32x2 v) { const f32x2 a = v * (-1.4426950408889634f); f32x2 e; e.x = __builtin_amdgcn_exp2f(a.x); e.y = __builtin_amdgcn_exp2f(a.y);
    const f32x2 d = e + 1.0f; f32x2 r; r.x = __builtin_amdgcn_rcpf(d.x); r.y = __builtin_amdgcn_rcpf(d.y); return v * r; }
__device__ __forceinline__ f32x4 silu4(f32x4 v) { const f32x2 a = silu_pk((f32x2){v[0], v[1]}), b = silu_pk((f32x2){v[2], v[3]}); return (f32x4){a.x, a.y, b.x, b.y}; }
#ifndef MK_REP
#define MK_REP 0
#endif
__device__ __forceinline__ void store8(bf16_t* p, f32x4 a, f32x4 b) { u32x4 w; w.x = cvt_pk_bf16(a[0], a[1]); w.y = cvt_pk_bf16(a[2], a[3]); w.z = cvt_pk_bf16(b[0], b[1]); w.w = cvt_pk_bf16(b[2], b[3]); *(u32x4*)p = w;
    if (MK_REP & 128) { asm volatile("" ::: "memory"); *(u32x4*)p = w; asm volatile("" ::: "memory"); } }

namespace pg8 {
constexpr int BM = 256, BK = 64, HALF = 128, HTB = HALF * BK * 2, STAGE_BYTES = 8 * HTB, NXCD = 8, WGM = 2;
__host__ __device__ __forceinline__ int lds_byte(int r, int c) { const int st = (r >> 4) * 2 + (c >> 5), rr = r & 15, cc = c & 31, ob = rr * 64 + cc * 2; return st * 1024 + (ob ^ (((ob >> 9) & 1) << 5)); }
__host__ __device__ __forceinline__ void stage_rc(int b, int& R, int& C) { const int st = b / 1024, sb = b % 1024, swz = sb ^ (((sb >> 9) & 1) << 5); R = (st >> 1) * 16 + swz / 64; C = (st & 1) * 32 + (swz % 64) / 2; }
__host__ __device__ __forceinline__ int perm32(int rho) { const int n = rho >> 4, i = rho & 15; return 8 * (i >> 2) + 4 * n + (i & 3); }

struct Unit { int pm, pn, kind; };
struct Gemm { const bf16_t* A0; const bf16_t* B0; const bf16_t* A1; const bf16_t* B1; int K; };

struct StaticOrder {
    int nM, nN, nwg, G, c;
    __device__ void init(int M_, int N_, int G_, int c_) { nM = M_ / BM; nN = N_ / BM; nwg = nM * nN; G = G_; c = c_; }
    __device__ __forceinline__ void map(int wgid, Unit& u) const {
        { const int q = nwg / NXCD, r = nwg % NXCD, xcd = wgid % NXCD, off = wgid / NXCD; wgid = (xcd < r ? xcd * (q + 1) : r * (q + 1) + (xcd - r) * q) + off; }
        const int nig = WGM * nN, gid = wgid / nig, fm = gid * WGM, gsz = (nM - fm) < WGM ? (nM - fm) : WGM;
        u.pm = fm + ((wgid % nig) % gsz); u.pn = (wgid % nig) / gsz; u.kind = 0;
    }
    __device__ __forceinline__ bool next(int i, Unit& u) const { const long L = (long)i * G + c; if (L >= nwg) return false; map((int)L, u); return true; }
};
struct ProjOrder {
    StaticOrder S; int nswap;
    __device__ void init(int G_, int c_) { S.init(M, 5120, G_, c_); nswap = 512; }
    __device__ __forceinline__ bool next(int i, Unit& u) const {
        const long L = (long)i * S.G + S.c;
        if (L < S.nwg) { S.map((int)L, u); return true; }
        const int idx = (int)(L - S.nwg); if (idx >= nswap) return false;
        const int x = idx % 8, t = idx / 8, rnd = t >> 5, j = t & 31;
        u.pm = (j + 4 * rnd) & 7; u.pn = 8 * x + 4 * rnd + (j >> 3); u.kind = 1; return true;
    }
};

struct EpiProj {
    static constexpr bool PERM = true;
    bf16_t *GA, *VGT, *Qb, *VT;
    __device__ __forceinline__ void operator()(const f32x4 (&acc)[2][2][4][2], const Unit& u, int wr, int wc, int fr, int fq) const {
        const int rl = wr * 64 + fr, cl = wc * 32 + 8 * fq;
        if (u.kind == 1) {
            const int tok0 = u.pn * 256 + cl;
            if (u.pm < 4) {
#pragma unroll
                for (int ai = 0; ai < 2; ++ai)
#pragma unroll
                    for (int m = 0; m < 4; ++m) { const int ch = u.pm * 256 + rl + ai * HALF + m * 16;
#pragma unroll
                        for (int bj = 0; bj < 2; ++bj) { const int tk = tok0 + bj * HALF;
                            store8(VGT + ((size_t)(tk >> 7) * DS + ch) * 128 + (tk & 127), gelu4(acc[ai][bj][m][0]), gelu4(acc[ai][bj][m][1])); } }
            } else {
                const int bb = tok0 >> 13;
#pragma unroll
                for (int ai = 0; ai < 2; ++ai)
#pragma unroll
                    for (int m = 0; m < 4; ++m) { const int ch = (u.pm - 4) * 256 + rl + ai * HALF + m * 16;
                        bf16_t* rowp = VT + ((size_t)(bb * NH + (ch >> 6)) * (T / 8) * 64 + (ch & 63)) * 8;
#pragma unroll
                        for (int bj = 0; bj < 2; ++bj) store8(rowp + (size_t)(((tok0 + bj * HALF) & (T - 1)) >> 3) * 512, acc[ai][bj][m][0], acc[ai][bj][m][1]); }
            }
        } else if (u.pn < 8) {
            bf16_t* base = GA + (size_t)(u.pm * 256 + rl) * DS + u.pn * 128 + cl;
#pragma unroll
            for (int ai = 0; ai < 2; ++ai)
#pragma unroll
                for (int m = 0; m < 4; ++m) {
                    const f32x4 r0 = gelu4(acc[ai][0][m][0]) * silu4(acc[ai][1][m][0]), r1 = gelu4(acc[ai][0][m][1]) * silu4(acc[ai][1][m][1]);
                    store8(base + (size_t)(ai * HALF + m * 16) * DS, r0, r1); }
        } else {
            const int t = (u.pn - 8) >> 2, colt = ((u.pn - 8) & 3) * 256;
            bf16_t* out = Qb + (size_t)t * ((size_t)M * DS);
            const int row0 = u.pm * 256 + rl;
            const int bb = row0 >> 13, t0 = row0 & (T - 1);
#define EPI_QKZ(XFORM) _Pragma("unroll") for (int bj = 0; bj < 2; ++bj) { const int col = colt + bj * HALF + cl; \
                bf16_t* base = out + ((size_t)(bb * NH + (col >> 6)) * T + t0) * 64 + (col & 63); \
                _Pragma("unroll") for (int ai = 0; ai < 2; ++ai) _Pragma("unroll") for (int m = 0; m < 4; ++m) { f32x4 v0 = acc[ai][bj][m][0], v1 = acc[ai][bj][m][1]; XFORM; \
                        store8(base + (size_t)(ai * HALF + m * 16) * 64, v0, v1); } }
            if (t == 0) { EPI_QKZ(v0 = v0 * 0.18033688011112042f; v1 = v1 * 0.18033688011112042f) }
            else if (t == 2) { EPI_QKZ(v0 = silu4(v0); v1 = silu4(v1)) }
            else { EPI_QKZ((void)0) }
#undef EPI_QKZ
        }
    }
};
struct EpiOut {
    static constexpr bool PERM = true;
    const LAS float* gate1; bf16_t* Y;
    __device__ __forceinline__ void operator()(const f32x4 (&acc)[2][2][4][2], const Unit& u, int wr, int wc, int fr, int fq) const {
        const int row0 = u.pm * BM + wr * 64 + fr, col0 = u.pn * BM + wc * 32 + 8 * fq;
        const LAS float* gp = gate1 + (u.pm >= (T / BM) ? D : 0) + col0;
        f32x4 g4[2][2];
#pragma unroll
        for (int bj = 0; bj < 2; ++bj)
#pragma unroll
            for (int n = 0; n < 2; ++n) g4[bj][n] = *(const LAS f32x4*)(gp + bj * HALF + n * 4);
#pragma unroll
        for (int ai = 0; ai < 2; ++ai)
#pragma unroll
            for (int m = 0; m < 4; ++m) { bf16_t* rowp = Y + (size_t)(row0 + ai * HALF + m * 16) * D + col0;
#pragma unroll
                for (int bj = 0; bj < 2; ++bj) store8(rowp + bj * HALF, g4[bj][0] * acc[ai][bj][m][0], g4[bj][1] * acc[ai][bj][m][1]); }
    }
};

template <class Epi, class Sched>
__device__ __forceinline__ void gemm_phase(LAS unsigned char* lds, const int tid, const Gemm g, const Sched& S, const Epi& E) {
    const int wid = __builtin_amdgcn_readfirstlane(tid >> 6), lane = tid & 63, wr = wid >> 2, wc = wid & 3, fr = lane & 15, fq = lane >> 4;
    const int K = g.K, nt = K / BK;
    unsigned voffA[2], voffB[2];
#pragma unroll
    for (int i = 0; i < 2; ++i) { int R, C; stage_rc(tid * 16 + i * 8192, R, C); const int Rb = Epi::PERM ? ((R & ~31) + perm32(R & 31)) : R;
        voffA[i] = (unsigned)(R * K + C) * 2u; voffB[i] = (unsigned)(Rb * K + C) * 2u; }
    const size_t kstep = (size_t)(BK * 2);
    const size_t hstep = (size_t)HALF * K * 2;
    const size_t tstep = 2 * hstep;
    const unsigned ldsw = (unsigned)wid * 1024u;
    const int aoff = lds_byte(wr * 64 + fr, fq * 8), boff = lds_byte(wc * 32 + fr, fq * 8);
#define PG8_SA(b, h) (((b) * 2 + (h)) * HTB)
#define PG8_SB(b, h) ((4 + (b) * 2 + (h)) * HTB)
#define PG8_STAGE(bufoff, gbase, voff) do { _Pragma("unroll") for (int _i = 0; _i < 2; ++_i) \
        __builtin_amdgcn_global_load_lds((const unsigned*)((const char*)(gbase) + (voff)[_i]), (LAS unsigned*)(lds + (bufoff) + ldsw + _i * 8192), 16, 0, 0); } while (0)
#define PG8_LDA(dst, b, h) do { _Pragma("unroll") for (int m = 0; m < 4; ++m) _Pragma("unroll") for (int k = 0; k < 2; ++k) dst[m][k] = *(const LAS bf16x8*)(lds + PG8_SA(b, h) + aoff + m * 2048 + k * 1024); } while (0)
#define PG8_LDB(dst, b, h) do { _Pragma("unroll") for (int n = 0; n < 2; ++n) _Pragma("unroll") for (int k = 0; k < 2; ++k) dst[n][k] = *(const LAS bf16x8*)(lds + PG8_SB(b, h) + boff + n * 2048 + k * 1024); } while (0)
#define PG8_MMA(ai, bj, At, Bt) do { __builtin_amdgcn_sched_barrier(0); _Pragma("unroll") for (int m = 0; m < 4; ++m) _Pragma("unroll") for (int n = 0; n < 2; ++n) _Pragma("unroll") for (int k = 0; k < 2; ++k) \
        acc[ai][bj][m][n] = __builtin_amdgcn_mfma_f32_16x16x32_bf16(Bt[n][k], At[m][k], acc[ai][bj][m][n], 0, 0, 0); __builtin_amdgcn_sched_barrier(0); } while (0)
#define PG8_WAIT_V(n) asm volatile("s_waitcnt vmcnt(" #n ")" ::: "memory")
#define PG8_WAIT_L(n) asm volatile("s_waitcnt lgkmcnt(" #n ")" ::: "memory")
#define PG8_BAR __builtin_amdgcn_s_barrier()
#define PG8_SCHED __builtin_amdgcn_sched_barrier(0)
#define PG8_UA(u) ((const char*)((u).kind ? g.A1 : g.A0) + (size_t)(u).pm * tstep)
#define PG8_UB(u) ((const char*)((u).kind ? g.B1 : g.B0) + (size_t)(u).pn * tstep)
    Unit cur, nxt; int ui = 0;
    if (!S.next(0, cur)) return;
    f32x4 acc[2][2][4][2];
#pragma unroll
    for (int a = 0; a < 2; ++a)
#pragma unroll
        for (int b = 0; b < 2; ++b)
#pragma unroll
            for (int m = 0; m < 4; ++m)
#pragma unroll
                for (int n = 0; n < 2; ++n) acc[a][b][m][n] = (f32x4){0.f, 0.f, 0.f, 0.f};
    bf16x8 At[4][2], B0[2][2], B1[2][2];
    const char* cA = PG8_UA(cur); const char* cB = PG8_UB(cur);
    PG8_STAGE(PG8_SB(0, 0), cB, voffB); PG8_STAGE(PG8_SB(0, 1), cB + hstep, voffB); PG8_STAGE(PG8_SA(0, 0), cA, voffA); PG8_STAGE(PG8_SA(0, 1), cA + hstep, voffA);
    if (wr == 1) PG8_BAR;
    PG8_WAIT_V(2); PG8_BAR;
    PG8_STAGE(PG8_SB(1, 0), cB + kstep, voffB); PG8_STAGE(PG8_SA(1, 0), cA + kstep, voffA); PG8_STAGE(PG8_SB(1, 1), cB + hstep + kstep, voffB);
    PG8_WAIT_V(6); PG8_BAR;
    for (;;) {
        const bool has_next = S.next(ui + 1, nxt);
        const char* nA = has_next ? PG8_UA(nxt) : cA; const char* nB = has_next ? PG8_UB(nxt) : cB;
        for (int t = 0; t < nt; t += 2) {
            const bool last = (t == nt - 2);
            const char* a1 = cA + (size_t)(t + 1) * kstep;
            const char* a2 = last ? nA : cA + (size_t)(t + 2) * kstep; const char* b2 = last ? nB : cB + (size_t)(t + 2) * kstep;
            const char* a3 = a2 + kstep; const char* b3 = b2 + kstep;
            PG8_LDB(B0, 0, 0); PG8_LDB(B1, 0, 1); PG8_SCHED; PG8_LDA(At, 0, 0); PG8_STAGE(PG8_SA(1, 1), a1 + hstep, voffA);
            PG8_WAIT_V(8); PG8_WAIT_L(0); PG8_BAR; PG8_MMA(0, 0, At, B0); PG8_MMA(0, 1, At, B1); PG8_BAR; PG8_SCHED;
            PG8_LDA(At, 0, 1); PG8_STAGE(PG8_SB(0, 0), b2, voffB); PG8_STAGE(PG8_SB(0, 1), b2 + hstep, voffB); PG8_STAGE(PG8_SA(0, 0), a2, voffA);
            PG8_WAIT_V(8); PG8_WAIT_L(0); PG8_BAR; PG8_MMA(1, 0, At, B0); PG8_MMA(1, 1, At, B1); PG8_BAR; PG8_SCHED;
            PG8_LDB(B0, 1, 0); PG8_LDB(B1, 1, 1); PG8_SCHED; PG8_LDA(At, 1, 0); PG8_STAGE(PG8_SA(0, 1), a2 + hstep, voffA);
            PG8_WAIT_V(8); PG8_WAIT_L(0); PG8_BAR; PG8_MMA(0, 0, At, B0); PG8_MMA(0, 1, At, B1); PG8_BAR; PG8_SCHED;
            PG8_LDA(At, 1, 1); PG8_STAGE(PG8_SB(1, 0), b3, voffB); PG8_STAGE(PG8_SB(1, 1), b3 + hstep, voffB); PG8_STAGE(PG8_SA(1, 0), a3, voffA);
            PG8_WAIT_V(8); PG8_WAIT_L(0); PG8_BAR; PG8_MMA(1, 0, At, B0); PG8_MMA(1, 1, At, B1); PG8_BAR; PG8_SCHED;
        }
        if (wr == 0) PG8_BAR;
        E(acc, cur, wr, wc, fr, fq);
        if (!has_next) break;
#pragma unroll
        for (int a = 0; a < 2; ++a)
#pragma unroll
            for (int b = 0; b < 2; ++b)
#pragma unroll
                for (int m = 0; m < 4; ++m)
#pragma unroll
                    for (int n = 0; n < 2; ++n) acc[a][b][m][n] = (f32x4){0.f, 0.f, 0.f, 0.f};
        cur = nxt; cA = nA; cB = nB; ++ui;
        if (wr == 1) PG8_BAR;
    }
    PG8_WAIT_V(0);
    PG8_BAR;
#undef PG8_SA
#undef PG8_SB
#undef PG8_STAGE
#undef PG8_LDA
#undef PG8_LDB
#undef PG8_MMA
#undef PG8_WAIT_V
#undef PG8_WAIT_L
#undef PG8_BAR
#undef PG8_SCHED
#undef PG8_UA
#undef PG8_UB
}
}

constexpr size_t MiB = 1u << 20;
constexpr size_t WS_CTL = 0, CTL_ZERO_BYTES = 64 * 1024;
constexpr size_t WS_MOD = 1 * MiB;
constexpr size_t WS_WSB = 1 * MiB + 512 * 1024;
constexpr size_t WS_WIN = 2 * MiB;
constexpr size_t WS_WOUT = 58 * MiB;
constexpr size_t WS_H = 80 * MiB;
constexpr size_t WS_GA = 144 * MiB, WS_VG = 176 * MiB, WS_Q = 208 * MiB, WS_K = 240 * MiB, WS_ZB = 272 * MiB, WS_VT = 304 * MiB;
constexpr size_t WS_Y = 144 * MiB;
constexpr size_t WS_Y0 = 336 * MiB;
constexpr size_t WS_END = 400 * MiB;
static_assert(WS_K - WS_Q == (size_t)M * DS * 2 && WS_ZB - WS_K == (size_t)M * DS * 2, "EpiProj indexes Q|K|ZB as one array");
static_assert((4096 + 3 * 3456) * 4 <= 64 * 1024, "control words inside the memset region");
constexpr int CW_BAR = 4096, CW_HANDOFF = 64;

constexpr int RING_BYTES = 131072, LDS_BYTES = 163840, LDSCTL_OFF = LDS_BYTES - 1024, MISC_OFF = LDSCTL_OFF + 320;

typedef GAS unsigned gu32;
#define RLX_AGENT __ATOMIC_RELAXED, __HIP_MEMORY_SCOPE_AGENT
#define LDS_WAIT() asm volatile("s_waitcnt lgkmcnt(0)" ::: "memory")

#define XB_TMO      128
#define XB_XCNT(j)  (256  + 64 * (j))
#define XB_XSUB(j)  (1280 + 64 * (j))
#define XB_XGEN(j)  (2304 + 64 * (j))
#define XB_TOP      3328
#define XB_TOPGEN   3392
#define XCD_BAR_WORDS 3456
#define XB_SPIN_CAP (1u << 18)
__device__ __forceinline__ unsigned xb_ld(unsigned* p)              { return __hip_atomic_load(p, __ATOMIC_RELAXED, __HIP_MEMORY_SCOPE_AGENT); }
__device__ __forceinline__ unsigned xb_add(unsigned* p, unsigned v) { return __hip_atomic_fetch_add(p, v, __ATOMIC_RELAXED, __HIP_MEMORY_SCOPE_AGENT); }
__device__ __forceinline__ unsigned xb_xcc_id() { return (unsigned)__builtin_amdgcn_s_getreg((3 << 11) | 20) & 0xFu; }
#define XB_SPIN(cond, bar) do { unsigned _sp = 0; while (cond) { __builtin_amdgcn_s_sleep(1); \
    if ((++_sp & 255u) == 0u) { if (xb_ld(&(bar)[XB_TMO])) break; if (_sp > XB_SPIN_CAP) { atomicAdd(&(bar)[XB_TMO], 1u); break; } } } } while (0)
struct XcdBarrier { unsigned* bar; unsigned x; volatile LAS unsigned* st; unsigned expect; };
__device__ __forceinline__ XcdBarrier xcd_barrier_post(unsigned* bar, volatile LAS unsigned* st, unsigned expect) {
    XcdBarrier b; b.bar = bar; b.x = xb_xcc_id(); b.st = st; b.expect = expect;
    if (threadIdx.x == 0) (void)xb_add(&bar[XB_XCNT(b.x)], 1u);
    return b;
}
__device__ __forceinline__ void xcd_barrier_complete(unsigned* bar, unsigned x, unsigned G, unsigned& nloc, unsigned& nx) {
    unsigned sum, cnt, mine, sp = 0u;
    for (;;) {
        sum = 0u; cnt = 0u; mine = 0u;
#pragma unroll
        for (unsigned j = 0; j < 16; ++j) { const unsigned c = xb_ld(&bar[XB_XCNT(j)]); sum += c; cnt += (c > 0u) ? 1u : 0u; mine = (j == x) ? c : mine; }
        if (sum == G) break;
        __builtin_amdgcn_s_sleep(1);
        if ((++sp & 255u) == 0u) { if (xb_ld(&bar[XB_TMO])) break; if (sp > XB_SPIN_CAP) { atomicAdd(&bar[XB_TMO], 1u); break; } }
    }
    nloc = mine > 0u ? mine : 1u; nx = cnt > 0u ? cnt : 1u;
}
__device__ __forceinline__ void xcd_barrier(const XcdBarrier& b) {
    asm volatile("s_waitcnt vmcnt(0)" ::: "memory");
    __syncthreads();
    if (threadIdx.x == 0) {
        unsigned* bar = b.bar;
        __builtin_amdgcn_s_waitcnt(0);
        unsigned nloc = b.st[0], nx = b.st[1];
        if (nloc == 0u) { xcd_barrier_complete(bar, b.x, b.expect, nloc, nx); b.st[0] = nloc; b.st[1] = nx; }
        const unsigned old = xb_add(&bar[XB_XSUB(b.x)], 1u);
        const unsigned gen = old / nloc;
        if (old + 1u == (gen + 1u) * nloc) {
            __builtin_amdgcn_fence(__ATOMIC_RELEASE, "agent");
            asm volatile("s_waitcnt vmcnt(0)" ::: "memory");
            const unsigned og = xb_add(&bar[XB_TOP], 1u);
            const unsigned tg = og / nx;
            if (og + 1u == (tg + 1u) * nx) xb_add(&bar[XB_TOPGEN], 1u);
            else XB_SPIN(xb_ld(&bar[XB_TOPGEN]) == tg, bar);
            __builtin_amdgcn_fence(__ATOMIC_ACQUIRE, "agent");
            xb_add(&bar[XB_XGEN(b.x)], 1u);
            asm volatile("s_waitcnt vmcnt(0)" ::: "memory");
        } else {
            XB_SPIN(xb_ld(&bar[XB_XGEN(b.x)]) == gen, bar);
            __builtin_amdgcn_fence(__ATOMIC_ACQUIRE, "agent");
            asm volatile("s_waitcnt vmcnt(0)" ::: "memory");
        }
    }
    __syncthreads();
}

struct Frame {
    LAS unsigned char* lds;
    int tid, lane, wave, vcu, G;
};

#define DPP_ADD(v, ctrl) ((v) + __builtin_bit_cast(float, __builtin_amdgcn_update_dpp(0, __builtin_bit_cast(int, (v)), (ctrl), 0xf, 0xf, true)))
__device__ __forceinline__ float wave_sum(float v) {
    v = DPP_ADD(v, 0xB1);
    v = DPP_ADD(v, 0x4E);
    v = DPP_ADD(v, 0x141);
    v = DPP_ADD(v, 0x140);
    const int vi = __builtin_bit_cast(int, v);
    const float r0 = __builtin_bit_cast(float, __builtin_amdgcn_readlane(vi, 0)), r1 = __builtin_bit_cast(float, __builtin_amdgcn_readlane(vi, 16));
    const float r2 = __builtin_bit_cast(float, __builtin_amdgcn_readlane(vi, 32)), r3 = __builtin_bit_cast(float, __builtin_amdgcn_readlane(vi, 48));
    return (r0 + r1) + (r2 + r3);
}

__device__ __forceinline__ void p0_transpose_item(const float* W, int N, bf16_t* WT, int K, int k0, int n0, int drow0, LAS float* scr, int lane) {
#pragma unroll 8
    for (int i = 0; i < 32; ++i) { const int kk = 2 * i + (lane >> 5); scr[kk * 33 + (lane & 31)] = __builtin_nontemporal_load(W + (size_t)(k0 + kk) * N + n0 + (lane & 31)); }
    LDS_WAIT(); asm volatile("" ::: "memory");
    const int c = lane & 7;
#pragma unroll
    for (int j = 0; j < 4; ++j) { const int n = (lane >> 3) + 8 * j; const LAS float* s = scr + (8 * c) * 33 + n;
        u32x4 o; o.x = cvt_pk_bf16(s[0 * 33], s[1 * 33]); o.y = cvt_pk_bf16(s[2 * 33], s[3 * 33]); o.z = cvt_pk_bf16(s[4 * 33], s[5 * 33]); o.w = cvt_pk_bf16(s[6 * 33], s[7 * 33]);
        *(u32x4*)(WT + (size_t)(drow0 + n) * K + k0 + 8 * c) = o; }
    LDS_WAIT(); asm volatile("" ::: "memory");
}
__device__ __forceinline__ int win_dest_row(int n0) {
    const int s = n0 >> 10, ch = n0 & 1023;
    switch (s) {
        case 0: return 256 * (ch >> 7) + (ch & 127);
        case 1: return 5120 + ch;
        case 2: return 256 * (ch >> 7) + 128 + (ch & 127);
        case 3: return 2048 + ch;
        case 4: return 3072 + ch;
        case 5: return 6144 + ch;
        default: return 4096 + ch;
    }
}
__device__ __forceinline__ void p0_weights(const Frame& F, const float* w_in, const float* w_out, bf16_t* WIN, bf16_t* WOUT, int l, int gw, int NGW) {
    LAS float* scr = (LAS float*)(F.lds + F.wave * 16384);
    constexpr int I_IN = (D / 64) * (DIN / 32), I_OUT = (D / 64) * (D / 32), I_L = I_IN + I_OUT;
    for (int it = gw; it < I_L; it += NGW) {
        int r = it;
        if (r < I_IN) { const int kb = r / (DIN / 32), nb = r % (DIN / 32);
            p0_transpose_item(w_in + (size_t)l * D * DIN, DIN, WIN + (size_t)l * DIN * D, D, 64 * kb, 32 * nb, win_dest_row(32 * nb), scr, F.lane); }
        else { r -= I_IN; const int kb = r / (D / 32), nb = r % (D / 32);
            p0_transpose_item(w_out + (size_t)l * D * D, D, WOUT + (size_t)l * D * D, D, 64 * kb, 32 * nb, 32 * nb, scr, F.lane); }
    }
}
__device__ __forceinline__ void p0_prologue(const Frame& F, const float* c_in, const float* w_ada, const float* b_ada, const float* w_in, const float* w_out, const float* w_sp,
                                            float* MOD, bf16_t* WIN, bf16_t* WOUT, bf16_t* WSB) {
    LAS float* sc = (LAS float*)F.lds;
    LAS float* red = (LAS float*)(F.lds + 16384);
    constexpr int NCH = 48, NIT = NMOD / NCH;
    for (int it = F.vcu; it < DEPTH * NIT; it += F.G) {
        for (int i = F.tid; i < BATCH * D; i += 512) sc[i] = silu_f(c_in[i]);
        __syncthreads();
        const int l = it / NIT, n0 = (it % NIT) * NCH;
        const int ln = F.lane < NCH ? F.lane : NCH - 1;
        const float* W = w_ada + (size_t)l * D * NMOD + n0 + ln;
        const int k0 = F.wave * 256;
        float a0 = 0.f, a1 = 0.f;
#pragma unroll 16
        for (int k = 0; k < 256; ++k) { const float w = __builtin_nontemporal_load(W + (size_t)(k0 + k) * NMOD); a0 += sc[k0 + k] * w; a1 += sc[D + k0 + k] * w; }
        red[(F.wave * 2 + 0) * 64 + F.lane] = a0; red[(F.wave * 2 + 1) * 64 + F.lane] = a1;
        __syncthreads();
        if (F.tid < 128 && (F.tid & 63) < NCH) { const int b = F.tid >> 6, lc = F.tid & 63; float s = 0.f;
#pragma unroll
            for (int w = 0; w < 8; ++w) s += red[(w * 2 + b) * 64 + lc];
            MOD[(size_t)(l * BATCH + b) * NMOD + n0 + lc] = s + b_ada[(size_t)l * NMOD + n0 + lc]; }
        __syncthreads();
    }
    p0_weights(F, w_in, w_out, WIN, WOUT, 0, F.vcu * 8 + F.wave, F.G * 8);
    const int gw = F.vcu * 8 + F.wave, NGW = F.G * 8;
    for (int i = (gw * 64 + F.lane) * 4; i < DEPTH * NG * 128 * 128; i += NGW * 64 * 4) { const f32x4 v = *(const f32x4*)(w_sp + i); u32x2 o; o.x = cvt_pk_bf16(v[0], v[1]); o.y = cvt_pk_bf16(v[2], v[3]); *(u32x2*)(WSB + i) = o; }
}

struct LnStage { const bf16_t* y; const float* g; const float* b; };
__device__ __forceinline__ void ln_row_norm(f32x4 (&v)[8], float& rstd) {
    float s = 0.f;
#pragma unroll
    for (int j = 0; j < 8; ++j) s += (v[j][0] + v[j][1]) + (v[j][2] + v[j][3]);
    const float mean = wave_sum(s) * (1.f / D); float s2 = 0.f;
#pragma unroll
    for (int j = 0; j < 8; ++j) { v[j] = v[j] - mean; s2 += (v[j][0] * v[j][0] + v[j][1] * v[j][1]) + (v[j][2] * v[j][2] + v[j][3] * v[j][3]); }
    rstd = __builtin_amdgcn_rsqf(wave_sum(s2) * (1.f / D) + LN_EPS);
}
__device__ __forceinline__ void ln_phase(const Frame& F, const float* src, const LnStage sa, const LnStage sb, float* xout, bool has_h, const float* modn, bf16_t* H) {
    LAS float* tga = (LAS float*)F.lds;
    LAS float* tba = tga + D; LAS float* tgb = tba + D; LAS float* tbb = tgb + D; LAS float* ts = tbb + D; LAS float* th = ts + D;
    for (int rb = F.vcu; rb < M / 64; rb += F.G) {
        const int bat = (rb * 64) / T;
        __syncthreads();
        for (int i = F.tid; i < D; i += 512) {
            if (sa.y) { tga[i] = sa.g[i]; tba[i] = sa.b[i]; }
            if (sb.y) { tgb[i] = sb.g[i]; tbb[i] = sb.b[i]; }
            if (has_h) { th[i] = modn[(size_t)bat * NMOD + i]; ts[i] = 1.0f + modn[(size_t)bat * NMOD + D + i]; }
        }
        __syncthreads();
        for (int i = 0; i < 8; ++i) {
            const size_t row = (size_t)rb * 64 + F.wave * 8 + i;
            const f32x4* xr = (const f32x4*)(src + row * D) + F.lane;
            f32x4 v[8]; u32x2 ya[8], yb[8];
#pragma unroll
            for (int j = 0; j < 8; ++j) v[j] = __builtin_nontemporal_load(xr + 64 * j);
            if (sa.y) { const u32x2* yr = (const u32x2*)(sa.y + row * D) + F.lane;
#pragma unroll
                for (int j = 0; j < 8; ++j) ya[j] = yr[64 * j]; }
            if (sb.y) { const u32x2* yr = (const u32x2*)(sb.y + row * D) + F.lane;
#pragma unroll
                for (int j = 0; j < 8; ++j) yb[j] = yr[64 * j]; }
            if (sa.y) {
#pragma unroll
                for (int j = 0; j < 8; ++j) v[j] = v[j] * DN_ALPHA + (f32x4){bf_lo(ya[j].x), bf_hi(ya[j].x), bf_lo(ya[j].y), bf_hi(ya[j].y)};
                float rstd; ln_row_norm(v, rstd);
#pragma unroll
                for (int j = 0; j < 8; ++j) v[j] = v[j] * rstd * *(const LAS f32x4*)(tga + 4 * F.lane + 256 * j) + *(const LAS f32x4*)(tba + 4 * F.lane + 256 * j);
            }
            if (sb.y) {
#pragma unroll
                for (int j = 0; j < 8; ++j) v[j] = v[j] * DN_ALPHA + (f32x4){bf_lo(yb[j].x), bf_hi(yb[j].x), bf_lo(yb[j].y), bf_hi(yb[j].y)};
                float rstd; ln_row_norm(v, rstd);
#pragma unroll
                for (int j = 0; j < 8; ++j) v[j] = v[j] * rstd * *(const LAS f32x4*)(tgb + 4 * F.lane + 256 * j) + *(const LAS f32x4*)(tbb + 4 * F.lane + 256 * j);
            }
            if (xout) { f32x4* xo = (f32x4*)(xout + row * D) + F.lane;
#pragma unroll
                for (int j = 0; j < 8; ++j) __builtin_nontemporal_store(v[j], xo + 64 * j); }
            if (has_h) {
                float rstd; ln_row_norm(v, rstd);
                u32x2* ho = (u32x2*)(H + row * D) + F.lane;
#pragma unroll
                for (int j = 0; j < 8; ++j) { const f32x4 o = v[j] * rstd * *(const LAS f32x4*)(ts + 4 * F.lane + 256 * j) + *(const LAS f32x4*)(th + 4 * F.lane + 256 * j);
                    u32x2 w; w.x = cvt_pk_bf16(o[0], o[1]); w.y = cvt_pk_bf16(o[2], o[3]); ho[64 * j] = w; }
            }
        }
    }
    __syncthreads();
}

__device__ __forceinline__ void lds_sync() { asm volatile("s_waitcnt lgkmcnt(0)" ::: "memory"); __builtin_amdgcn_s_barrier(); asm volatile("" ::: "memory"); }
constexpr int SG_LDP = 136;
constexpr int SG_W_OFF = 0, SG_VT_OFF = 34816, SG_GY_OFF = 69632, SG_RED_OFF = 104448, SG_STAT_OFF = SG_RED_OFF + 8192;
__device__ __forceinline__ void sgu_phase(const Frame& F, int l, const float* sgu_g, const float* sgu_b, const float* b_sp, const bf16_t* WSB, const bf16_t* VGT, const bf16_t* GA, bf16_t* YC) {
    LAS bf16_t* wl = (LAS bf16_t*)(F.lds + SG_W_OFF);
    LAS bf16_t* vt = (LAS bf16_t*)(F.lds + SG_VT_OFF);
    LAS bf16_t* gy = (LAS bf16_t*)(F.lds + SG_GY_OFF);
    LAS float* red = (LAS float*)(F.lds + SG_RED_OFF);
    LAS float* stat = (LAS float*)(F.lds + SG_STAT_OFF);
    const int fr = F.lane & 15, fq = F.lane >> 4;
    const int chunk = F.tid & 15, rq = F.tid >> 4;
    const int hG = F.G / 2, hf = F.vcu / hG, vl = F.vcu % hG, nitems = NG * (T / 128);
    const int per = (nitems + hG - 1) / hG;
    u32x4 vw[4], gv[4];
    float gam[4], bet[4], bsv[8];
    { const int sc = min(vl * per, nitems - 1), g = sc / (T / 128), bn = hf * (T / 128) + sc % (T / 128);
#pragma unroll
      for (int j = 0; j < 4; ++j) { vw[j] = *(const u32x4*)(VGT + ((size_t)bn * DS + g * 128 + rq + 32 * j) * 128 + 8 * chunk); gv[j] = *(const u32x4*)(GA + ((size_t)bn * 128 + rq + 32 * j) * DS + g * 128 + 8 * chunk); } }
    for (int ii = 0; ii < per;) {
      const int s_run = vl * per + ii; if (s_run >= nitems) break;
      const int g = s_run / (T / 128);
      lds_sync();
      {
            const bf16_t* Wg = WSB + ((size_t)l * NG + g) * 128 * 128;
            u32x4 wv[4];
#pragma unroll
            for (int j = 0; j < 4; ++j) wv[j] = *(const u32x4*)(Wg + (rq + 32 * j) * 128 + 8 * chunk);
#pragma unroll
            for (int j = 0; j < 4; ++j) { gam[j] = sgu_g[(size_t)l * DS + g * 128 + rq + 32 * j]; bet[j] = sgu_b[(size_t)l * DS + g * 128 + rq + 32 * j]; }
#pragma unroll
            for (int nt = 0; nt < 8; ++nt) bsv[nt] = b_sp[((size_t)l * NG + g) * 128 + 16 * nt + fr];
#pragma unroll
            for (int j = 0; j < 4; ++j) *(LAS u32x4*)(wl + (rq + 32 * j) * SG_LDP + 8 * chunk) = wv[j];
      }
      for (bool first = true; ii < per; ++ii, first = false) {
        const int s = vl * per + ii; if (s >= nitems || s / (T / 128) != g) break;
        const int bn = hf * (T / 128) + s % (T / 128);
        const size_t m0 = (size_t)bn * 128;
        if (!first) lds_sync();
#pragma unroll
        for (int j = 0; j < 4; ++j) *(LAS u32x4*)(gy + (rq + 32 * j) * SG_LDP + 8 * chunk) = gv[j];
        float x[4][8], s1[8], s2[8];
#pragma unroll
        for (int j = 0; j < 4; ++j) { x[j][0] = bf_lo(vw[j].x); x[j][1] = bf_hi(vw[j].x); x[j][2] = bf_lo(vw[j].y); x[j][3] = bf_hi(vw[j].y); x[j][4] = bf_lo(vw[j].z); x[j][5] = bf_hi(vw[j].z); x[j][6] = bf_lo(vw[j].w); x[j][7] = bf_hi(vw[j].w); }
        { const int sn = (ii + 1 < per && s + 1 < nitems) ? s + 1 : s, gn = sn / (T / 128), bnn = hf * (T / 128) + sn % (T / 128);
#pragma unroll
          for (int j = 0; j < 4; ++j) { vw[j] = *(const u32x4*)(VGT + ((size_t)bnn * DS + gn * 128 + rq + 32 * j) * 128 + 8 * chunk); gv[j] = *(const u32x4*)(GA + ((size_t)bnn * 128 + rq + 32 * j) * DS + gn * 128 + 8 * chunk); } }
#pragma unroll
        for (int e = 0; e < 8; ++e) { s1[e] = (x[0][e] + x[1][e]) + (x[2][e] + x[3][e]); s2[e] = (x[0][e] * x[0][e] + x[1][e] * x[1][e]) + (x[2][e] * x[2][e] + x[3][e] * x[3][e]);
            s1[e] += __shfl_xor(s1[e], 16); s1[e] += __shfl_xor(s1[e], 32); s2[e] += __shfl_xor(s2[e], 16); s2[e] += __shfl_xor(s2[e], 32); }
        if (fq == 0) {
            *(LAS f32x4*)(red + (F.wave * 2 + 0) * 128 + 8 * chunk) = (f32x4){s1[0], s1[1], s1[2], s1[3]}; *(LAS f32x4*)(red + (F.wave * 2 + 0) * 128 + 8 * chunk + 4) = (f32x4){s1[4], s1[5], s1[6], s1[7]};
            *(LAS f32x4*)(red + (F.wave * 2 + 1) * 128 + 8 * chunk) = (f32x4){s2[0], s2[1], s2[2], s2[3]}; *(LAS f32x4*)(red + (F.wave * 2 + 1) * 128 + 8 * chunk + 4) = (f32x4){s2[4], s2[5], s2[6], s2[7]};
        }
        lds_sync();
        if (F.tid < 128) { float a1 = 0.f, a2 = 0.f;
#pragma unroll
            for (int w = 0; w < 8; ++w) { a1 += red[(w * 2 + 0) * 128 + F.tid]; a2 += red[(w * 2 + 1) * 128 + F.tid]; }
            const float mean = a1 * (1.f / 128.f); const float var = fmaxf(a2 * (1.f / 128.f) - mean * mean, 0.f);
            stat[2 * F.tid] = mean; stat[2 * F.tid + 1] = __builtin_amdgcn_rsqf(var + LN_EPS); }
        lds_sync();
        {
            float mu[8], rs[8];
#pragma unroll
            for (int e = 0; e < 8; e += 2) { const f32x4 st4 = *(const LAS f32x4*)(stat + 2 * (8 * chunk + e)); mu[e] = st4[0]; rs[e] = st4[1]; mu[e + 1] = st4[2]; rs[e + 1] = st4[3]; }
#pragma unroll
            for (int j = 0; j < 4; ++j) { u32x4 o;
                o.x = cvt_pk_bf16((x[j][0] - mu[0]) * rs[0] * gam[j] + bet[j], (x[j][1] - mu[1]) * rs[1] * gam[j] + bet[j]);
                o.y = cvt_pk_bf16((x[j][2] - mu[2]) * rs[2] * gam[j] + bet[j], (x[j][3] - mu[3]) * rs[3] * gam[j] + bet[j]);
                o.z = cvt_pk_bf16((x[j][4] - mu[4]) * rs[4] * gam[j] + bet[j], (x[j][5] - mu[5]) * rs[5] * gam[j] + bet[j]);
                o.w = cvt_pk_bf16((x[j][6] - mu[6]) * rs[6] * gam[j] + bet[j], (x[j][7] - mu[7]) * rs[7] * gam[j] + bet[j]);
                *(LAS u32x4*)(vt + (rq + 32 * j) * SG_LDP + 8 * chunk) = o; }
        }
        lds_sync();
        {
            bf16x8 af[4];
#pragma unroll
            for (int ks = 0; ks < 4; ++ks) af[ks] = *(const LAS bf16x8*)(vt + (16 * F.wave + fr) * SG_LDP + 32 * ks + 8 * fq);
#pragma unroll
            for (int nt = 0; nt < 8; ++nt) {
                f32x4 acc = {0.f, 0.f, 0.f, 0.f};
#pragma unroll
                for (int ks = 0; ks < 4; ++ks) { const bf16x8 bfrag = *(const LAS bf16x8*)(wl + (16 * nt + fr) * SG_LDP + 32 * ks + 8 * fq);
                    acc = __builtin_amdgcn_mfma_f32_16x16x32_bf16(af[ks], bfrag, acc, 0, 0, 0); }
                const int p = 16 * nt + fr;
                const float bs = bsv[nt];
                LAS u32x2* gp = (LAS u32x2*)(gy + p * SG_LDP + 16 * F.wave + 4 * fq);
                const u32x2 gaw = *gp;
                u32x2 o; o.x = cvt_pk_bf16(bf_lo(gaw.x) * (acc[0] + bs), bf_hi(gaw.x) * (acc[1] + bs)); o.y = cvt_pk_bf16(bf_lo(gaw.y) * (acc[2] + bs), bf_hi(gaw.y) * (acc[3] + bs));
                *gp = o;
            }
        }
        lds_sync();
#pragma unroll
        for (int j = 0; j < 4; ++j) { const int p = rq + 32 * j; *(u32x4*)(YC + (m0 + p) * D + g * 128 + 8 * chunk) = *(const LAS u32x4*)(gy + p * SG_LDP + 8 * chunk); }
      }
    }
    __syncthreads();
}

struct AttnPtrs { const float* rpb; const bf16_t *Qb, *Kb, *VT, *ZB; bf16_t* YC; };
constexpr int AK_OFF = 0, AV_OFF = 73728, ATT_BIAS_OFF = 147456;
static_assert(ATT_BIAS_OFF + 15 * 32 * 4 <= LDSCTL_OFF, "attention LDS map");
static_assert(DEPTH == 2, "the LN phases chain exactly two DeepNorm stages");
__device__ __forceinline__ int kswz(int key) { return ((key >> 1) & 1) | (((key >> 3) & 3) << 1); }
__device__ __forceinline__ int rstart(int r) { return min(max(r - 4, 0), 120); }
__device__ __forceinline__ void attn_phase(const Frame& F, const AttnPtrs& P, int l) {
    const int fr = F.lane & 15, fq = F.lane >> 4, cb = F.wave & 3, rsel = F.wave >> 2;
    const int bs = min(max(16 * cb - 8, 0), 32);
    const int qcol = 16 * cb + fr;
    const int wst = min(max(qcol - 8, 0), 48);
    int ci[2][4];
#pragma unroll
    for (int X = 0; X < 2; ++X)
#pragma unroll
        for (int e = 0; e < 4; ++e) { const int kc = bs + 8 * fq + 4 * X + e; ci[X][e] = ((kc >= wst) && (kc < wst + 16)) ? min(max(kc - qcol + 15, 0), 30) : 31; }
    int koff[2][2];
#pragma unroll
    for (int X = 0; X < 2; ++X) { const int key = bs + 8 * (fr >> 2) + 4 * X + (fr & 3);
#pragma unroll
        for (int ks = 0; ks < 2; ++ks) koff[X][ks] = key * 128 + (((ks * 4 + fq) ^ kswz(key)) << 4); }
    const int voff = (((bs >> 3) + fq) * 64 + fr) * 16;
    const int kwr = (F.tid >> 3) * 128 + (((F.tid & 7) ^ kswz(F.tid >> 3)) << 4);
    const LAS float* rp = (const LAS float*)(F.lds + ATT_BIAS_OFF);
    for (int item = F.vcu; item < BATCH * NH * 8; item += F.G) {
        const int bh = item >> 3, r0 = 16 * (item & 7), b = bh >> 4, h = bh & 15;
        const size_t hb = (size_t)bh * T;
        const bf16_t* Kg = P.Kb + hb * 64 + F.tid * 8;
        const bf16_t* Vg = P.VT + hb * 64 + F.tid * 8;
        bf16_t* yb = P.YC + ((size_t)b * T + qcol) * D + DS + h * 64 + 4 * fq;
        __syncthreads();
        for (int i = F.tid; i < 15 * 32; i += 512) ((LAS float*)(F.lds + ATT_BIAS_OFF))[i] = (i & 31) == 31 ? -1.0e30f : P.rpb[((size_t)l * NH + h) * 15 * 31 + (i >> 5) * 31 + (i & 31)] * 1.4426950408889634f;
        { const int lo = rstart(r0), hi = rstart(r0 + 1) + 8;
            u32x4 kv[9], vv[9];
#pragma unroll
            for (int i = 0; i < 9; ++i) { const int kr = min(lo + i, T / 64 - 1); kv[i] = *(const u32x4*)(Kg + (size_t)kr * 4096); vv[i] = *(const u32x4*)(Vg + (size_t)kr * 4096); }
#pragma unroll
            for (int i = 0; i < 9; ++i) if (lo + i < hi) { const int slot = (lo + i) % 9;
                *(LAS u32x4*)(F.lds + AK_OFF + slot * 8192 + kwr) = kv[i]; *(LAS u32x4*)(F.lds + AV_OFF + slot * 8192 + F.tid * 16) = vv[i]; } }
        bf16x8 qf[2]; u32x2 zw[4];
        { const size_t tk = hb + (r0 + rsel) * 64 + qcol;
#pragma unroll
            for (int ks = 0; ks < 2; ++ks) qf[ks] = *(const bf16x8*)(P.Qb + tk * 64 + 32 * ks + 8 * fq);
#pragma unroll
            for (int d = 0; d < 4; ++d) zw[d] = *(const u32x2*)(P.ZB + tk * 64 + 16 * d + 4 * fq); }
        u32x2 yw[4];
        __syncthreads();
        for (int st = 0; st < 8; ++st) {
            const int ra = r0 + 2 * st, r = ra + rsel, rs = rstart(r);
            if (st > 0) {
#pragma unroll
                for (int d = 0; d < 4; ++d) *(u32x2*)(yb + (size_t)(r - 2) * 64 * D + 16 * d) = yw[d]; }
            const int nlo = rstart(ra + 1) + 8, nhi = (st < 7) ? rstart(ra + 3) + 7 : -1;
            const int kr0 = min(nlo, T / 64 - 1), kr1 = min(nlo + 1, T / 64 - 1);
            const u32x4 pk0 = *(const u32x4*)(Kg + (size_t)kr0 * 4096), pv0 = *(const u32x4*)(Vg + (size_t)kr0 * 4096);
            const u32x4 pk1 = *(const u32x4*)(Kg + (size_t)kr1 * 4096), pv1 = *(const u32x4*)(Vg + (size_t)kr1 * 4096);
            const size_t tkn = hb + min(r + 2, T / 64 - 1) * 64 + qcol;
            bf16x8 qn[2]; u32x2 zn[4];
#pragma unroll
            for (int ks = 0; ks < 2; ++ks) qn[ks] = *(const bf16x8*)(P.Qb + tkn * 64 + 32 * ks + 8 * fq);
#pragma unroll
            for (int d = 0; d < 4; ++d) zn[d] = *(const u32x2*)(P.ZB + tkn * 64 + 16 * d + 4 * fq);
            float s[8][2][4];
            float mx = -3.0e38f;
#pragma unroll
            for (int i = 0; i < 8; ++i) {
                const LAS float* rpi = rp + (rs + i - r + 7) * 32;
                const LAS unsigned char* kb = F.lds + AK_OFF + ((rs + i) % 9) * 8192;
#pragma unroll
                for (int X = 0; X < 2; ++X) {
                    f32x4 c = {rpi[ci[X][0]], rpi[ci[X][1]], rpi[ci[X][2]], rpi[ci[X][3]]};
#pragma unroll
                    for (int ks = 0; ks < 2; ++ks) c = __builtin_amdgcn_mfma_f32_16x16x32_bf16(*(const LAS bf16x8*)(kb + koff[X][ks]), qf[ks], c, 0, 0, 0);
                    s[i][X][0] = c[0]; s[i][X][1] = c[1]; s[i][X][2] = c[2]; s[i][X][3] = c[3];
                    mx = fmaxf(fmaxf(mx, c[0]), c[1]); mx = fmaxf(fmaxf(mx, c[2]), c[3]);
                }
            }
            mx = fmaxf(mx, __shfl_xor(mx, 16)); mx = fmaxf(mx, __shfl_xor(mx, 32));
#pragma unroll
            for (int i = 0; i < 8; ++i)
#pragma unroll
                for (int X = 0; X < 2; ++X)
#pragma unroll
                    for (int e = 0; e < 4; ++e) s[i][X][e] = __builtin_amdgcn_exp2f(s[i][X][e] - mx);
            f32x4 o[4], osum = {0.f, 0.f, 0.f, 0.f};
#pragma unroll
            for (int d = 0; d < 4; ++d) o[d] = (f32x4){0.f, 0.f, 0.f, 0.f};
            const bf16x8 ones = {0x3F80, 0x3F80, 0x3F80, 0x3F80, 0x3F80, 0x3F80, 0x3F80, 0x3F80};
#pragma unroll
            for (int i = 0; i < 8; ++i) {
                union { u32x4 u; bf16x8 v; } pb;
                pb.u.x = cvt_pk_bf16(s[i][0][0], s[i][0][1]); pb.u.y = cvt_pk_bf16(s[i][0][2], s[i][0][3]); pb.u.z = cvt_pk_bf16(s[i][1][0], s[i][1][1]); pb.u.w = cvt_pk_bf16(s[i][1][2], s[i][1][3]);
                const LAS unsigned char* vb = F.lds + AV_OFF + ((rs + i) % 9) * 8192 + voff;
#pragma unroll
                for (int d = 0; d < 4; ++d) o[d] = __builtin_amdgcn_mfma_f32_16x16x32_bf16(*(const LAS bf16x8*)(vb + d * 256), pb.v, o[d], 0, 0, 0);
                osum = __builtin_amdgcn_mfma_f32_16x16x32_bf16(ones, pb.v, osum, 0, 0, 0);
            }
            const float sum = osum[0];
            const float inv = 1.0f / sum;
#pragma unroll
            for (int d = 0; d < 4; ++d) {
                yw[d].x = cvt_pk_bf16(o[d][0] * inv * bf_lo(zw[d].x), o[d][1] * inv * bf_hi(zw[d].x)); yw[d].y = cvt_pk_bf16(o[d][2] * inv * bf_lo(zw[d].y), o[d][3] * inv * bf_hi(zw[d].y)); }
            __syncthreads();
            if (nlo <= nhi) { const int slot = nlo % 9; *(LAS u32x4*)(F.lds + AK_OFF + slot * 8192 + kwr) = pk0; *(LAS u32x4*)(F.lds + AV_OFF + slot * 8192 + F.tid * 16) = pv0; }
            if (nlo + 1 <= nhi) { const int slot = (nlo + 1) % 9; *(LAS u32x4*)(F.lds + AK_OFF + slot * 8192 + kwr) = pk1; *(LAS u32x4*)(F.lds + AV_OFF + slot * 8192 + F.tid * 16) = pv1; }
            __syncthreads();
            qf[0] = qn[0]; qf[1] = qn[1];
#pragma unroll
            for (int d = 0; d < 4; ++d) zw[d] = zn[d];
        }
#pragma unroll
        for (int d = 0; d < 4; ++d) *(u32x2*)(yb + (size_t)(r0 + 14 + rsel) * 64 * D + 16 * d) = yw[d];
    }
    __syncthreads();
}

struct Args { const float* in[13]; float* out; unsigned char* ws; int ph_lo, ph_hi; };
constexpr int N_PHASES = 2 + 4 * DEPTH;

typedef const __attribute__((address_space(4))) Args* ArgsP;
__device__ __forceinline__ ArgsP fresh_args() { ArgsP p = (ArgsP)__builtin_amdgcn_kernarg_segment_ptr(); asm volatile("" : "+s"(p)); return p; }
#ifndef MK_MASK
#define MK_MASK 63
#endif
#ifndef MK_REP
#define MK_REP 0
#endif
__global__ void __launch_bounds__(512, 2) mk_fwd(Args args) {
    extern __shared__ __attribute__((aligned(16))) unsigned char lds[];
    { LAS unsigned* z = (LAS unsigned*)((LAS unsigned char*)lds + LDSCTL_OFF); for (int u = threadIdx.x; u < (LDS_BYTES - LDSCTL_OFF) / 4; u += 512) z[u] = 0u; }
    __syncthreads();
    const int lo = args.ph_lo, hi = args.ph_hi;
    const unsigned half_ = ((blockIdx.x & 7u) >> 2) & 1u;
    XcdBarrier bar, barh; bar.bar = (unsigned*)(args.ws + WS_CTL) + CW_BAR; bar.x = 0; bar.st = nullptr; bar.expect = gridDim.x; barh = bar;
    if (hi - lo > 1) {
        bar = xcd_barrier_post((unsigned*)(args.ws + WS_CTL) + CW_BAR, (volatile LAS unsigned*)((LAS unsigned char*)lds + MISC_OFF) + 8, gridDim.x);
        barh = xcd_barrier_post((unsigned*)(args.ws + WS_CTL) + CW_BAR + (1 + half_) * XCD_BAR_WORDS, (volatile LAS unsigned*)((LAS unsigned char*)lds + MISC_OFF) + 10, gridDim.x / 2);
    }
    const bool split_ok = (gridDim.x % 16) == 0;

    for (int ph = lo; ph < hi; ++ph) {
      const int kind_ = ph == 0 ? 1 : (ph == 1 ? 2 : (((ph - 2) & 3) == 0 ? 4 : (((ph - 2) & 3) == 1 ? 64 : (((ph - 2) & 3) == 2 ? 32 : 2))));
      const int nrep_ = (MK_REP & kind_) ? 2 : 1;
      for (int rep_ = 0; rep_ < nrep_; ++rep_) {
        ArgsP ap = fresh_args();
        unsigned char* ws = ap->ws;
        int tid_ = threadIdx.x, bx = blockIdx.x, G_ = gridDim.x;
        asm volatile("" : "+v"(tid_)); asm volatile("" : "+s"(bx), "+s"(G_));
        Frame F; F.lds = (LAS unsigned char*)lds; F.tid = tid_; F.lane = tid_ & 63; F.wave = __builtin_amdgcn_readfirstlane(tid_ >> 6);
        F.G = G_; F.vcu = (G_ % 8 == 0) ? (bx % 8) * (G_ / 8) + bx / 8 : bx;
        if (ph == 0) {
            if (MK_MASK & 1) p0_prologue(F, ap->in[1], ap->in[2], ap->in[3], ap->in[4], ap->in[10], ap->in[7], (float*)(ws + WS_MOD), (bf16_t*)(ws + WS_WIN), (bf16_t*)(ws + WS_WOUT), (bf16_t*)(ws + WS_WSB));
        } else if (ph == 1) {
            if (split_ok && half_ == 1u) {
                __syncthreads();
                p0_weights(F, ap->in[4], ap->in[10], (bf16_t*)(ws + WS_WIN), (bf16_t*)(ws + WS_WOUT), 1, (F.vcu - F.G / 2) * 8 + F.wave, (F.G / 2) * 8);
                __syncthreads();
            } else if (!split_ok) { __syncthreads(); p0_weights(F, ap->in[4], ap->in[10], (bf16_t*)(ws + WS_WIN), (bf16_t*)(ws + WS_WOUT), 1, F.vcu * 8 + F.wave, F.G * 8); __syncthreads(); }
            if (MK_MASK & 2) ln_phase(F, ap->in[0], LnStage{nullptr, nullptr, nullptr}, LnStage{nullptr, nullptr, nullptr}, nullptr, true, (const float*)(ws + WS_MOD), (bf16_t*)(ws + WS_H));
        } else {
            const int l = (ph - 2) >> 2, k = (ph - 2) & 3;
            if (k == 0) { if (MK_MASK & 4) {
                const bf16_t* H = (const bf16_t*)(ws + WS_H); const bf16_t* W = (const bf16_t*)(ws + WS_WIN) + (size_t)l * DIN * D;
                pg8::Gemm g{H, W, W + (size_t)5120 * D, H, D};
                pg8::ProjOrder S; S.init(F.G, bx);
                pg8::EpiProj E{(bf16_t*)(ws + WS_GA), (bf16_t*)(ws + WS_VG), (bf16_t*)(ws + WS_Q), (bf16_t*)(ws + WS_VT)};
                pg8::gemm_phase<pg8::EpiProj, pg8::ProjOrder>(F.lds, F.tid, g, S, E); }
            } else if (k == 1) {
                for (int q_ = 0; q_ < ((MK_REP & 8) ? 2 : 1); ++q_) if (MK_MASK & 8) sgu_phase(F, l, ap->in[5], ap->in[6], ap->in[8], (const bf16_t*)(ws + WS_WSB), (const bf16_t*)(ws + WS_VG), (const bf16_t*)(ws + WS_GA), (bf16_t*)(ws + WS_H));
                for (int q_ = 0; q_ < ((MK_REP & 16) ? 2 : 1); ++q_) if (MK_MASK & 16) { const AttnPtrs P{ap->in[9], (const bf16_t*)(ws + WS_Q), (const bf16_t*)(ws + WS_K), (const bf16_t*)(ws + WS_VT), (const bf16_t*)(ws + WS_ZB), (bf16_t*)(ws + WS_H)};
                    attn_phase(F, P, l); }
            } else if (k == 2) { if (MK_MASK & 32) {
                pg8::Gemm g{(const bf16_t*)(ws + WS_H), (const bf16_t*)(ws + WS_WOUT) + (size_t)l * D * D, nullptr, nullptr, D};
                pg8::StaticOrder S; S.init(M, D, F.G, bx);
                LAS float* g1 = (LAS float*)(F.lds + pg8::STAGE_BYTES);
                { const float* gsrc = (const float*)(ws + WS_MOD) + (size_t)l * BATCH * NMOD + 2 * D;
                  for (int i = F.tid; i < BATCH * D / 4; i += 512) { const int b = i / (D / 4), c4 = i % (D / 4); *(LAS f32x4*)(g1 + b * D + c4 * 4) = *(const f32x4*)(gsrc + (size_t)b * NMOD + c4 * 4) + 1.0f; }
                  __syncthreads(); }
                pg8::EpiOut E{g1, (bf16_t*)(ws + (l == 0 ? WS_Y0 : WS_Y))};
                pg8::gemm_phase<pg8::EpiOut, pg8::StaticOrder>(F.lds, F.tid, g, S, E); }
            } else {
                const LnStage s0{(const bf16_t*)(ws + WS_Y0), ap->in[11], ap->in[12]};
                if (l == 0) { if (MK_MASK & 2) ln_phase(F, ap->in[0], s0, LnStage{nullptr, nullptr, nullptr}, nullptr, true, (const float*)(ws + WS_MOD) + (size_t)BATCH * NMOD, (bf16_t*)(ws + WS_H)); }
                else { const LnStage s1{(const bf16_t*)(ws + WS_Y), ap->in[11] + D, ap->in[12] + D};
                    if (MK_MASK & 2) ln_phase(F, ap->in[0], s0, s1, ap->out, false, nullptr, nullptr); }
            }
        }
        if (ph + 1 < hi || rep_ + 1 < nrep_) {
            if (ph == 0 || !split_ok) xcd_barrier(bar);
            else {
                if (ph == 5 && half_ == 0u && threadIdx.x == 0) {
                    unsigned* hc = (unsigned*)(ws + WS_CTL) + CW_HANDOFF; unsigned sp = 0;
                    while (xb_ld(hc) < gridDim.x / 2) { __builtin_amdgcn_s_sleep(2); if (++sp > (1u << 22)) break; }
                }
                xcd_barrier(barh);
                if (ph == 1 && half_ == 1u && threadIdx.x == 0 && rep_ == 0) xb_add((unsigned*)(ws + WS_CTL) + CW_HANDOFF, 1u);
            }
        }
      }
    }
}

extern "C" void kernel_launch(void* const* d_in, const int* in_sizes, int n_in, void* d_out, int out_size, void* d_ws, size_t ws_size, hipStream_t stream) {
    static int grid = 0;
    if (grid == 0) {
        if (n_in != 13 || out_size != M * D || ws_size < WS_END) { fprintf(stderr, "kernel_launch: unexpected shapes (n_in %d, out %d, ws %zu)\n", n_in, out_size, ws_size); grid = -1; return; }
        int dev = 0, cus = 0, per_cu = 0;
        if (hipGetDevice(&dev) != hipSuccess || hipDeviceGetAttribute(&cus, hipDeviceAttributeMultiprocessorCount, dev) != hipSuccess) { grid = -1; return; }
        if (hipFuncSetAttribute((const void*)mk_fwd, hipFuncAttributeMaxDynamicSharedMemorySize, LDS_BYTES) != hipSuccess) { fprintf(stderr, "kernel_launch: hipFuncSetAttribute failed\n"); grid = -1; return; }
        if (hipOccupancyMaxActiveBlocksPerMultiprocessor(&per_cu, (const void*)mk_fwd, 512, LDS_BYTES) != hipSuccess || per_cu < 1) { fprintf(stderr, "kernel_launch: occupancy query reports %d blocks per CU\n", per_cu); per_cu = 1; }
        (void)hipGetLastError();
        grid = cus;
    }
    if (grid < 0) return;
    (void)hipMemsetAsync((char*)d_ws + WS_CTL, 0, CTL_ZERO_BYTES, stream);
    Args a{};
    for (int i = 0; i < 13; ++i) a.in[i] = (const float*)d_in[i];
    a.out = (float*)d_out; a.ws = (unsigned char*)d_ws;
    if (MK_N_LAUNCHES == 1) { a.ph_lo = 0; a.ph_hi = N_PHASES; hipLaunchKernelGGL(mk_fwd, dim3(grid), dim3(512), LDS_BYTES, stream, a); }
    else { for (int p = 0; p < N_PHASES; ++p) { a.ph_lo = p; a.ph_hi = p + 1; hipLaunchKernelGGL(mk_fwd, dim3(grid), dim3(512), LDS_BYTES, stream, a); } }
}
```

```cpp
#include <hip/hip_runtime.h>
#include <cstdio>
#include <cstdint>

#ifndef MK_N_LAUNCHES
#define MK_N_LAUNCHES 1
#endif

#define LAS __attribute__((address_space(3)))
#define GAS __attribute__((address_space(1)))
typedef unsigned short bf16_t;
typedef short bf16x8 __attribute__((ext_vector_type(8)));
typedef float f32x4 __attribute__((ext_vector_type(4)));
typedef float f32x2 __attribute__((ext_vector_type(2)));
typedef unsigned u32x4 __attribute__((ext_vector_type(4)));
typedef unsigned u32x2 __attribute__((ext_vector_type(2)));

constexpr int BATCH = 2, T = 8192, D = 2048, M = BATCH * T, DIN = 7168, DS = 1024, NG = 8, NH = 16, DEPTH = 2;
constexpr int NMOD = 3 * D;
constexpr float LN_EPS = 1e-5f;
constexpr float DN_ALPHA = 1.4142135623730951f;

typedef __bf16 bf16v2 __attribute__((ext_vector_type(2)));
__device__ __forceinline__ unsigned cvt_pk_bf16(float lo, float hi) { const f32x2 v = {lo, hi}; const bf16v2 r = __builtin_convertvector(v, bf16v2); return __builtin_bit_cast(unsigned, r); }
__device__ __forceinline__ float bf_lo(unsigned w) { return __builtin_bit_cast(float, w << 16); }
__device__ __forceinline__ float bf_hi(unsigned w) { return __builtin_bit_cast(float, w & 0xffff0000u); }
__device__ __forceinline__ float silu_f(float x) { return x * __builtin_amdgcn_rcpf(1.0f + __builtin_amdgcn_exp2f(-1.4426950408889634f * x)); }
__device__ __forceinline__ f32x2 gelu_pk(f32x2 v) {
    f32x2 c; c.x = __builtin_amdgcn_fmed3f(v.x, -4.0f, 4.0f); c.y = __builtin_amdgcn_fmed3f(v.y, -4.0f, 4.0f);
    const f32x2 s = c * c;
    f32x2 r = s * 7.0374646370e-11f + (-6.2872893160e-09f);
    r = r * s + 2.5093203053e-07f; r = r * s + (-5.9760889818e-06f); r = r * s + 9.6085055597e-05f; r = r * s + (-1.1195942566e-03f);
    r = r * s + 9.8383713455e-03f; r = r * s + (-6.6361911043e-02f); r = r * s + 3.9890514886e-01f;
    return v * (c * r + 0.5f);
}
__device__ __forceinline__ f32x4 gelu4(f32x4 v) { f32x2 a = gelu_pk((f32x2){v[0], v[1]}), b = gelu_pk((f32x2){v[2], v[3]}); return (f32x4){a.x, a.y, b.x, b.y}; }
__device__ __forceinline__ f32x2 silu_pk(f32x2 v) { const f32x2 a = v * (-1.4426950408889634f); f32x2 e; e.x = __builtin_amdgcn_exp2f(a.x); e.y = __builtin_amdgcn_exp2f(a.y);
    const f32x2 d = e + 1.0f; f32x2 r; r.x = __builtin_amdgcn_rcpf(d.x); r.y = __builtin_amdgcn_rcpf(d.y); return v * r; }
__device__ __forceinline__ f32x4 silu4(f32x4 v) { const f32x2 a = silu_pk((f32x2){v[0], v[1]}), b = silu_pk((f32x2){v[2], v[3]}); return (f32x4){a.x, a.y, b.x, b.y}; }
#ifndef MK_REP
#define MK_REP 0
#endif
__device__ __forceinline__ void store8(bf16_t* p, f32x4 a, f32x4 b) { u32x4 w; w.x = cvt_pk_bf16(a[0], a[1]); w.y = cvt_pk_bf16(a[2], a[3]); w.z = cvt_pk_bf16(b[0], b[1]); w.w = cvt_pk_bf16(b[2], b[3]); *(u32x4*)p = w;
    if (MK_REP & 128) { asm volatile("" ::: "memory"); *(u32x4*)p = w; asm volatile("" ::: "memory"); } }

namespace pg8 {
constexpr int BM = 256, BK = 64, HALF = 128, HTB = HALF * BK * 2, STAGE_BYTES = 8 * HTB, NXCD = 8, WGM = 2;
__host__ __device__ __forceinline__ int lds_byte(int r, int c) { const int st = (r >> 4) * 2 + (c >> 5), rr = r & 15, cc = c & 31, ob = rr * 64 + cc * 2; return st * 1024 + (ob ^ (((ob >> 9) & 1) << 5)); }
__host__ __device__ __forceinline__ void stage_rc(int b, int& R, int& C) { const int st = b / 1024, sb = b % 1024, swz = sb ^ (((sb >> 9) & 1) << 5); R = (st >> 1) * 16 + swz / 64; C = (st & 1) * 32 + (swz % 64) / 2; }
__host__ __device__ __forceinline__ int perm32(int rho) { const int n = rho >> 4, i = rho & 15; return 8 * (i >> 2) + 4 * n + (i & 3); }

struct Unit { int pm, pn, kind; };
struct Gemm { const bf16_t* A0; const bf16_t* B0; const bf16_t* A1; const bf16_t* B1; int K; };

struct StaticOrder {
    int nM, nN, nwg, G, c;
    __device__ void init(int M_, int N_, int G_, int c_) { nM = M_ / BM; nN = N_ / BM; nwg = nM * nN; G = G_; c = c_; }
    __device__ __forceinline__ void map(int wgid, Unit& u) const {
        { const int q = nwg / NXCD, r = nwg % NXCD, xcd = wgid % NXCD, off = wgid / NXCD; wgid = (xcd < r ? xcd * (q + 1) : r * (q + 1) + (xcd - r) * q) + off; }
        const int nig = WGM * nN, gid = wgid / nig, fm = gid * WGM, gsz = (nM - fm) < WGM ? (nM - fm) : WGM;
        u.pm = fm + ((wgid % nig) % gsz); u.pn = (wgid % nig) / gsz; u.kind = 0;
    }
    __device__ __forceinline__ bool next(int i, Unit& u) const { const long L = (long)i * G + c; if (L >= nwg) return false; map((int)L, u); return true; }
};
struct ProjOrder {
    StaticOrder S; int nswap;
    __device__ void init(int G_, int c_) { S.init(M, 5120, G_, c_); nswap = 512; }
    __device__ __forceinline__ bool next(int i, Unit& u) const {
        const long L = (long)i * S.G + S.c;
        if (L < S.nwg) { S.map((int)L, u); return true; }
        const int idx = (int)(L - S.nwg); if (idx >= nswap) return false;
        const int x = idx % 8, t = idx / 8, rnd = t >> 5, j = t & 31;
        u.pm = (j + 4 * rnd) & 7; u.pn = 8 * x + 4 * rnd + (j >> 3); u.kind = 1; return true;
    }
};

struct EpiProj {
    static constexpr bool PERM = true;
    bf16_t *GA, *VGT, *Qb, *VT;
    __device__ __forceinline__ void operator()(const f32x4 (&acc)[2][2][4][2], const Unit& u, int wr, int wc, int fr, int fq) const {
        const int rl = wr * 64 + fr, cl = wc * 32 + 8 * fq;
        if (u.kind == 1) {
            const int tok0 = u.pn * 256 + cl;
            if (u.pm < 4) {
#pragma unroll
                for (int ai = 0; ai < 2; ++ai)
#pragma unroll
                    for (int m = 0; m < 4; ++m) { const int ch = u.pm * 256 + rl + ai * HALF + m * 16;
#pragma unroll
                        for (int bj = 0; bj < 2; ++bj) { const int tk = tok0 + bj * HALF;
                            store8(VGT + ((size_t)(tk >> 7) * DS + ch) * 128 + (tk & 127), gelu4(acc[ai][bj][m][0]), gelu4(acc[ai][bj][m][1])); } }
            } else {
                const int bb = tok0 >> 13;
#pragma unroll
                for (int ai = 0; ai < 2; ++ai)
#pragma unroll
                    for (int m = 0; m < 4; ++m) { const int ch = (u.pm - 4) * 256 + rl + ai * HALF + m * 16;
                        bf16_t* rowp = VT + ((size_t)(bb * NH + (ch >> 6)) * (T / 8) * 64 + (ch & 63)) * 8;
#pragma unroll
                        for (int bj = 0; bj < 2; ++bj) store8(rowp + (size_t)(((tok0 + bj * HALF) & (T - 1)) >> 3) * 512, acc[ai][bj][m][0], acc[ai][bj][m][1]); }
            }
        } else if (u.pn < 8) {
            bf16_t* base = GA + (size_t)(u.pm * 256 + rl) * DS + u.pn * 128 + cl;
#pragma unroll
            for (int ai = 0; ai < 2; ++ai)
#pragma unroll
                for (int m = 0; m < 4; ++m) {
                    const f32x4 r0 = gelu4(acc[ai][0][m][0]) * silu4(acc[ai][1][m][0]), r1 = gelu4(acc[ai][0][m][1]) * silu4(acc[ai][1][m][1]);
                    store8(base + (size_t)(ai * HALF + m * 16) * DS, r0, r1); }
        } else {
            const int t = (u.pn - 8) >> 2, colt = ((u.pn - 8) & 3) * 256;
            bf16_t* out = Qb + (size_t)t * ((size_t)M * DS);
            const int row0 = u.pm * 256 + rl;
            const int bb = row0 >> 13, t0 = row0 & (T - 1);
#define EPI_QKZ(XFORM) _Pragma("unroll") for (int bj = 0; bj < 2; ++bj) { const int col = colt + bj * HALF + cl; \
                bf16_t* base = out + ((size_t)(bb * NH + (col >> 6)) * T + t0) * 64 + (col & 63); \
                _Pragma("unroll") for (int ai = 0; ai < 2; ++ai) _Pragma("unroll") for (int m = 0; m < 4; ++m) { f32x4 v0 = acc[ai][bj][m][0], v1 = acc[ai][bj][m][1]; XFORM; \
                        store8(base + (size_t)(ai * HALF + m * 16) * 64, v0, v1); } }
            if (t == 0) { EPI_QKZ(v0 = v0 * 0.18033688011112042f; v1 = v1 * 0.18033688011112042f) }
            else if (t == 2) { EPI_QKZ(v0 = silu4(v0); v1 = silu4(v1)) }
            else { EPI_QKZ((void)0) }
#undef EPI_QKZ
        }
    }
};
struct EpiOut {
    static constexpr bool PERM = true;
    const LAS float* gate1; bf16_t* Y;
    __device__ __forceinline__ void operator()(const f32x4 (&acc)[2][2][4][2], const Unit& u, int wr, int wc, int fr, int fq) const {
        const int row0 = u.pm * BM + wr * 64 + fr, col0 = u.pn * BM + wc * 32 + 8 * fq;
        const LAS float* gp = gate1 + (u.pm >= (T / BM) ? D : 0) + col0;
        f32x4 g4[2][2];
#pragma unroll
        for (int bj = 0; bj < 2; ++bj)
#pragma unroll
            for (int n = 0; n < 2; ++n) g4[bj][n] = *(const LAS f32x4*)(gp + bj * HALF + n * 4);
#pragma unroll
        for (int ai = 0; ai < 2; ++ai)
#pragma unroll
            for (int m = 0; m < 4; ++m) { bf16_t* rowp = Y + (size_t)(row0 + ai * HALF + m * 16) * D + col0;
#pragma unroll
                for (int bj = 0; bj < 2; ++bj) store8(rowp + bj * HALF, g4[bj][0] * acc[ai][bj][m][0], g4[bj][1] * acc[ai][bj][m][1]); }
    }
};

template <class Epi, class Sched>
__device__ __forceinline__ void gemm_phase(LAS unsigned char* lds, const int tid, const Gemm g, const Sched& S, const Epi& E) {
    const int wid = __builtin_amdgcn_readfirstlane(tid >> 6), lane = tid & 63, wr = wid >> 2, wc = wid & 3, fr = lane & 15, fq = lane >> 4;
    const int K = g.K, nt = K / BK;
    unsigned voffA[2], voffB[2];
#pragma unroll
    for (int i = 0; i < 2; ++i) { int R, C; stage_rc(tid * 16 + i * 8192, R, C); const int Rb = Epi::PERM ? ((R & ~31) + perm32(R & 31)) : R;
        voffA[i] = (unsigned)(R * K + C) * 2u; voffB[i] = (unsigned)(Rb * K + C) * 2u; }
    const size_t kstep = (size_t)(BK * 2);
    const size_t hstep = (size_t)HALF * K * 2;
    const size_t tstep = 2 * hstep;
    const unsigned ldsw = (unsigned)wid * 1024u;
    const int aoff = lds_byte(wr * 64 + fr, fq * 8), boff = lds_byte(wc * 32 + fr, fq * 8);
#define PG8_SA(b, h) (((b) * 2 + (h)) * HTB)
#define PG8_SB(b, h) ((4 + (b) * 2 + (h)) * HTB)
#define PG8_STAGE(bufoff, gbase, voff) do { _Pragma("unroll") for (int _i = 0; _i < 2; ++_i) \
        __builtin_amdgcn_global_load_lds((const unsigned*)((const char*)(gbase) + (voff)[_i]), (LAS unsigned*)(lds + (bufoff) + ldsw + _i * 8192), 16, 0, 0); } while (0)
#define PG8_LDA(dst, b, h) do { _Pragma("unroll") for (int m = 0; m < 4; ++m) _Pragma("unroll") for (int k = 0; k < 2; ++k) dst[m][k] = *(const LAS bf16x8*)(lds + PG8_SA(b, h) + aoff + m * 2048 + k * 1024); } while (0)
#define PG8_LDB(dst, b, h) do { _Pragma("unroll") for (int n = 0; n < 2; ++n) _Pragma("unroll") for (int k = 0; k < 2; ++k) dst[n][k] = *(const LAS bf16x8*)(lds + PG8_SB(b, h) + boff + n * 2048 + k * 1024); } while (0)
#define PG8_MMA(ai, bj, At, Bt) do { __builtin_amdgcn_sched_barrier(0); _Pragma("unroll") for (int m = 0; m < 4; ++m) _Pragma("unroll") for (int n = 0; n < 2; ++n) _Pragma("unroll") for (int k = 0; k < 2; ++k) \
        acc[ai][bj][m][n] = __builtin_amdgcn_mfma_f32_16x16x32_bf16(Bt[n][k], At[m][k], acc[ai][bj][m][n], 0, 0, 0); __builtin_amdgcn_sched_barrier(0); } while (0)
#define PG8_WAIT_V(n) asm volatile("s_waitcnt vmcnt(" #n ")" ::: "memory")
#define PG8_WAIT_L(n) asm volatile("s_waitcnt lgkmcnt(" #n ")" ::: "memory")
#define PG8_BAR __builtin_amdgcn_s_barrier()
#define PG8_SCHED __builtin_amdgcn_sched_barrier(0)
#define PG8_UA(u) ((const char*)((u).kind ? g.A1 : g.A0) + (size_t)(u).pm * tstep)
#define PG8_UB(u) ((const char*)((u).kind ? g.B1 : g.B0) + (size_t)(u).pn * tstep)
    Unit cur, nxt; int ui = 0;
    if (!S.next(0, cur)) return;
    f32x4 acc[2][2][4][2];
#pragma unroll
    for (int a = 0; a < 2; ++a)
#pragma unroll
        for (int b = 0; b < 2; ++b)
#pragma unroll
            for (int m = 0; m < 4; ++m)
#pragma unroll
                for (int n = 0; n < 2; ++n) acc[a][b][m][n] = (f32x4){0.f, 0.f, 0.f, 0.f};
    bf16x8 At[4][2], B0[2][2], B1[2][2];
    const char* cA = PG8_UA(cur); const char* cB = PG8_UB(cur);
    PG8_STAGE(PG8_SB(0, 0), cB, voffB); PG8_STAGE(PG8_SB(0, 1), cB + hstep, voffB); PG8_STAGE(PG8_SA(0, 0), cA, voffA); PG8_STAGE(PG8_SA(0, 1), cA + hstep, voffA);
    if (wr == 1) PG8_BAR;
    PG8_WAIT_V(2); PG8_BAR;
    PG8_STAGE(PG8_SB(1, 0), cB + kstep, voffB); PG8_STAGE(PG8_SA(1, 0), cA + kstep, voffA); PG8_STAGE(PG8_SB(1, 1), cB + hstep + kstep, voffB);
    PG8_WAIT_V(6); PG8_BAR;
    for (;;) {
        const bool has_next = S.next(ui + 1, nxt);
        const char* nA = has_next ? PG8_UA(nxt) : cA; const char* nB = has_next ? PG8_UB(nxt) : cB;
        for (int t = 0; t < nt; t += 2) {
            const bool last = (t == nt - 2);
            const char* a1 = cA + (size_t)(t + 1) * kstep;
            const char* a2 = last ? nA : cA + (size_t)(t + 2) * kstep; const char* b2 = last ? nB : cB + (size_t)(t + 2) * kstep;
            const char* a3 = a2 + kstep; const char* b3 = b2 + kstep;
            PG8_LDB(B0, 0, 0); PG8_LDB(B1, 0, 1); PG8_SCHED; PG8_LDA(At, 0, 0); PG8_STAGE(PG8_SA(1, 1), a1 + hstep, voffA);
            PG8_WAIT_V(8); PG8_WAIT_L(0); PG8_BAR; PG8_MMA(0, 0, At, B0); PG8_MMA(0, 1, At, B1); PG8_BAR; PG8_SCHED;
            PG8_LDA(At, 0, 1); PG8_STAGE(PG8_SB(0, 0), b2, voffB); PG8_STAGE(PG8_SB(0, 1), b2 + hstep, voffB); PG8_STAGE(PG8_SA(0, 0), a2, voffA);
            PG8_WAIT_V(8); PG8_WAIT_L(0); PG8_BAR; PG8_MMA(1, 0, At, B0); PG8_MMA(1, 1, At, B1); PG8_BAR; PG8_SCHED;
            PG8_LDB(B0, 1, 0); PG8_LDB(B1, 1, 1); PG8_SCHED; PG8_LDA(At, 1, 0); PG8_STAGE(PG8_SA(0, 1), a2 + hstep, voffA);
            PG8_WAIT_V(8); PG8_WAIT_L(0); PG8_BAR; PG8_MMA(0, 0, At, B0); PG8_MMA(0, 1, At, B1); PG8_BAR; PG8_SCHED;
            PG8_LDA(At, 1, 1); PG8_STAGE(PG8_SB(1, 0), b3, voffB); PG8_STAGE(PG8_SB(1, 1), b3 + hstep, voffB); PG8_STAGE(PG8_SA(1, 0), a3, voffA);
            PG8_WAIT_V(8); PG8_WAIT_L(0); PG8_BAR; PG8_MMA(1, 0, At, B0); PG8_MMA(1, 1, At, B1); PG8_BAR; PG8_SCHED;
        }
        if (wr == 0) PG8_BAR;
        E(acc, cur, wr, wc, fr, fq);
        if (!has_next) break;
#pragma unroll
        for (int a = 0; a < 2; ++a)
#pragma unroll
            for (int b = 0; b < 2; ++b)
#pragma unroll
                for (int m = 0; m < 4; ++m)
#pragma unroll
                    for (int n = 0; n < 2; ++n) acc[a][b][m][n] = (f32x4){0.f, 0.f, 0.f, 0.f};
        cur = nxt; cA = nA; cB = nB; ++ui;
        if (wr == 1) PG8_BAR;
    }
    PG8_WAIT_V(0);
    PG8_BAR;
#undef PG8_SA
#undef PG8_SB
#undef PG8_STAGE
#undef PG8_LDA
#undef PG8_LDB
#undef PG8_MMA
#undef PG8_WAIT_V
#undef PG8_WAIT_L
#undef PG8_BAR
#undef PG8_SCHED
#undef PG8_UA
#undef PG8_UB
}
}

constexpr size_t MiB = 1u << 20;
constexpr size_t WS_CTL = 0, CTL_ZERO_BYTES = 64 * 1024;
constexpr size_t WS_MOD = 1 * MiB;
constexpr size_t WS_WSB = 1 * MiB + 512 * 1024;
constexpr size_t WS_WIN = 2 * MiB;
constexpr size_t WS_WOUT = 58 * MiB;
constexpr size_t WS_H = 80 * MiB;
constexpr size_t WS_GA = 144 * MiB, WS_VG = 176 * MiB, WS_Q = 208 * MiB, WS_K = 240 * MiB, WS_ZB = 272 * MiB, WS_VT = 304 * MiB;
constexpr size_t WS_Y = 144 * MiB;
constexpr size_t WS_Y0 = 336 * MiB;
constexpr size_t WS_END = 400 * MiB;
static_assert(WS_K - WS_Q == (size_t)M * DS * 2 && WS_ZB - WS_K == (size_t)M * DS * 2, "EpiProj indexes Q|K|ZB as one array");
static_assert((4096 + 3 * 3456) * 4 <= 64 * 1024, "control words inside the memset region");
constexpr int CW_BAR = 4096, CW_HANDOFF = 64;

constexpr int RING_BYTES = 131072, LDS_BYTES = 163840, LDSCTL_OFF = LDS_BYTES - 1024, MISC_OFF = LDSCTL_OFF + 320;

typedef GAS unsigned gu32;
#define RLX_AGENT __ATOMIC_RELAXED, __HIP_MEMORY_SCOPE_AGENT
#define LDS_WAIT() asm volatile("s_waitcnt lgkmcnt(0)" ::: "memory")

#define XB_TMO      128
#define XB_XCNT(j)  (256  + 64 * (j))
#define XB_XSUB(j)  (1280 + 64 * (j))
#define XB_XGEN(j)  (2304 + 64 * (j))
#define XB_TOP      3328
#define XB_TOPGEN   3392
#define XCD_BAR_WORDS 3456
#define XB_SPIN_CAP (1u << 18)
__device__ __forceinline__ unsigned xb_ld(unsigned* p)              { return __hip_atomic_load(p, __ATOMIC_RELAXED, __HIP_MEMORY_SCOPE_AGENT); }
__device__ __forceinline__ unsigned xb_add(unsigned* p, unsigned v) { return __hip_atomic_fetch_add(p, v, __ATOMIC_RELAXED, __HIP_MEMORY_SCOPE_AGENT); }
__device__ __forceinline__ unsigned xb_xcc_id() { return (unsigned)__builtin_amdgcn_s_getreg((3 << 11) | 20) & 0xFu; }
#define XB_SPIN(cond, bar) do { unsigned _sp = 0; while (cond) { __builtin_amdgcn_s_sleep(1); \
    if ((++_sp & 255u) == 0u) { if (xb_ld(&(bar)[XB_TMO])) break; if (_sp > XB_SPIN_CAP) { atomicAdd(&(bar)[XB_TMO], 1u); break; } } } } while (0)
struct XcdBarrier { unsigned* bar; unsigned x; volatile LAS unsigned* st; unsigned expect; };
__device__ __forceinline__ XcdBarrier xcd_barrier_post(unsigned* bar, volatile LAS unsigned* st, unsigned expect) {
    XcdBarrier b; b.bar = bar; b.x = xb_xcc_id(); b.st = st; b.expect = expect;
    if (threadIdx.x == 0) (void)xb_add(&bar[XB_XCNT(b.x)], 1u);
    return b;
}
__device__ __forceinline__ void xcd_barrier_complete(unsigned* bar, unsigned x, unsigned G, unsigned& nloc, unsigned& nx) {
    unsigned sum, cnt, mine, sp = 0u;
    for (;;) {
        sum = 0u; cnt = 0u; mine = 0u;
#pragma unroll
        for (unsigned j = 0; j < 16; ++j) { const unsigned c = xb_ld(&bar[XB_XCNT(j)]); sum += c; cnt += (c > 0u) ? 1u : 0u; mine = (j == x) ? c : mine; }
        if (sum == G) break;
        __builtin_amdgcn_s_sleep(1);
        if ((++sp & 255u) == 0u) { if (xb_ld(&bar[XB_TMO])) break; if (sp > XB_SPIN_CAP) { atomicAdd(&bar[XB_TMO], 1u); break; } }
    }
    nloc = mine > 0u ? mine : 1u; nx = cnt > 0u ? cnt : 1u;
}
__device__ __forceinline__ void xcd_barrier(const XcdBarrier& b) {
    asm volatile("s_waitcnt vmcnt(0)" ::: "memory");
    __syncthreads();
    if (threadIdx.x == 0) {
        unsigned* bar = b.bar;
        __builtin_amdgcn_s_waitcnt(0);
        unsigned nloc = b.st[0], nx = b.st[1];
        if (nloc == 0u) { xcd_barrier_complete(bar, b.x, b.expect, nloc, nx); b.st[0] = nloc; b.st[1] = nx; }
        const unsigned old = xb_add(&bar[XB_XSUB(b.x)], 1u);
        const unsigned gen = old / nloc;
        if (old + 1u == (gen + 1u) * nloc) {
            __builtin_amdgcn_fence(__ATOMIC_RELEASE, "agent");
            asm volatile("s_waitcnt vmcnt(0)" ::: "memory");
            const unsigned og = xb_add(&bar[XB_TOP], 1u);
            const unsigned tg = og / nx;
            if (og + 1u == (tg + 1u) * nx) xb_add(&bar[XB_TOPGEN], 1u);
            else XB_SPIN(xb_ld(&bar[XB_TOPGEN]) == tg, bar);
            __builtin_amdgcn_fence(__ATOMIC_ACQUIRE, "agent");
            xb_add(&bar[XB_XGEN(b.x)], 1u);
            asm volatile("s_waitcnt vmcnt(0)" ::: "memory");
        } else {
            XB_SPIN(xb_ld(&bar[XB_XGEN(b.x)]) == gen, bar);
            __builtin_amdgcn_fence(__ATOMIC_ACQUIRE, "agent");
            asm volatile("s_waitcnt vmcnt(0)" ::: "memory");
        }
    }
    __syncthreads();
}

struct Frame {
    LAS unsigned char* lds;
    int tid, lane, wave, vcu, G;
};

#define DPP_ADD(v, ctrl) ((v) + __builtin_bit_cast(float, __builtin_amdgcn_update_dpp(0, __builtin_bit_cast(int, (v)), (ctrl), 0xf, 0xf, true)))
__device__ __forceinline__ float wave_sum(float v) {
    v = DPP_ADD(v, 0xB1);
    v = DPP_ADD(v, 0x4E);
    v = DPP_ADD(v, 0x141);
    v = DPP_ADD(v, 0x140);
    const int vi = __builtin_bit_cast(int, v);
    const float r0 = __builtin_bit_cast(float, __builtin_amdgcn_readlane(vi, 0)), r1 = __builtin_bit_cast(float, __builtin_amdgcn_readlane(vi, 16));
    const float r2 = __builtin_bit_cast(float, __builtin_amdgcn_readlane(vi, 32)), r3 = __builtin_bit_cast(float, __builtin_amdgcn_readlane(vi, 48));
    return (r0 + r1) + (r2 + r3);
}

__device__ __forceinline__ void p0_transpose_item(const float* W, int N, bf16_t* WT, int K, int k0, int n0, int drow0, LAS float* scr, int lane) {
#pragma unroll 8
    for (int i = 0; i < 32; ++i) { const int kk = 2 * i + (lane >> 5); scr[kk * 33 + (lane & 31)] = __builtin_nontemporal_load(W + (size_t)(k0 + kk) * N + n0 + (lane & 31)); }
    LDS_WAIT(); asm volatile("" ::: "memory");
    const int c = lane & 7;
#pragma unroll
    for (int j = 0; j < 4; ++j) { const int n = (lane >> 3) + 8 * j; const LAS float* s = scr + (8 * c) * 33 + n;
        u32x4 o; o.x = cvt_pk_bf16(s[0 * 33], s[1 * 33]); o.y = cvt_pk_bf16(s[2 * 33], s[3 * 33]); o.z = cvt_pk_bf16(s[4 * 33], s[5 * 33]); o.w = cvt_pk_bf16(s[6 * 33], s[7 * 33]);
        *(u32x4*)(WT + (size_t)(drow0 + n) * K + k0 + 8 * c) = o; }
    LDS_WAIT(); asm volatile("" ::: "memory");
}
__device__ __forceinline__ int win_dest_row(int n0) {
    const int s = n0 >> 10, ch = n0 & 1023;
    switch (s) {
        case 0: return 256 * (ch >> 7) + (ch & 127);
        case 1: return 5120 + ch;
        case 2: return 256 * (ch >> 7) + 128 + (ch & 127);
        case 3: return 2048 + ch;
        case 4: return 3072 + ch;
        case 5: return 6144 + ch;
        default: return 4096 + ch;
    }
}
__device__ __forceinline__ void p0_weights(const Frame& F, const float* w_in, const float* w_out, bf16_t* WIN, bf16_t* WOUT, int l, int gw, int NGW) {
    LAS float* scr = (LAS float*)(F.lds + F.wave * 16384);
    constexpr int I_IN = (D / 64) * (DIN / 32), I_OUT = (D / 64) * (D / 32), I_L = I_IN + I_OUT;
    for (int it = gw; it < I_L; it += NGW) {
        int r = it;
        if (r < I_IN) { const int kb = r / (DIN / 32), nb = r % (DIN / 32);
            p0_transpose_item(w_in + (size_t)l * D * DIN, DIN, WIN + (size_t)l * DIN * D, D, 64 * kb, 32 * nb, win_dest_row(32 * nb), scr, F.lane); }
        else { r -= I_IN; const int kb = r / (D / 32), nb = r % (D / 32);
            p0_transpose_item(w_out + (size_t)l * D * D, D, WOUT + (size_t)l * D * D, D, 64 * kb, 32 * nb, 32 * nb, scr, F.lane); }
    }
}
__device__ __forceinline__ void p0_prologue(const Frame& F, const float* c_in, const float* w_ada, const float* b_ada, const float* w_in, const float* w_out, const float* w_sp,
                                            float* MOD, bf16_t* WIN, bf16_t* WOUT, bf16_t* WSB) {
    LAS float* sc = (LAS float*)F.lds;
    LAS float* red = (LAS float*)(F.lds + 16384);
    constexpr int NCH = 48, NIT = NMOD / NCH;
    for (int it = F.vcu; it < DEPTH * NIT; it += F.G) {
        for (int i = F.tid; i < BATCH * D; i += 512) sc[i] = silu_f(c_in[i]);
        __syncthreads();
        const int l = it / NIT, n0 = (it % NIT) * NCH;
        const int ln = F.lane < NCH ? F.lane : NCH - 1;
        const float* W = w_ada + (size_t)l * D * NMOD + n0 + ln;
        const int k0 = F.wave * 256;
        float a0 = 0.f, a1 = 0.f;
#pragma unroll 16
        for (int k = 0; k < 256; ++k) { const float w = __builtin_nontemporal_load(W + (size_t)(k0 + k) * NMOD); a0 += sc[k0 + k] * w; a1 += sc[D + k0 + k] * w; }
        red[(F.wave * 2 + 0) * 64 + F.lane] = a0; red[(F.wave * 2 + 1) * 64 + F.lane] = a1;
        __syncthreads();
        if (F.tid < 128 && (F.tid & 63) < NCH) { const int b = F.tid >> 6, lc = F.tid & 63; float s = 0.f;
#pragma unroll
            for (int w = 0; w < 8; ++w) s += red[(w * 2 + b) * 64 + lc];
            MOD[(size_t)(l * BATCH + b) * NMOD + n0 + lc] = s + b_ada[(size_t)l * NMOD + n0 + lc]; }
        __syncthreads();
    }
    p0_weights(F, w_in, w_out, WIN, WOUT, 0, F.vcu * 8 + F.wave, F.G * 8);
    const int gw = F.vcu * 8 + F.wave, NGW = F.G * 8;
    for (int i = (gw * 64 + F.lane) * 4; i < DEPTH * NG * 128 * 128; i += NGW * 64 * 4) { const f32x4 v = *(const f32x4*)(w_sp + i); u32x2 o; o.x = cvt_pk_bf16(v[0], v[1]); o.y = cvt_pk_bf16(v[2], v[3]); *(u32x2*)(WSB + i) = o; }
}

struct LnStage { const bf16_t* y; const float* g; const float* b; };
__device__ __forceinline__ void ln_row_norm(f32x4 (&v)[8], float& rstd) {
    float s = 0.f;
#pragma unroll
    for (int j = 0; j < 8; ++j) s += (v[j][0] + v[j][1]) + (v[j][2] + v[j][3]);
    const float mean = wave_sum(s) * (1.f / D); float s2 = 0.f;
#pragma unroll
    for (int j = 0; j < 8; ++j) { v[j] = v[j] - mean; s2 += (v[j][0] * v[j][0] + v[j][1] * v[j][1]) + (v[j][2] * v[j][2] + v[j][3] * v[j][3]); }
    rstd = __builtin_amdgcn_rsqf(wave_sum(s2) * (1.f / D) + LN_EPS);
}
__device__ __forceinline__ void ln_phase(const Frame& F, const float* src, const LnStage sa, const LnStage sb, float* xout, bool has_h, const float* modn, bf16_t* H) {
    LAS float* tga = (LAS float*)F.lds;
    LAS float* tba = tga + D; LAS float* tgb = tba + D; LAS float* tbb = tgb + D; LAS float* ts = tbb + D; LAS float* th = ts + D;
    for (int rb = F.vcu; rb < M / 64; rb += F.G) {
        const int bat = (rb * 64) / T;
        __syncthreads();
        for (int i = F.tid; i < D; i += 512) {
            if (sa.y) { tga[i] = sa.g[i]; tba[i] = sa.b[i]; }
            if (sb.y) { tgb[i] = sb.g[i]; tbb[i] = sb.b[i]; }
            if (has_h) { th[i] = modn[(size_t)bat * NMOD + i]; ts[i] = 1.0f + modn[(size_t)bat * NMOD + D + i]; }
        }
        __syncthreads();
        for (int i = 0; i < 8; ++i) {
            const size_t row = (size_t)rb * 64 + F.wave * 8 + i;
            const f32x4* xr = (const f32x4*)(src + row * D) + F.lane;
            f32x4 v[8]; u32x2 ya[8], yb[8];
#pragma unroll
            for (int j = 0; j < 8; ++j) v[j] = __builtin_nontemporal_load(xr + 64 * j);
            if (sa.y) { const u32x2* yr = (const u32x2*)(sa.y + row * D) + F.lane;
#pragma unroll
                for (int j = 0; j < 8; ++j) ya[j] = yr[64 * j]; }
            if (sb.y) { const u32x2* yr = (const u32x2*)(sb.y + row * D) + F.lane;
#pragma unroll
                for (int j = 0; j < 8; ++j) yb[j] = yr[64 * j]; }
            if (sa.y) {
#pragma unroll
                for (int j = 0; j < 8; ++j) v[j] = v[j] * DN_ALPHA + (f32x4){bf_lo(ya[j].x), bf_hi(ya[j].x), bf_lo(ya[j].y), bf_hi(ya[j].y)};
                float rstd; ln_row_norm(v, rstd);
#pragma unroll
                for (int j = 0; j < 8; ++j) v[j] = v[j] * rstd * *(const LAS f32x4*)(tga + 4 * F.lane + 256 * j) + *(const LAS f32x4*)(tba + 4 * F.lane + 256 * j);
            }
            if (sb.y) {
#pragma unroll
                for (int j = 0; j < 8; ++j) v[j] = v[j] * DN_ALPHA + (f32x4){bf_lo(yb[j].x), bf_hi(yb[j].x), bf_lo(yb[j].y), bf_hi(yb[j].y)};
                float rstd; ln_row_norm(v, rstd);
#pragma unroll
                for (int j = 0; j < 8; ++j) v[j] = v[j] * rstd * *(const LAS f32x4*)(tgb + 4 * F.lane + 256 * j) + *(const LAS f32x4*)(tbb + 4 * F.lane + 256 * j);
            }
            if (xout) { f32x4* xo = (f32x4*)(xout + row * D) + F.lane;
#pragma unroll
                for (int j = 0; j < 8; ++j) __builtin_nontemporal_store(v[j], xo + 64 * j); }
            if (has_h) {
                float rstd; ln_row_norm(v, rstd);
                u32x2* ho = (u32x2*)(H + row * D) + F.lane;
#pragma unroll
                for (int j = 0; j < 8; ++j) { const f32x4 o = v[j] * rstd * *(const LAS f32x4*)(ts + 4 * F.lane + 256 * j) + *(const LAS f32x4*)(th + 4 * F.lane + 256 * j);
                    u32x2 w; w.x = cvt_pk_bf16(o[0], o[1]); w.y = cvt_pk_bf16(o[2], o[3]); ho[64 * j] = w; }
            }
        }
    }
    __syncthreads();
}

struct AttnPtrs { const float* rpb; const bf16_t *Qb, *Kb, *VT, *ZB; bf16_t* YC; };
constexpr int AK_OFF = 0, AV_OFF = 73728, ATT_BIAS_OFF = 147456;
static_assert(ATT_BIAS_OFF + 15 * 32 * 4 <= LDSCTL_OFF, "attention LDS map");
static_assert(DEPTH == 2, "the LN phases chain exactly two DeepNorm stages");
__device__ __forceinline__ int kswz(int key) { return ((key >> 1) & 1) | (((key >> 3) & 3) << 1); }
__device__ __forceinline__ int rstart(int r) { return min(max(r - 4, 0), 120); }
struct AttnPre { u32x4 kv[9], vv[9]; };
template <bool VPART>
__device__ __forceinline__ void attn_issue(const Frame& F, const AttnPtrs& P, int item, AttnPre& A) {
    const int bh = item >> 3, r0 = 16 * (item & 7);
    const bf16_t* g = (VPART ? P.VT : P.Kb) + (size_t)bh * T * 64 + F.tid * 8;
    const int lo = rstart(r0);
#pragma unroll
    for (int i = 0; i < 9; ++i) { const int kr = min(lo + i, T / 64 - 1); const u32x4 w = *(const u32x4*)(g + (size_t)kr * 4096); if (VPART) A.vv[i] = w; else A.kv[i] = w; }
}

__device__ __forceinline__ void lds_sync() { asm volatile("s_waitcnt lgkmcnt(0)" ::: "memory"); __builtin_amdgcn_s_barrier(); asm volatile("" ::: "memory"); }
constexpr int SG_LDP = 136;
constexpr int SG_W_OFF = 0, SG_VT_OFF = 34816, SG_GY_OFF = 69632, SG_RED_OFF = 104448, SG_STAT_OFF = SG_RED_OFF + 8192;
template <bool B> struct BoolTag { static constexpr bool value = B; };
__device__ __forceinline__ void sgu_phase(const Frame& F, int l, const float* sgu_g, const float* sgu_b, const float* b_sp, const bf16_t* WSB, const bf16_t* VGT, const bf16_t* GA, bf16_t* YC, const AttnPtrs& AP, AttnPre& A) {
    LAS bf16_t* wl = (LAS bf16_t*)(F.lds + SG_W_OFF);
    LAS bf16_t* vt = (LAS bf16_t*)(F.lds + SG_VT_OFF);
    LAS bf16_t* gy = (LAS bf16_t*)(F.lds + SG_GY_OFF);
    LAS float* red = (LAS float*)(F.lds + SG_RED_OFF);
    LAS float* stat = (LAS float*)(F.lds + SG_STAT_OFF);
    const int fr = F.lane & 15, fq = F.lane >> 4;
    const int chunk = F.tid & 15, rq = F.tid >> 4;
    const int hG = F.G / 2, hf = F.vcu / hG, vl = F.vcu % hG, nitems = NG * (T / 128);
    const int per = (nitems + hG - 1) / hG;
    const int s0 = vl * per, n_my = max(0, min(per, nitems - s0));
    u32x4 vw[4], gv[4];
    float gam[4], bet[4];
    LAS float* bl = stat + 256;
    { const int sc = min(s0, nitems - 1), g = sc / (T / 128), bn = hf * (T / 128) + sc % (T / 128);
#pragma unroll
      for (int j = 0; j < 4; ++j) { vw[j] = *(const u32x4*)(VGT + ((size_t)bn * DS + g * 128 + rq + 32 * j) * 128 + 8 * chunk); gv[j] = *(const u32x4*)(GA + ((size_t)bn * 128 + rq + 32 * j) * DS + g * 128 + 8 * chunk); } }
    auto load_group = [&](int g) __attribute__((always_inline)) {
            const bf16_t* Wg = WSB + ((size_t)l * NG + g) * 128 * 128;
            u32x4 wv[4];
#pragma unroll
            for (int j = 0; j < 4; ++j) wv[j] = *(const u32x4*)(Wg + (rq + 32 * j) * 128 + 8 * chunk);
#pragma unroll
            for (int j = 0; j < 4; ++j) { gam[j] = sgu_g[(size_t)l * DS + g * 128 + rq + 32 * j]; bet[j] = sgu_b[(size_t)l * DS + g * 128 + rq + 32 * j]; }
            if (F.tid < 128) bl[F.tid] = b_sp[((size_t)l * NG + g) * 128 + F.tid];
#pragma unroll
            for (int j = 0; j < 4; ++j) *(LAS u32x4*)(wl + (rq + 32 * j) * SG_LDP + 8 * chunk) = wv[j];
    };
    auto item_body = [&](int s, int g, auto last_tag) __attribute__((always_inline)) {
        const int bn = hf * (T / 128) + s % (T / 128);
        const size_t m0 = (size_t)bn * 128;
#pragma unroll
        for (int j = 0; j < 4; ++j) *(LAS u32x4*)(gy + (rq + 32 * j) * SG_LDP + 8 * chunk) = gv[j];
        float x[4][8], s1[8], s2[8];
#pragma unroll
        for (int j = 0; j < 4; ++j) { x[j][0] = bf_lo(vw[j].x); x[j][1] = bf_hi(vw[j].x); x[j][2] = bf_lo(vw[j].y); x[j][3] = bf_hi(vw[j].y); x[j][4] = bf_lo(vw[j].z); x[j][5] = bf_hi(vw[j].z); x[j][6] = bf_lo(vw[j].w); x[j][7] = bf_hi(vw[j].w); }
        if constexpr (decltype(last_tag)::value) attn_issue<false>(F, AP, F.vcu, A);
        else { const int sn = s + 1, gn = sn / (T / 128), bnn = hf * (T / 128) + sn % (T / 128);
#pragma unroll
          for (int j = 0; j < 4; ++j) { vw[j] = *(const u32x4*)(VGT + ((size_t)bnn * DS + gn * 128 + rq + 32 * j) * 128 + 8 * chunk); gv[j] = *(const u32x4*)(GA + ((size_t)bnn * 128 + rq + 32 * j) * DS + gn * 128 + 8 * chunk); } }
#pragma unroll
        for (int e = 0; e < 8; ++e) { s1[e] = (x[0][e] + x[1][e]) + (x[2][e] + x[3][e]); s2[e] = (x[0][e] * x[0][e] + x[1][e] * x[1][e]) + (x[2][e] * x[2][e] + x[3][e] * x[3][e]);
            s1[e] += __shfl_xor(s1[e], 16); s1[e] += __shfl_xor(s1[e], 32); s2[e] += __shfl_xor(s2[e], 16); s2[e] += __shfl_xor(s2[e], 32); }
        if (fq == 0) {
            *(LAS f32x4*)(red + (F.wave * 2 + 0) * 128 + 8 * chunk) = (f32x4){s1[0], s1[1], s1[2], s1[3]}; *(LAS f32x4*)(red + (F.wave * 2 + 0) * 128 + 8 * chunk + 4) = (f32x4){s1[4], s1[5], s1[6], s1[7]};
            *(LAS f32x4*)(red + (F.wave * 2 + 1) * 128 + 8 * chunk) = (f32x4){s2[0], s2[1], s2[2], s2[3]}; *(LAS f32x4*)(red + (F.wave * 2 + 1) * 128 + 8 * chunk + 4) = (f32x4){s2[4], s2[5], s2[6], s2[7]};
        }
        lds_sync();
        if (F.tid < 128) { float a1 = 0.f, a2 = 0.f;
#pragma unroll
            for (int w = 0; w < 8; ++w) { a1 += red[(w * 2 + 0) * 128 + F.tid]; a2 += red[(w * 2 + 1) * 128 + F.tid]; }
            const float mean = a1 * (1.f / 128.f); const float var = fmaxf(a2 * (1.f / 128.f) - mean * mean, 0.f);
            stat[2 * F.tid] = mean; stat[2 * F.tid + 1] = __builtin_amdgcn_rsqf(var + LN_EPS); }
        lds_sync();
        {
            float mu[8], rs[8];
#pragma unroll
            for (int e = 0; e < 8; e += 2) { const f32x4 st4 = *(const LAS f32x4*)(stat + 2 * (8 * chunk + e)); mu[e] = st4[0]; rs[e] = st4[1]; mu[e + 1] = st4[2]; rs[e + 1] = st4[3]; }
#pragma unroll
            for (int j = 0; j < 4; ++j) { u32x4 o;
                o.x = cvt_pk_bf16((x[j][0] - mu[0]) * rs[0] * gam[j] + bet[j], (x[j][1] - mu[1]) * rs[1] * gam[j] + bet[j]);
                o.y = cvt_pk_bf16((x[j][2] - mu[2]) * rs[2] * gam[j] + bet[j], (x[j][3] - mu[3]) * rs[3] * gam[j] + bet[j]);
                o.z = cvt_pk_bf16((x[j][4] - mu[4]) * rs[4] * gam[j] + bet[j], (x[j][5] - mu[5]) * rs[5] * gam[j] + bet[j]);
                o.w = cvt_pk_bf16((x[j][6] - mu[6]) * rs[6] * gam[j] + bet[j], (x[j][7] - mu[7]) * rs[7] * gam[j] + bet[j]);
                *(LAS u32x4*)(vt + (rq + 32 * j) * SG_LDP + 8 * chunk) = o; }
        }
        lds_sync();
        {
            bf16x8 af[4];
#pragma unroll
            for (int ks = 0; ks < 4; ++ks) af[ks] = *(const LAS bf16x8*)(vt + (16 * F.wave + fr) * SG_LDP + 32 * ks + 8 * fq);
#pragma unroll
            for (int nt = 0; nt < 8; ++nt) {
                f32x4 acc = {0.f, 0.f, 0.f, 0.f};
#pragma unroll
                for (int ks = 0; ks < 4; ++ks) { const bf16x8 bfrag = *(const LAS bf16x8*)(wl + (16 * nt + fr) * SG_LDP + 32 * ks + 8 * fq);
                    acc = __builtin_amdgcn_mfma_f32_16x16x32_bf16(af[ks], bfrag, acc, 0, 0, 0); }
                const int p = 16 * nt + fr;
                const float bs = bl[p];
                LAS u32x2* gp = (LAS u32x2*)(gy + p * SG_LDP + 16 * F.wave + 4 * fq);
                const u32x2 gaw = *gp;
                u32x2 o; o.x = cvt_pk_bf16(bf_lo(gaw.x) * (acc[0] + bs), bf_hi(gaw.x) * (acc[1] + bs)); o.y = cvt_pk_bf16(bf_lo(gaw.y) * (acc[2] + bs), bf_hi(gaw.y) * (acc[3] + bs));
                *gp = o;
            }
        }
        lds_sync();
#pragma unroll
        for (int j = 0; j < 4; ++j) { const int p = rq + 32 * j; *(u32x4*)(YC + (m0 + p) * D + g * 128 + 8 * chunk) = *(const LAS u32x4*)(gy + p * SG_LDP + 8 * chunk); }
    };
    int ii = 0, g_cur = -1;
    while (ii < n_my - 1) {
        const int g = (s0 + ii) / (T / 128);
        lds_sync();
        load_group(g); g_cur = g;
        for (bool first = true; ii < n_my - 1 && (s0 + ii) / (T / 128) == g; ++ii, first = false) { if (!first) lds_sync(); item_body(s0 + ii, g, BoolTag<false>{}); }
    }
    if (n_my > 0) { const int s = s0 + n_my - 1, g = s / (T / 128);
        lds_sync();
        if (g != g_cur) load_group(g);
        item_body(s, g, BoolTag<true>{}); }
    else attn_issue<false>(F, AP, F.vcu, A);
    __syncthreads();
}

__device__ __forceinline__ void attn_phase(const Frame& F, const AttnPtrs& P, int l, AttnPre& A) {
    const int kwr = (F.tid >> 3) * 128 + (((F.tid & 7) ^ kswz(F.tid >> 3)) << 4);
    const LAS float* rp = (const LAS float*)(F.lds + ATT_BIAS_OFF);
    for (int item = F.vcu; item < BATCH * NH * 8; item += F.G) {
        const int bh = item >> 3, r0 = 16 * (item & 7), b = bh >> 4, h = bh & 15;
        const size_t hb = (size_t)bh * T;
        attn_issue<true>(F, P, item, A);
        __syncthreads();
        { const int lo = rstart(r0), hi = rstart(r0 + 1) + 8;
#pragma unroll
            for (int i = 0; i < 9; ++i) if (lo + i < hi) { const int slot = (lo + i) % 9;
                *(LAS u32x4*)(F.lds + AK_OFF + slot * 8192 + kwr) = A.kv[i]; *(LAS u32x4*)(F.lds + AV_OFF + slot * 8192 + F.tid * 16) = A.vv[i]; } }
        int lane_ = F.lane; asm volatile("" : "+v"(lane_));
        const int fr = lane_ & 15, fq = lane_ >> 4, cb = F.wave & 3, rsel = F.wave >> 2;
        const int bs = min(max(16 * cb - 8, 0), 32);
        const int qcol = 16 * cb + fr;
        const int wst = min(max(qcol - 8, 0), 48);
        int ci[2][4];
#pragma unroll
        for (int X = 0; X < 2; ++X)
#pragma unroll
            for (int e = 0; e < 4; ++e) { const int kc = bs + 8 * fq + 4 * X + e; ci[X][e] = ((kc >= wst) && (kc < wst + 16)) ? min(max(kc - qcol + 15, 0), 30) : 31; }
        int koff[2][2];
#pragma unroll
        for (int X = 0; X < 2; ++X) { const int key = bs + 8 * (fr >> 2) + 4 * X + (fr & 3);
#pragma unroll
            for (int ks = 0; ks < 2; ++ks) koff[X][ks] = key * 128 + (((ks * 4 + fq) ^ kswz(key)) << 4); }
        const int voff = (((bs >> 3) + fq) * 64 + fr) * 16;
        const bf16_t* Kg = P.Kb + hb * 64 + F.tid * 8;
        const bf16_t* Vg = P.VT + hb * 64 + F.tid * 8;
        bf16_t* yb = P.YC + ((size_t)b * T + qcol) * D + DS + h * 64 + 4 * fq;
        for (int i = F.tid; i < 15 * 32; i += 512) ((LAS float*)(F.lds + ATT_BIAS_OFF))[i] = (i & 31) == 31 ? -1.0e30f : P.rpb[((size_t)l * NH + h) * 15 * 31 + (i >> 5) * 31 + (i & 31)] * 1.4426950408889634f;
        bf16x8 qf[2]; u32x2 zw[4];
        { const size_t tk = hb + (r0 + rsel) * 64 + qcol;
#pragma unroll
            for (int ks = 0; ks < 2; ++ks) qf[ks] = *(const bf16x8*)(P.Qb + tk * 64 + 32 * ks + 8 * fq);
#pragma unroll
            for (int d = 0; d < 4; ++d) zw[d] = *(const u32x2*)(P.ZB + tk * 64 + 16 * d + 4 * fq); }
        u32x2 yw[4];
        __syncthreads();
        for (int st = 0; st < 8; ++st) {
            const int ra = r0 + 2 * st, r = ra + rsel, rs = rstart(r);
            if (st > 0) {
#pragma unroll
                for (int d = 0; d < 4; ++d) *(u32x2*)(yb + (size_t)(r - 2) * 64 * D + 16 * d) = yw[d]; }
            const int nlo = rstart(ra + 1) + 8, nhi = (st < 7) ? rstart(ra + 3) + 7 : -1;
            const int kr0 = min(nlo, T / 64 - 1), kr1 = min(nlo + 1, T / 64 - 1);
            const u32x4 pk0 = *(const u32x4*)(Kg + (size_t)kr0 * 4096), pv0 = *(const u32x4*)(Vg + (size_t)kr0 * 4096);
            const u32x4 pk1 = *(const u32x4*)(Kg + (size_t)kr1 * 4096), pv1 = *(const u32x4*)(Vg + (size_t)kr1 * 4096);
            const size_t tkn = hb + min(r + 2, T / 64 - 1) * 64 + qcol;
            bf16x8 qn[2]; u32x2 zn[4];
#pragma unroll
            for (int ks = 0; ks < 2; ++ks) qn[ks] = *(const bf16x8*)(P.Qb + tkn * 64 + 32 * ks + 8 * fq);
#pragma unroll
            for (int d = 0; d < 4; ++d) zn[d] = *(const u32x2*)(P.ZB + tkn * 64 + 16 * d + 4 * fq);
            float s[8][2][4];
            float mx = -3.0e38f;
#pragma unroll
            for (int i = 0; i < 8; ++i) {
                const LAS float* rpi = rp + (rs + i - r + 7) * 32;
                const LAS unsigned char* kb = F.lds + AK_OFF + ((rs + i) % 9) * 8192;
#pragma unroll
                for (int X = 0; X < 2; ++X) {
                    f32x4 c = {rpi[ci[X][0]], rpi[ci[X][1]], rpi[ci[X][2]], rpi[ci[X][3]]};
#pragma unroll
                    for (int ks = 0; ks < 2; ++ks) c = __builtin_amdgcn_mfma_f32_16x16x32_bf16(*(const LAS bf16x8*)(kb + koff[X][ks]), qf[ks], c, 0, 0, 0);
                    s[i][X][0] = c[0]; s[i][X][1] = c[1]; s[i][X][2] = c[2]; s[i][X][3] = c[3];
                    mx = fmaxf(fmaxf(mx, c[0]), c[1]); mx = fmaxf(fmaxf(mx, c[2]), c[3]);
                }
            }
            mx = fmaxf(mx, __shfl_xor(mx, 16)); mx = fmaxf(mx, __shfl_xor(mx, 32));
#pragma unroll
            for (int i = 0; i < 8; ++i)
#pragma unroll
                for (int X = 0; X < 2; ++X)
#pragma unroll
                    for (int e = 0; e < 4; ++e) s[i][X][e] = __builtin_amdgcn_exp2f(s[i][X][e] - mx);
            f32x4 o[4], osum = {0.f, 0.f, 0.f, 0.f};
#pragma unroll
            for (int d = 0; d < 4; ++d) o[d] = (f32x4){0.f, 0.f, 0.f, 0.f};
            const bf16x8 ones = {0x3F80, 0x3F80, 0x3F80, 0x3F80, 0x3F80, 0x3F80, 0x3F80, 0x3F80};
#pragma unroll
            for (int i = 0; i < 8; ++i) {
                union { u32x4 u; bf16x8 v; } pb;
                pb.u.x = cvt_pk_bf16(s[i][0][0], s[i][0][1]); pb.u.y = cvt_pk_bf16(s[i][0][2], s[i][0][3]); pb.u.z = cvt_pk_bf16(s[i][1][0], s[i][1][1]); pb.u.w = cvt_pk_bf16(s[i][1][2], s[i][1][3]);
                const LAS unsigned char* vb = F.lds + AV_OFF + ((rs + i) % 9) * 8192 + voff;
#pragma unroll
                for (int d = 0; d < 4; ++d) o[d] = __builtin_amdgcn_mfma_f32_16x16x32_bf16(*(const LAS bf16x8*)(vb + d * 256), pb.v, o[d], 0, 0, 0);
                osum = __builtin_amdgcn_mfma_f32_16x16x32_bf16(ones, pb.v, osum, 0, 0, 0);
            }
            const float sum = osum[0];
            const float inv = 1.0f / sum;
#pragma unroll
            for (int d = 0; d < 4; ++d) {
                yw[d].x = cvt_pk_bf16(o[d][0] * inv * bf_lo(zw[d].x), o[d][1] * inv * bf_hi(zw[d].x)); yw[d].y = cvt_pk_bf16(o[d][2] * inv * bf_lo(zw[d].y), o[d][3] * inv * bf_hi(zw[d].y)); }
            __syncthreads();
            if (nlo <= nhi) { const int slot = nlo % 9; *(LAS u32x4*)(F.lds + AK_OFF + slot * 8192 + kwr) = pk0; *(LAS u32x4*)(F.lds + AV_OFF + slot * 8192 + F.tid * 16) = pv0; }
            if (nlo + 1 <= nhi) { const int slot = (nlo + 1) % 9; *(LAS u32x4*)(F.lds + AK_OFF + slot * 8192 + kwr) = pk1; *(LAS u32x4*)(F.lds + AV_OFF + slot * 8192 + F.tid * 16) = pv1; }
            __syncthreads();
            qf[0] = qn[0]; qf[1] = qn[1];
#pragma unroll
            for (int d = 0; d < 4; ++d) zw[d] = zn[d];
        }
#pragma unroll
        for (int d = 0; d < 4; ++d) *(u32x2*)(yb + (size_t)(r0 + 14 + rsel) * 64 * D + 16 * d) = yw[d];
        if (item + F.G < BATCH * NH * 8) attn_issue<false>(F, P, item + F.G, A);
    }
    __syncthreads();
}

struct Args { const float* in[13]; float* out; unsigned char* ws; int ph_lo, ph_hi; };
constexpr int N_PHASES = 2 + 4 * DEPTH;

typedef const __attribute__((address_space(4))) Args* ArgsP;
__device__ __forceinline__ ArgsP fresh_args() { ArgsP p = (ArgsP)__builtin_amdgcn_kernarg_segment_ptr(); asm volatile("" : "+s"(p)); return p; }
#ifndef MK_MASK
#define MK_MASK 63
#endif
#ifndef MK_REP
#define MK_REP 0
#endif
__global__ void __launch_bounds__(512, 2) mk_fwd(Args args) {
    extern __shared__ __attribute__((aligned(16))) unsigned char lds[];
    { LAS unsigned* z = (LAS unsigned*)((LAS unsigned char*)lds + LDSCTL_OFF); for (int u = threadIdx.x; u < (LDS_BYTES - LDSCTL_OFF) / 4; u += 512) z[u] = 0u; }
    __syncthreads();
    const int lo = args.ph_lo, hi = args.ph_hi;
    const unsigned half_ = ((blockIdx.x & 7u) >> 2) & 1u;
    XcdBarrier bar, barh; bar.bar = (unsigned*)(args.ws + WS_CTL) + CW_BAR; bar.x = 0; bar.st = nullptr; bar.expect = gridDim.x; barh = bar;
    if (hi - lo > 1) {
        bar = xcd_barrier_post((unsigned*)(args.ws + WS_CTL) + CW_BAR, (volatile LAS unsigned*)((LAS unsigned char*)lds + MISC_OFF) + 8, gridDim.x);
        barh = xcd_barrier_post((unsigned*)(args.ws + WS_CTL) + CW_BAR + (1 + half_) * XCD_BAR_WORDS, (volatile LAS unsigned*)((LAS unsigned char*)lds + MISC_OFF) + 10, gridDim.x / 2);
    }
    const bool split_ok = (gridDim.x % 16) == 0;

    for (int ph = lo; ph < hi; ++ph) {
      const int kind_ = ph == 0 ? 1 : (ph == 1 ? 2 : (((ph - 2) & 3) == 0 ? 4 : (((ph - 2) & 3) == 1 ? 64 : (((ph - 2) & 3) == 2 ? 32 : 2))));
      const int nrep_ = (MK_REP & kind_) ? 2 : 1;
      for (int rep_ = 0; rep_ < nrep_; ++rep_) {
        ArgsP ap = fresh_args();
        unsigned char* ws = ap->ws;
        int tid_ = threadIdx.x, bx = blockIdx.x, G_ = gridDim.x;
        asm volatile("" : "+v"(tid_)); asm volatile("" : "+s"(bx), "+s"(G_));
        Frame F; F.lds = (LAS unsigned char*)lds; F.tid = tid_; F.lane = tid_ & 63; F.wave = __builtin_amdgcn_readfirstlane(tid_ >> 6);
        F.G = G_; F.vcu = (G_ % 8 == 0) ? (bx % 8) * (G_ / 8) + bx / 8 : bx;
        if (ph == 0) {
            if (MK_MASK & 1) p0_prologue(F, ap->in[1], ap->in[2], ap->in[3], ap->in[4], ap->in[10], ap->in[7], (float*)(ws + WS_MOD), (bf16_t*)(ws + WS_WIN), (bf16_t*)(ws + WS_WOUT), (bf16_t*)(ws + WS_WSB));
        } else if (ph == 1) {
            if (split_ok && half_ == 1u) {
                __syncthreads();
                p0_weights(F, ap->in[4], ap->in[10], (bf16_t*)(ws + WS_WIN), (bf16_t*)(ws + WS_WOUT), 1, (F.vcu - F.G / 2) * 8 + F.wave, (F.G / 2) * 8);
                __syncthreads();
            } else if (!split_ok) { __syncthreads(); p0_weights(F, ap->in[4], ap->in[10], (bf16_t*)(ws + WS_WIN), (bf16_t*)(ws + WS_WOUT), 1, F.vcu * 8 + F.wave, F.G * 8); __syncthreads(); }
            if (MK_MASK & 2) ln_phase(F, ap->in[0], LnStage{nullptr, nullptr, nullptr}, LnStage{nullptr, nullptr, nullptr}, nullptr, true, (const float*)(ws + WS_MOD), (bf16_t*)(ws + WS_H));
        } else {
            const int l = (ph - 2) >> 2, k = (ph - 2) & 3;
            if (k == 0) { if (MK_MASK & 4) {
                const bf16_t* H = (const bf16_t*)(ws + WS_H); const bf16_t* W = (const bf16_t*)(ws + WS_WIN) + (size_t)l * DIN * D;
                pg8::Gemm g{H, W, W + (size_t)5120 * D, H, D};
                pg8::ProjOrder S; S.init(F.G, bx);
                pg8::EpiProj E{(bf16_t*)(ws + WS_GA), (bf16_t*)(ws + WS_VG), (bf16_t*)(ws + WS_Q), (bf16_t*)(ws + WS_VT)};
                pg8::gemm_phase<pg8::EpiProj, pg8::ProjOrder>(F.lds, F.tid, g, S, E); }
            } else if (k == 1) {
                const AttnPtrs P{ap->in[9], (const bf16_t*)(ws + WS_Q), (const bf16_t*)(ws + WS_K), (const bf16_t*)(ws + WS_VT), (const bf16_t*)(ws + WS_ZB), (bf16_t*)(ws + WS_H)};
                AttnPre pre;
                sgu_phase(F, l, ap->in[5], ap->in[6], ap->in[8], (const bf16_t*)(ws + WS_WSB), (const bf16_t*)(ws + WS_VG), (const bf16_t*)(ws + WS_GA), (bf16_t*)(ws + WS_H), P, pre);
                attn_phase(F, P, l, pre);
            } else if (k == 2) { if (MK_MASK & 32) {
                pg8::Gemm g{(const bf16_t*)(ws + WS_H), (const bf16_t*)(ws + WS_WOUT) + (size_t)l * D * D, nullptr, nullptr, D};
                pg8::StaticOrder S; S.init(M, D, F.G, bx);
                LAS float* g1 = (LAS float*)(F.lds + pg8::STAGE_BYTES);
                { const float* gsrc = (const float*)(ws + WS_MOD) + (size_t)l * BATCH * NMOD + 2 * D;
                  for (int i = F.tid; i < BATCH * D / 4; i += 512) { const int b = i / (D / 4), c4 = i % (D / 4); *(LAS f32x4*)(g1 + b * D + c4 * 4) = *(const f32x4*)(gsrc + (size_t)b * NMOD + c4 * 4) + 1.0f; }
                  __syncthreads(); }
                pg8::EpiOut E{g1, (bf16_t*)(ws + (l == 0 ? WS_Y0 : WS_Y))};
                pg8::gemm_phase<pg8::EpiOut, pg8::StaticOrder>(F.lds, F.tid, g, S, E); }
            } else {
                const LnStage s0{(const bf16_t*)(ws + WS_Y0), ap->in[11], ap->in[12]};
                if (l == 0) { if (MK_MASK & 2) ln_phase(F, ap->in[0], s0, LnStage{nullptr, nullptr, nullptr}, nullptr, true, (const float*)(ws + WS_MOD) + (size_t)BATCH * NMOD, (bf16_t*)(ws + WS_H)); }
                else { const LnStage s1{(const bf16_t*)(ws + WS_Y), ap->in[11] + D, ap->in[12] + D};
                    if (MK_MASK & 2) ln_phase(F, ap->in[0], s0, s1, ap->out, false, nullptr, nullptr); }
            }
        }
        if (ph + 1 < hi || rep_ + 1 < nrep_) {
            if (ph == 0 || !split_ok) xcd_barrier(bar);
            else {
                if (ph == 5 && half_ == 0u && threadIdx.x == 0) {
                    unsigned* hc = (unsigned*)(ws + WS_CTL) + CW_HANDOFF; unsigned sp = 0;
                    while (xb_ld(hc) < gridDim.x / 2) { __builtin_amdgcn_s_sleep(2); if (++sp > (1u << 22)) break; }
                }
                xcd_barrier(barh);
                if (ph == 1 && half_ == 1u && threadIdx.x == 0 && rep_ == 0) xb_add((unsigned*)(ws + WS_CTL) + CW_HANDOFF, 1u);
            }
        }
      }
    }
}

extern "C" void kernel_launch(void* const* d_in, const int* in_sizes, int n_in, void* d_out, int out_size, void* d_ws, size_t ws_size, hipStream_t stream) {
    static int grid = 0;
    if (grid == 0) {
        if (n_in != 13 || out_size != M * D || ws_size < WS_END) { fprintf(stderr, "kernel_launch: unexpected shapes (n_in %d, out %d, ws %zu)\n", n_in, out_size, ws_size); grid = -1; return; }
        int dev = 0, cus = 0, per_cu = 0;
        if (hipGetDevice(&dev) != hipSuccess || hipDeviceGetAttribute(&cus, hipDeviceAttributeMultiprocessorCount, dev) != hipSuccess) { grid = -1; return; }
        if (hipFuncSetAttribute((const void*)mk_fwd, hipFuncAttributeMaxDynamicSharedMemorySize, LDS_BYTES) != hipSuccess) { fprintf(stderr, "kernel_launch: hipFuncSetAttribute failed\n"); grid = -1; return; }
        if (hipOccupancyMaxActiveBlocksPerMultiprocessor(&per_cu, (const void*)mk_fwd, 512, LDS_BYTES) != hipSuccess || per_cu < 1) { fprintf(stderr, "kernel_launch: occupancy query reports %d blocks per CU\n", per_cu); per_cu = 1; }
        (void)hipGetLastError();
        grid = cus;
    }
    if (grid < 0) return;
    (void)hipMemsetAsync((char*)d_ws + WS_CTL, 0, CTL_ZERO_BYTES, stream);
    Args a{};
    for (int i = 0; i < 13; ++i) a.in[i] = (const float*)d_in[i];
    a.out = (float*)d_out; a.ws = (unsigned char*)d_ws;
    if (MK_N_LAUNCHES == 1) { a.ph_lo = 0; a.ph_hi = N_PHASES; hipLaunchKernelGGL(mk_fwd, dim3(grid), dim3(512), LDS_BYTES, stream, a); }
    else { for (int p = 0; p < N_PHASES; ++p) { a.ph_lo = p; a.ph_hi = p + 1; hipLaunchKernelGGL(mk_fwd, dim3(grid), dim3(512), LDS_BYTES, stream, a); } }
}
```

```cpp
#include <hip/hip_runtime.h>
#include <cstdio>
#include <cstdint>

#ifndef MK_N_LAUNCHES
#define MK_N_LAUNCHES 1
#endif

#define LAS __attribute__((address_space(3)))
#define GAS __attribute__((address_space(1)))
typedef unsigned short bf16_t;
typedef short bf16x8 __attribute__((ext_vector_type(8)));
typedef float f32x4 __attribute__((ext_vector_type(4)));
typedef float f32x2 __attribute__((ext_vector_type(2)));
typedef unsigned u32x4 __attribute__((ext_vector_type(4)));
typedef unsigned u32x2 __attribute__((ext_vector_type(2)));

constexpr int BATCH = 2, T = 8192, D = 2048, M = BATCH * T, DIN = 7168, DS = 1024, NG = 8, NH = 16, DEPTH = 2;
constexpr int NMOD = 3 * D;
constexpr float LN_EPS = 1e-5f;
constexpr float DN_ALPHA = 1.4142135623730951f;

typedef __bf16 bf16v2 __attribute__((ext_vector_type(2)));
__device__ __forceinline__ unsigned cvt_pk_bf16(float lo, float hi) { const f32x2 v = {lo, hi}; const bf16v2 r = __builtin_convertvector(v, bf16v2); return __builtin_bit_cast(unsigned, r); }
__device__ __forceinline__ float bf_lo(unsigned w) { return __builtin_bit_cast(float, w << 16); }
__device__ __forceinline__ float bf_hi(unsigned w) { return __builtin_bit_cast(float, w & 0xffff0000u); }
__device__ __forceinline__ float silu_f(float x) { return x * __builtin_amdgcn_rcpf(1.0f + __builtin_amdgcn_exp2f(-1.4426950408889634f * x)); }
__device__ __forceinline__ f32x2 gelu_pk(f32x2 v) {
    f32x2 c; c.x = __builtin_amdgcn_fmed3f(v.x, -4.0f, 4.0f); c.y = __builtin_amdgcn_fmed3f(v.y, -4.0f, 4.0f);
    const f32x2 s = c * c;
    f32x2 r = s * 7.0374646370e-11f + (-6.2872893160e-09f);
    r = r * s + 2.5093203053e-07f; r = r * s + (-5.9760889818e-06f); r = r * s + 9.6085055597e-05f; r = r * s + (-1.1195942566e-03f);
    r = r * s + 9.8383713455e-03f; r = r * s + (-6.6361911043e-02f); r = r * s + 3.9890514886e-01f;
    return v * (c * r + 0.5f);
}
__device__ __forceinline__ f32x4 gelu4(f32x4 v) { f32x2 a = gelu_pk((f32x2){v[0], v[1]}), b = gelu_pk((f32x2){v[2], v[3]}); return (f32x4){a.x, a.y, b.x, b.y}; }
__device__ __forceinline__ f32x2 silu_pk(f32x2 v) { const f32x2 a = v * (-1.4426950408889634f); f32x2 e; e.x = __builtin_amdgcn_exp2f(a.x); e.y = __builtin_amdgcn_exp2f(a.y);
    const f32x2 d = e + 1.0f; f32x2 r; r.x = __builtin_amdgcn_rcpf(d.x); r.y = __builtin_amdgcn_rcpf(d.y); return v * r; }
__device__ __forceinline__ f32x4 silu4(f32x4 v) { const f32x2 a = silu_pk((f32x2){v[0], v[1]}), b = silu_pk((f32x2){v[2], v[3]}); return (f32x4){a.x, a.y, b.x, b.y}; }
#ifndef MK_REP
#define MK_REP 0
#endif
__device__ __forceinline__ void store8(bf16_t* p, f32x4 a, f32x4 b) { u32x4 w; w.x = cvt_pk_bf16(a[0], a[1]); w.y = cvt_pk_bf16(a[2], a[3]); w.z = cvt_pk_bf16(b[0], b[1]); w.w = cvt_pk_bf16(b[2], b[3]); *(u32x4*)p = w;
    if (MK_REP & 128) { asm volatile("" ::: "memory"); *(u32x4*)p = w; asm volatile("" ::: "memory"); } }

namespace pg8 {
constexpr int BM = 256, BK = 64, HALF = 128, HTB = HALF * BK * 2, STAGE_BYTES = 8 * HTB, NXCD = 8, WGM = 2;
__host__ __device__ __forceinline__ int lds_byte(int r, int c) { const int st = (r >> 4) * 2 + (c >> 5), rr = r & 15, cc = c & 31, ob = rr * 64 + cc * 2; return st * 1024 + (ob ^ (((ob >> 9) & 1) << 5)); }
__host__ __device__ __forceinline__ void stage_rc(int b, int& R, int& C) { const int st = b / 1024, sb = b % 1024, swz = sb ^ (((sb >> 9) & 1) << 5); R = (st >> 1) * 16 + swz / 64; C = (st & 1) * 32 + (swz % 64) / 2; }
__host__ __device__ __forceinline__ int perm32(int rho) { const int n = rho >> 4, i = rho & 15; return 8 * (i >> 2) + 4 * n + (i & 3); }

struct Unit { int pm, pn, kind; };
struct Gemm { const bf16_t* A0; const bf16_t* B0; const bf16_t* A1; const bf16_t* B1; int K; };

struct StaticOrder {
    int nM, nN, nwg, G, c;
    __device__ void init(int M_, int N_, int G_, int c_) { nM = M_ / BM; nN = N_ / BM; nwg = nM * nN; G = G_; c = c_; }
    __device__ __forceinline__ void map(int wgid, Unit& u) const {
        { const int q = nwg / NXCD, r = nwg % NXCD, xcd = wgid % NXCD, off = wgid / NXCD; wgid = (xcd < r ? xcd * (q + 1) : r * (q + 1) + (xcd - r) * q) + off; }
        const int nig = WGM * nN, gid = wgid / nig, fm = gid * WGM, gsz = (nM - fm) < WGM ? (nM - fm) : WGM;
        u.pm = fm + ((wgid % nig) % gsz); u.pn = (wgid % nig) / gsz; u.kind = 0;
    }
    __device__ __forceinline__ bool next(int i, Unit& u) const { const long L = (long)i * G + c; if (L >= nwg) return false; map((int)L, u); return true; }
};
struct ProjOrder {
    StaticOrder S; int nswap;
    __device__ void init(int G_, int c_) { S.init(M, 5120, G_, c_); nswap = 512; }
    __device__ __forceinline__ bool next(int i, Unit& u) const {
        const long L = (long)i * S.G + S.c;
        if (L < S.nwg) { S.map((int)L, u); return true; }
        const int idx = (int)(L - S.nwg); if (idx >= nswap) return false;
        const int x = idx % 8, t = idx / 8, rnd = t >> 5, j = t & 31;
        u.pm = (j + 4 * rnd) & 7; u.pn = 8 * x + 4 * rnd + (j >> 3); u.kind = 1; return true;
    }
};

struct EpiProj {
    static constexpr bool PERM = true;
    bf16_t *GA, *VGT, *Qb, *VT;
    __device__ __forceinline__ void operator()(const f32x4 (&acc)[2][2][4][2], const Unit& u, int wr, int wc, int fr, int fq) const {
        const int rl = wr * 64 + fr, cl = wc * 32 + 8 * fq;
        if (u.kind == 1) {
            const int tok0 = u.pn * 256 + cl;
            if (u.pm < 4) {
#pragma unroll
                for (int ai = 0; ai < 2; ++ai)
#pragma unroll
                    for (int m = 0; m < 4; ++m) { const int ch = u.pm * 256 + rl + ai * HALF + m * 16;
#pragma unroll
                        for (int bj = 0; bj < 2; ++bj) { const int tk = tok0 + bj * HALF;
                            store8(VGT + ((size_t)(tk >> 7) * DS + ch) * 128 + (tk & 127), gelu4(acc[ai][bj][m][0]), gelu4(acc[ai][bj][m][1])); } }
            } else {
                const int bb = tok0 >> 13;
#pragma unroll
                for (int ai = 0; ai < 2; ++ai)
#pragma unroll
                    for (int m = 0; m < 4; ++m) { const int ch = (u.pm - 4) * 256 + rl + ai * HALF + m * 16;
                        bf16_t* rowp = VT + ((size_t)(bb * NH + (ch >> 6)) * (T / 8) * 64 + (ch & 63)) * 8;
#pragma unroll
                        for (int bj = 0; bj < 2; ++bj) store8(rowp + (size_t)(((tok0 + bj * HALF) & (T - 1)) >> 3) * 512, acc[ai][bj][m][0], acc[ai][bj][m][1]); }
            }
        } else if (u.pn < 8) {
            bf16_t* base = GA + (size_t)(u.pm * 256 + rl) * DS + u.pn * 128 + cl;
#pragma unroll
            for (int ai = 0; ai < 2; ++ai)
#pragma unroll
                for (int m = 0; m < 4; ++m) {
                    const f32x4 r0 = gelu4(acc[ai][0][m][0]) * silu4(acc[ai][1][m][0]), r1 = gelu4(acc[ai][0][m][1]) * silu4(acc[ai][1][m][1]);
                    store8(base + (size_t)(ai * HALF + m * 16) * DS, r0, r1); }
        } else {
            const int t = (u.pn - 8) >> 2, colt = ((u.pn - 8) & 3) * 256;
            bf16_t* out = Qb + (size_t)t * ((size_t)M * DS);
            const int row0 = u.pm * 256 + rl;
            const int bb = row0 >> 13, t0 = row0 & (T - 1);
#define EPI_QKZ(XFORM) _Pragma("unroll") for (int bj = 0; bj < 2; ++bj) { const int col = colt + bj * HALF + cl; \
                bf16_t* base = out + ((size_t)(bb * NH + (col >> 6)) * T + t0) * 64 + (col & 63); \
                _Pragma("unroll") for (int ai = 0; ai < 2; ++ai) _Pragma("unroll") for (int m = 0; m < 4; ++m) { f32x4 v0 = acc[ai][bj][m][0], v1 = acc[ai][bj][m][1]; XFORM; \
                        store8(base + (size_t)(ai * HALF + m * 16) * 64, v0, v1); } }
            if (t == 0) { EPI_QKZ(v0 = v0 * 0.18033688011112042f; v1 = v1 * 0.18033688011112042f) }
            else if (t == 2) { EPI_QKZ(v0 = silu4(v0); v1 = silu4(v1)) }
            else { EPI_QKZ((void)0) }
#undef EPI_QKZ
        }
    }
};
struct EpiOut {
    static constexpr bool PERM = true;
    const LAS float* gate1; bf16_t* Y;
    __device__ __forceinline__ void operator()(const f32x4 (&acc)[2][2][4][2], const Unit& u, int wr, int wc, int fr, int fq) const {
        const int row0 = u.pm * BM + wr * 64 + fr, col0 = u.pn * BM + wc * 32 + 8 * fq;
        const LAS float* gp = gate1 + (u.pm >= (T / BM) ? D : 0) + col0;
        f32x4 g4[2][2];
#pragma unroll
        for (int bj = 0; bj < 2; ++bj)
#pragma unroll
            for (int n = 0; n < 2; ++n) g4[bj][n] = *(const LAS f32x4*)(gp + bj * HALF + n * 4);
#pragma unroll
        for (int ai = 0; ai < 2; ++ai)
#pragma unroll
            for (int m = 0; m < 4; ++m) { bf16_t* rowp = Y + (size_t)(row0 + ai * HALF + m * 16) * D + col0;
#pragma unroll
                for (int bj = 0; bj < 2; ++bj) store8(rowp + bj * HALF, g4[bj][0] * acc[ai][bj][m][0], g4[bj][1] * acc[ai][bj][m][1]); }
    }
};

template <class Epi, class Sched>
__device__ __forceinline__ void gemm_phase(LAS unsigned char* lds, const int tid, const Gemm g, const Sched& S, const Epi& E) {
    const int wid = __builtin_amdgcn_readfirstlane(tid >> 6), lane = tid & 63, wr = wid >> 2, wc = wid & 3, fr = lane & 15, fq = lane >> 4;
    const int K = g.K, nt = K / BK;
    unsigned voffA[2], voffB[2];
#pragma unroll
    for (int i = 0; i < 2; ++i) { int R, C; stage_rc(tid * 16 + i * 8192, R, C); const int Rb = Epi::PERM ? ((R & ~31) + perm32(R & 31)) : R;
        voffA[i] = (unsigned)(R * K + C) * 2u; voffB[i] = (unsigned)(Rb * K + C) * 2u; }
    const size_t kstep = (size_t)(BK * 2);
    const size_t hstep = (size_t)HALF * K * 2;
    const size_t tstep = 2 * hstep;
    const unsigned ldsw = (unsigned)wid * 1024u;
    const int aoff = lds_byte(wr * 64 + fr, fq * 8), boff = lds_byte(wc * 32 + fr, fq * 8);
#define PG8_SA(b, h) (((b) * 2 + (h)) * HTB)
#define PG8_SB(b, h) ((4 + (b) * 2 + (h)) * HTB)
#define PG8_STAGE(bufoff, gbase, voff) do { _Pragma("unroll") for (int _i = 0; _i < 2; ++_i) \
        __builtin_amdgcn_global_load_lds((const unsigned*)((const char*)(gbase) + (voff)[_i]), (LAS unsigned*)(lds + (bufoff) + ldsw + _i * 8192), 16, 0, 0); } while (0)
#define PG8_LDA(dst, b, h) do { _Pragma("unroll") for (int m = 0; m < 4; ++m) _Pragma("unroll") for (int k = 0; k < 2; ++k) dst[m][k] = *(const LAS bf16x8*)(lds + PG8_SA(b, h) + aoff + m * 2048 + k * 1024); } while (0)
#define PG8_LDB(dst, b, h) do { _Pragma("unroll") for (int n = 0; n < 2; ++n) _Pragma("unroll") for (int k = 0; k < 2; ++k) dst[n][k] = *(const LAS bf16x8*)(lds + PG8_SB(b, h) + boff + n * 2048 + k * 1024); } while (0)
#define PG8_MMA(ai, bj, At, Bt) do { __builtin_amdgcn_sched_barrier(0); _Pragma("unroll") for (int m = 0; m < 4; ++m) _Pragma("unroll") for (int n = 0; n < 2; ++n) _Pragma("unroll") for (int k = 0; k < 2; ++k) \
        acc[ai][bj][m][n] = __builtin_amdgcn_mfma_f32_16x16x32_bf16(Bt[n][k], At[m][k], acc[ai][bj][m][n], 0, 0, 0); __builtin_amdgcn_sched_barrier(0); } while (0)
#define PG8_WAIT_V(n) asm volatile("s_waitcnt vmcnt(" #n ")" ::: "memory")
#define PG8_WAIT_L(n) asm volatile("s_waitcnt lgkmcnt(" #n ")" ::: "memory")
#define PG8_BAR __builtin_amdgcn_s_barrier()
#define PG8_SCHED __builtin_amdgcn_sched_barrier(0)
#define PG8_UA(u) ((const char*)((u).kind ? g.A1 : g.A0) + (size_t)(u).pm * tstep)
#define PG8_UB(u) ((const char*)((u).kind ? g.B1 : g.B0) + (size_t)(u).pn * tstep)
    Unit cur, nxt; int ui = 0;
    if (!S.next(0, cur)) return;
    f32x4 acc[2][2][4][2];
#pragma unroll
    for (int a = 0; a < 2; ++a)
#pragma unroll
        for (int b = 0; b < 2; ++b)
#pragma unroll
            for (int m = 0; m < 4; ++m)
#pragma unroll
                for (int n = 0; n < 2; ++n) acc[a][b][m][n] = (f32x4){0.f, 0.f, 0.f, 0.f};
    bf16x8 At[4][2], B0[2][2], B1[2][2];
    const char* cA = PG8_UA(cur); const char* cB = PG8_UB(cur);
    PG8_STAGE(PG8_SB(0, 0), cB, voffB); PG8_STAGE(PG8_SB(0, 1), cB + hstep, voffB); PG8_STAGE(PG8_SA(0, 0), cA, voffA); PG8_STAGE(PG8_SA(0, 1), cA + hstep, voffA);
    if (wr == 1) PG8_BAR;
    PG8_WAIT_V(2); PG8_BAR;
    PG8_STAGE(PG8_SB(1, 0), cB + kstep, voffB); PG8_STAGE(PG8_SA(1, 0), cA + kstep, voffA); PG8_STAGE(PG8_SB(1, 1), cB + hstep + kstep, voffB);
    PG8_WAIT_V(6); PG8_BAR;
    for (;;) {
        const bool has_next = S.next(ui + 1, nxt);
        const char* nA = has_next ? PG8_UA(nxt) : cA; const char* nB = has_next ? PG8_UB(nxt) : cB;
        for (int t = 0; t < nt; t += 2) {
            const bool last = (t == nt - 2);
            const char* a1 = cA + (size_t)(t + 1) * kstep;
            const char* a2 = last ? nA : cA + (size_t)(t + 2) * kstep; const char* b2 = last ? nB : cB + (size_t)(t + 2) * kstep;
            const char* a3 = a2 + kstep; const char* b3 = b2 + kstep;
            PG8_LDB(B0, 0, 0); PG8_LDB(B1, 0, 1); PG8_SCHED; PG8_LDA(At, 0, 0); PG8_STAGE(PG8_SA(1, 1), a1 + hstep, voffA);
            PG8_WAIT_V(8); PG8_WAIT_L(0); PG8_BAR; PG8_MMA(0, 0, At, B0); PG8_MMA(0, 1, At, B1); PG8_BAR; PG8_SCHED;
            PG8_LDA(At, 0, 1); PG8_STAGE(PG8_SB(0, 0), b2, voffB); PG8_STAGE(PG8_SB(0, 1), b2 + hstep, voffB); PG8_STAGE(PG8_SA(0, 0), a2, voffA);
            PG8_WAIT_V(8); PG8_WAIT_L(0); PG8_BAR; PG8_MMA(1, 0, At, B0); PG8_MMA(1, 1, At, B1); PG8_BAR; PG8_SCHED;
            PG8_LDB(B0, 1, 0); PG8_LDB(B1, 1, 1); PG8_SCHED; PG8_LDA(At, 1, 0); PG8_STAGE(PG8_SA(0, 1), a2 + hstep, voffA);
            PG8_WAIT_V(8); PG8_WAIT_L(0); PG8_BAR; PG8_MMA(0, 0, At, B0); PG8_MMA(0, 1, At, B1); PG8_BAR; PG8_SCHED;
            PG8_LDA(At, 1, 1); PG8_STAGE(PG8_SB(1, 0), b3, voffB); PG8_STAGE(PG8_SB(1, 1), b3 + hstep, voffB); PG8_STAGE(PG8_SA(1, 0), a3, voffA);
            PG8_WAIT_V(8); PG8_WAIT_L(0); PG8_BAR; PG8_MMA(1, 0, At, B0); PG8_MMA(1, 1, At, B1); PG8_BAR; PG8_SCHED;
        }
        if (wr == 0) PG8_BAR;
        E(acc, cur, wr, wc, fr, fq);
        if (!has_next) break;
#pragma unroll
        for (int a = 0; a < 2; ++a)
#pragma unroll
            for (int b = 0; b < 2; ++b)
#pragma unroll
                for (int m = 0; m < 4; ++m)
#pragma unroll
                    for (int n = 0; n < 2; ++n) acc[a][b][m][n] = (f32x4){0.f, 0.f, 0.f, 0.f};
        cur = nxt; cA = nA; cB = nB; ++ui;
        if (wr == 1) PG8_BAR;
    }
    PG8_WAIT_V(0);
    PG8_BAR;
#undef PG8_SA
#undef PG8_SB
#undef PG8_STAGE
#undef PG8_LDA
#undef PG8_LDB
#undef PG8_MMA
#undef PG8_WAIT_V
#undef PG8_WAIT_L
#undef PG8_BAR
#undef PG8_SCHED
#undef PG8_UA
#undef PG8_UB
}
}

constexpr size_t MiB = 1u << 20;
constexpr size_t WS_CTL = 0, CTL_ZERO_BYTES = 64 * 1024;
constexpr size_t WS_MOD = 1 * MiB;
constexpr size_t WS_WSB = 1 * MiB + 512 * 1024;
constexpr size_t WS_WIN = 2 * MiB;
constexpr size_t WS_WOUT = 58 * MiB;
constexpr size_t WS_H = 80 * MiB;
constexpr size_t WS_GA = 144 * MiB, WS_VG = 176 * MiB, WS_Q = 208 * MiB, WS_K = 240 * MiB, WS_ZB = 272 * MiB, WS_VT = 304 * MiB;
constexpr size_t WS_Y = 144 * MiB;
constexpr size_t WS_Y0 = 336 * MiB;
constexpr size_t WS_END = 400 * MiB;
static_assert(WS_K - WS_Q == (size_t)M * DS * 2 && WS_ZB - WS_K == (size_t)M * DS * 2, "EpiProj indexes Q|K|ZB as one array");
static_assert((4096 + 3 * 3456) * 4 <= 64 * 1024, "control words inside the memset region");
constexpr int CW_BAR = 4096, CW_HANDOFF = 64;

constexpr int RING_BYTES = 131072, LDS_BYTES = 163840, LDSCTL_OFF = LDS_BYTES - 1024, MISC_OFF = LDSCTL_OFF + 320;

typedef GAS unsigned gu32;
#define RLX_AGENT __ATOMIC_RELAXED, __HIP_MEMORY_SCOPE_AGENT
#define LDS_WAIT() asm volatile("s_waitcnt lgkmcnt(0)" ::: "memory")

#define XB_TMO      128
#define XB_XCNT(j)  (256  + 64 * (j))
#define XB_XSUB(j)  (1280 + 64 * (j))
#define XB_XGEN(j)  (2304 + 64 * (j))
#define XB_TOP      3328
#define XB_TOPGEN   3392
#define XCD_BAR_WORDS 3456
#define XB_SPIN_CAP (1u << 18)
__device__ __forceinline__ unsigned xb_ld(unsigned* p)              { return __hip_atomic_load(p, __ATOMIC_RELAXED, __HIP_MEMORY_SCOPE_AGENT); }
__device__ __forceinline__ unsigned xb_add(unsigned* p, unsigned v) { return __hip_atomic_fetch_add(p, v, __ATOMIC_RELAXED, __HIP_MEMORY_SCOPE_AGENT); }
__device__ __forceinline__ unsigned xb_xcc_id() { return (unsigned)__builtin_amdgcn_s_getreg((3 << 11) | 20) & 0xFu; }
#define XB_SPIN(cond, bar) do { unsigned _sp = 0; while (cond) { __builtin_amdgcn_s_sleep(1); \
    if ((++_sp & 255u) == 0u) { if (xb_ld(&(bar)[XB_TMO])) break; if (_sp > XB_SPIN_CAP) { atomicAdd(&(bar)[XB_TMO], 1u); break; } } } } while (0)
struct XcdBarrier { unsigned* bar; unsigned x; volatile LAS unsigned* st; unsigned expect; };
__device__ __forceinline__ XcdBarrier xcd_barrier_post(unsigned* bar, volatile LAS unsigned* st, unsigned expect) {
    XcdBarrier b; b.bar = bar; b.x = xb_xcc_id(); b.st = st; b.expect = expect;
    if (threadIdx.x == 0) (void)xb_add(&bar[XB_XCNT(b.x)], 1u);
    return b;
}
__device__ __forceinline__ void xcd_barrier_complete(unsigned* bar, unsigned x, unsigned G, unsigned& nloc, unsigned& nx) {
    unsigned sum, cnt, mine, sp = 0u;
    for (;;) {
        sum = 0u; cnt = 0u; mine = 0u;
#pragma unroll
        for (unsigned j = 0; j < 16; ++j) { const unsigned c = xb_ld(&bar[XB_XCNT(j)]); sum += c; cnt += (c > 0u) ? 1u : 0u; mine = (j == x) ? c : mine; }
        if (sum == G) break;
        __builtin_amdgcn_s_sleep(1);
        if ((++sp & 255u) == 0u) { if (xb_ld(&bar[XB_TMO])) break; if (sp > XB_SPIN_CAP) { atomicAdd(&bar[XB_TMO], 1u); break; } }
    }
    nloc = mine > 0u ? mine : 1u; nx = cnt > 0u ? cnt : 1u;
}
__device__ __forceinline__ void xcd_barrier(const XcdBarrier& b) {
    asm volatile("s_waitcnt vmcnt(0)" ::: "memory");
    __syncthreads();
    if (threadIdx.x == 0) {
        unsigned* bar = b.bar;
        __builtin_amdgcn_s_waitcnt(0);
        unsigned nloc = b.st[0], nx = b.st[1];
        if (nloc == 0u) { xcd_barrier_complete(bar, b.x, b.expect, nloc, nx); b.st[0] = nloc; b.st[1] = nx; }
        const unsigned old = xb_add(&bar[XB_XSUB(b.x)], 1u);
        const unsigned gen = old / nloc;
        if (old + 1u == (gen + 1u) * nloc) {
            __builtin_amdgcn_fence(__ATOMIC_RELEASE, "agent");
            asm volatile("s_waitcnt vmcnt(0)" ::: "memory");
            const unsigned og = xb_add(&bar[XB_TOP], 1u);
            const unsigned tg = og / nx;
            if (og + 1u == (tg + 1u) * nx) xb_add(&bar[XB_TOPGEN], 1u);
            else XB_SPIN(xb_ld(&bar[XB_TOPGEN]) == tg, bar);
            __builtin_amdgcn_fence(__ATOMIC_ACQUIRE, "agent");
            xb_add(&bar[XB_XGEN(b.x)], 1u);
            asm volatile("s_waitcnt vmcnt(0)" ::: "memory");
        } else {
            XB_SPIN(xb_ld(&bar[XB_XGEN(b.x)]) == gen, bar);
            __builtin_amdgcn_fence(__ATOMIC_ACQUIRE, "agent");
            asm volatile("s_waitcnt vmcnt(0)" ::: "memory");
        }
    }
    __syncthreads();
}

struct Frame {
    LAS unsigned char* lds;
    int tid, lane, wave, vcu, G;
};

#define DPP_ADD(v, ctrl) ((v) + __builtin_bit_cast(float, __builtin_amdgcn_update_dpp(0, __builtin_bit_cast(int, (v)), (ctrl), 0xf, 0xf, true)))
__device__ __forceinline__ float wave_sum(float v) {
    v = DPP_ADD(v, 0xB1);
    v = DPP_ADD(v, 0x4E);
    v = DPP_ADD(v, 0x141);
    v = DPP_ADD(v, 0x140);
    const int vi = __builtin_bit_cast(int, v);
    const float r0 = __builtin_bit_cast(float, __builtin_amdgcn_readlane(vi, 0)), r1 = __builtin_bit_cast(float, __builtin_amdgcn_readlane(vi, 16));
    const float r2 = __builtin_bit_cast(float, __builtin_amdgcn_readlane(vi, 32)), r3 = __builtin_bit_cast(float, __builtin_amdgcn_readlane(vi, 48));
    return (r0 + r1) + (r2 + r3);
}

__device__ __forceinline__ void p0_transpose_item(const float* W, int N, bf16_t* WT, int K, int k0, int n0, int drow0, LAS float* scr, int lane) {
#pragma unroll 8
    for (int i = 0; i < 32; ++i) { const int kk = 2 * i + (lane >> 5); scr[kk * 33 + (lane & 31)] = __builtin_nontemporal_load(W + (size_t)(k0 + kk) * N + n0 + (lane & 31)); }
    LDS_WAIT(); asm volatile("" ::: "memory");
    const int c = lane & 7;
#pragma unroll
    for (int j = 0; j < 4; ++j) { const int n = (lane >> 3) + 8 * j; const LAS float* s = scr + (8 * c) * 33 + n;
        u32x4 o; o.x = cvt_pk_bf16(s[0 * 33], s[1 * 33]); o.y = cvt_pk_bf16(s[2 * 33], s[3 * 33]); o.z = cvt_pk_bf16(s[4 * 33], s[5 * 33]); o.w = cvt_pk_bf16(s[6 * 33], s[7 * 33]);
        *(u32x4*)(WT + (size_t)(drow0 + n) * K + k0 + 8 * c) = o; }
    LDS_WAIT(); asm volatile("" ::: "memory");
}
__device__ __forceinline__ int win_dest_row(int n0) {
    const int s = n0 >> 10, ch = n0 & 1023;
    switch (s) {
        case 0: return 256 * (ch >> 7) + (ch & 127);
        case 1: return 5120 + ch;
        case 2: return 256 * (ch >> 7) + 128 + (ch & 127);
        case 3: return 2048 + ch;
        case 4: return 3072 + ch;
        case 5: return 6144 + ch;
        default: return 4096 + ch;
    }
}
__device__ __forceinline__ void p0_weights(const Frame& F, const float* w_in, const float* w_out, bf16_t* WIN, bf16_t* WOUT, int l, int gw, int NGW) {
    LAS float* scr = (LAS float*)(F.lds + F.wave * 16384);
    constexpr int I_IN = (D / 64) * (DIN / 32), I_OUT = (D / 64) * (D / 32), I_L = I_IN + I_OUT;
    for (int it = gw; it < I_L; it += NGW) {
        int r = it;
        if (r < I_IN) { const int kb = r / (DIN / 32), nb = r % (DIN / 32);
            p0_transpose_item(w_in + (size_t)l * D * DIN, DIN, WIN + (size_t)l * DIN * D, D, 64 * kb, 32 * nb, win_dest_row(32 * nb), scr, F.lane); }
        else { r -= I_IN; const int kb = r / (D / 32), nb = r % (D / 32);
            p0_transpose_item(w_out + (size_t)l * D * D, D, WOUT + (size_t)l * D * D, D, 64 * kb, 32 * nb, 32 * nb, scr, F.lane); }
    }
}
__device__ __forceinline__ void p0_prologue(const Frame& F, const float* c_in, const float* w_ada, const float* b_ada, const float* w_in, const float* w_out, const float* w_sp,
                                            float* MOD, bf16_t* WIN, bf16_t* WOUT, bf16_t* WSB) {
    LAS float* sc = (LAS float*)F.lds;
    LAS float* red = (LAS float*)(F.lds + 16384);
    constexpr int NCH = 48, NIT = NMOD / NCH;
    for (int it = F.vcu; it < DEPTH * NIT; it += F.G) {
        for (int i = F.tid; i < BATCH * D; i += 512) sc[i] = silu_f(c_in[i]);
        __syncthreads();
        const int l = it / NIT, n0 = (it % NIT) * NCH;
        const int ln = F.lane < NCH ? F.lane : NCH - 1;
        const float* W = w_ada + (size_t)l * D * NMOD + n0 + ln;
        const int k0 = F.wave * 256;
        float a0 = 0.f, a1 = 0.f;
#pragma unroll 16
        for (int k = 0; k < 256; ++k) { const float w = __builtin_nontemporal_load(W + (size_t)(k0 + k) * NMOD); a0 += sc[k0 + k] * w; a1 += sc[D + k0 + k] * w; }
        red[(F.wave * 2 + 0) * 64 + F.lane] = a0; red[(F.wave * 2 + 1) * 64 + F.lane] = a1;
        __syncthreads();
        if (F.tid < 128 && (F.tid & 63) < NCH) { const int b = F.tid >> 6, lc = F.tid & 63; float s = 0.f;
#pragma unroll
            for (int w = 0; w < 8; ++w) s += red[(w * 2 + b) * 64 + lc];
            MOD[(size_t)(l * BATCH + b) * NMOD + n0 + lc] = s + b_ada[(size_t)l * NMOD + n0 + lc]; }
        __syncthreads();
    }
    p0_weights(F, w_in, w_out, WIN, WOUT, 0, F.vcu * 8 + F.wave, F.G * 8);
    const int gw = F.vcu * 8 + F.wave, NGW = F.G * 8;
    for (int i = (gw * 64 + F.lane) * 4; i < DEPTH * NG * 128 * 128; i += NGW * 64 * 4) { const f32x4 v = *(const f32x4*)(w_sp + i); u32x2 o; o.x = cvt_pk_bf16(v[0], v[1]); o.y = cvt_pk_bf16(v[2], v[3]); *(u32x2*)(WSB + i) = o; }
}

__device__ __forceinline__ void lds_sync() { asm volatile("s_waitcnt lgkmcnt(0)" ::: "memory"); __builtin_amdgcn_s_barrier(); asm volatile("" ::: "memory"); }
struct LnStage { const bf16_t* y; const float* g; const float* b; };
__device__ __forceinline__ void ln_row_norm(f32x4 (&v)[8], float& rstd) {
    float s = 0.f;
#pragma unroll
    for (int j = 0; j < 8; ++j) s += (v[j][0] + v[j][1]) + (v[j][2] + v[j][3]);
    const float mean = wave_sum(s) * (1.f / D); float s2 = 0.f;
#pragma unroll
    for (int j = 0; j < 8; ++j) { v[j] = v[j] - mean; s2 += (v[j][0] * v[j][0] + v[j][1] * v[j][1]) + (v[j][2] * v[j][2] + v[j][3] * v[j][3]); }
    rstd = __builtin_amdgcn_rsqf(wave_sum(s2) * (1.f / D) + LN_EPS);
}
__device__ __forceinline__ void ln_phase(const Frame& F, const float* src, const LnStage sa, const LnStage sb, float* xout, bool has_h, const float* modn, bf16_t* H) {
    LAS float* tga = (LAS float*)F.lds;
    LAS float* tba = tga + D; LAS float* tgb = tba + D; LAS float* tbb = tgb + D; LAS float* ts = tbb + D; LAS float* th = ts + D;
    for (int rb = F.vcu; rb < M / 64; rb += F.G) {
        const int bat = (rb * 64) / T;
        f32x4 v[8]; u32x2 ya[8], yb[8];
        auto load_row = [&](int i) __attribute__((always_inline)) {
            const size_t row = (size_t)rb * 64 + F.wave * 8 + i;
            const f32x4* xr = (const f32x4*)(src + row * D) + F.lane;
#pragma unroll
            for (int j = 0; j < 8; ++j) v[j] = __builtin_nontemporal_load(xr + 64 * j);
            if (sa.y) { const u32x2* yr = (const u32x2*)(sa.y + row * D) + F.lane;
#pragma unroll
                for (int j = 0; j < 8; ++j) ya[j] = yr[64 * j]; }
            if (sb.y) { const u32x2* yr = (const u32x2*)(sb.y + row * D) + F.lane;
#pragma unroll
                for (int j = 0; j < 8; ++j) yb[j] = yr[64 * j]; }
        };
        __syncthreads();
        {
            float tv[4][6];
#pragma unroll
            for (int q = 0; q < 4; ++q) { const int i = F.tid + 512 * q;
                if (sa.y) { tv[q][0] = sa.g[i]; tv[q][1] = sa.b[i]; }
                if (sb.y) { tv[q][2] = sb.g[i]; tv[q][3] = sb.b[i]; }
                if (has_h) { tv[q][4] = modn[(size_t)bat * NMOD + i]; tv[q][5] = modn[(size_t)bat * NMOD + D + i]; } }
            load_row(0);
#pragma unroll
            for (int q = 0; q < 4; ++q) { const int i = F.tid + 512 * q;
                if (sa.y) { tga[i] = tv[q][0]; tba[i] = tv[q][1]; }
                if (sb.y) { tgb[i] = tv[q][2]; tbb[i] = tv[q][3]; }
                if (has_h) { th[i] = tv[q][4]; ts[i] = 1.0f + tv[q][5]; } }
        }
        lds_sync();
        for (int i = 0; i < 8; ++i) {
            const size_t row = (size_t)rb * 64 + F.wave * 8 + i;
            if (i > 0) load_row(i);
            if (sa.y) {
#pragma unroll
                for (int j = 0; j < 8; ++j) v[j] = v[j] * DN_ALPHA + (f32x4){bf_lo(ya[j].x), bf_hi(ya[j].x), bf_lo(ya[j].y), bf_hi(ya[j].y)};
                float rstd; ln_row_norm(v, rstd);
#pragma unroll
                for (int j = 0; j < 8; ++j) v[j] = v[j] * rstd * *(const LAS f32x4*)(tga + 4 * F.lane + 256 * j) + *(const LAS f32x4*)(tba + 4 * F.lane + 256 * j);
            }
            if (sb.y) {
#pragma unroll
                for (int j = 0; j < 8; ++j) v[j] = v[j] * DN_ALPHA + (f32x4){bf_lo(yb[j].x), bf_hi(yb[j].x), bf_lo(yb[j].y), bf_hi(yb[j].y)};
                float rstd; ln_row_norm(v, rstd);
#pragma unroll
                for (int j = 0; j < 8; ++j) v[j] = v[j] * rstd * *(const LAS f32x4*)(tgb + 4 * F.lane + 256 * j) + *(const LAS f32x4*)(tbb + 4 * F.lane + 256 * j);
            }
            if (xout) { f32x4* xo = (f32x4*)(xout + row * D) + F.lane;
#pragma unroll
                for (int j = 0; j < 8; ++j) __builtin_nontemporal_store(v[j], xo + 64 * j); }
            if (has_h) {
                float rstd; ln_row_norm(v, rstd);
                u32x2* ho = (u32x2*)(H + row * D) + F.lane;
#pragma unroll
                for (int j = 0; j < 8; ++j) { const f32x4 o = v[j] * rstd * *(const LAS f32x4*)(ts + 4 * F.lane + 256 * j) + *(const LAS f32x4*)(th + 4 * F.lane + 256 * j);
                    u32x2 w; w.x = cvt_pk_bf16(o[0], o[1]); w.y = cvt_pk_bf16(o[2], o[3]); ho[64 * j] = w; }
            }
        }
    }
    __syncthreads();
}

struct AttnPtrs { const float* rpb; const bf16_t *Qb, *Kb, *VT, *ZB; bf16_t* YC; };
constexpr int AK_OFF = 0, AV_OFF = 73728, ATT_BIAS_OFF = 147456;
static_assert(ATT_BIAS_OFF + 15 * 32 * 4 <= LDSCTL_OFF, "attention LDS map");
static_assert(DEPTH == 2, "the LN phases chain exactly two DeepNorm stages");
__device__ __forceinline__ int kswz(int key) { return ((key >> 1) & 1) | (((key >> 3) & 3) << 1); }
__device__ __forceinline__ int rstart(int r) { return min(max(r - 4, 0), 120); }
struct AttnPre { u32x4 kv[9], vv[9]; };
template <bool VPART>
__device__ __forceinline__ void attn_issue(const Frame& F, const AttnPtrs& P, int item, AttnPre& A) {
    const int bh = item >> 3, r0 = 16 * (item & 7);
    const bf16_t* g = (VPART ? P.VT : P.Kb) + (size_t)bh * T * 64 + F.tid * 8;
    const int lo = rstart(r0);
#pragma unroll
    for (int i = 0; i < 9; ++i) { const int kr = min(lo + i, T / 64 - 1); const u32x4 w = *(const u32x4*)(g + (size_t)kr * 4096); if (VPART) A.vv[i] = w; else A.kv[i] = w; }
}

constexpr int SG_LDP = 136;
constexpr int SG_W_OFF = 0, SG_VT_OFF = 34816, SG_GY_OFF = 69632, SG_RED_OFF = 104448, SG_STAT_OFF = SG_RED_OFF + 8192;
template <bool B> struct BoolTag { static constexpr bool value = B; };
__device__ __forceinline__ void sgu_phase(const Frame& F, int l, const float* sgu_g, const float* sgu_b, const float* b_sp, const bf16_t* WSB, const bf16_t* VGT, const bf16_t* GA, bf16_t* YC, const AttnPtrs& AP, AttnPre& A) {
    LAS bf16_t* wl = (LAS bf16_t*)(F.lds + SG_W_OFF);
    LAS bf16_t* vt = (LAS bf16_t*)(F.lds + SG_VT_OFF);
    LAS bf16_t* gy = (LAS bf16_t*)(F.lds + SG_GY_OFF);
    LAS float* red = (LAS float*)(F.lds + SG_RED_OFF);
    LAS float* stat = (LAS float*)(F.lds + SG_STAT_OFF);
    const int fr = F.lane & 15, fq = F.lane >> 4;
    const int chunk = F.tid & 15, rq = F.tid >> 4;
    const int hG = F.G / 2, hf = F.vcu / hG, vl = F.vcu % hG, nitems = NG * (T / 128);
    const int per = (nitems + hG - 1) / hG;
    const int s0 = vl * per, n_my = max(0, min(per, nitems - s0));
    u32x4 vw[4], gv[4];
    float gam[4], bet[4];
    LAS float* bl = stat + 256;
    { const int sc = min(s0, nitems - 1), g = sc / (T / 128), bn = hf * (T / 128) + sc % (T / 128);
#pragma unroll
      for (int j = 0; j < 4; ++j) { vw[j] = *(const u32x4*)(VGT + ((size_t)bn * DS + g * 128 + rq + 32 * j) * 128 + 8 * chunk); gv[j] = *(const u32x4*)(GA + ((size_t)bn * 128 + rq + 32 * j) * DS + g * 128 + 8 * chunk); } }
    auto load_group = [&](int g) __attribute__((always_inline)) {
            const bf16_t* Wg = WSB + ((size_t)l * NG + g) * 128 * 128;
            u32x4 wv[4];
#pragma unroll
            for (int j = 0; j < 4; ++j) wv[j] = *(const u32x4*)(Wg + (rq + 32 * j) * 128 + 8 * chunk);
#pragma unroll
            for (int j = 0; j < 4; ++j) { gam[j] = sgu_g[(size_t)l * DS + g * 128 + rq + 32 * j]; bet[j] = sgu_b[(size_t)l * DS + g * 128 + rq + 32 * j]; }
            if (F.tid < 128) bl[F.tid] = b_sp[((size_t)l * NG + g) * 128 + F.tid];
#pragma unroll
            for (int j = 0; j < 4; ++j) *(LAS u32x4*)(wl + (rq + 32 * j) * SG_LDP + 8 * chunk) = wv[j];
    };
    auto item_body = [&](int s, int g, auto last_tag) __attribute__((always_inline)) {
        const int bn = hf * (T / 128) + s % (T / 128);
        const size_t m0 = (size_t)bn * 128;
#pragma unroll
        for (int j = 0; j < 4; ++j) *(LAS u32x4*)(gy + (rq + 32 * j) * SG_LDP + 8 * chunk) = gv[j];
        float x[4][8], s1[8], s2[8];
#pragma unroll
        for (int j = 0; j < 4; ++j) { x[j][0] = bf_lo(vw[j].x); x[j][1] = bf_hi(vw[j].x); x[j][2] = bf_lo(vw[j].y); x[j][3] = bf_hi(vw[j].y); x[j][4] = bf_lo(vw[j].z); x[j][5] = bf_hi(vw[j].z); x[j][6] = bf_lo(vw[j].w); x[j][7] = bf_hi(vw[j].w); }
        if constexpr (decltype(last_tag)::value) attn_issue<false>(F, AP, F.vcu, A);
        else { const int sn = s + 1, gn = sn / (T / 128), bnn = hf * (T / 128) + sn % (T / 128);
#pragma unroll
          for (int j = 0; j < 4; ++j) { vw[j] = *(const u32x4*)(VGT + ((size_t)bnn * DS + gn * 128 + rq + 32 * j) * 128 + 8 * chunk); gv[j] = *(const u32x4*)(GA + ((size_t)bnn * 128 + rq + 32 * j) * DS + gn * 128 + 8 * chunk); } }
#pragma unroll
        for (int e = 0; e < 8; ++e) { s1[e] = (x[0][e] + x[1][e]) + (x[2][e] + x[3][e]); s2[e] = (x[0][e] * x[0][e] + x[1][e] * x[1][e]) + (x[2][e] * x[2][e] + x[3][e] * x[3][e]);
            s1[e] += __shfl_xor(s1[e], 16); s1[e] += __shfl_xor(s1[e], 32); s2[e] += __shfl_xor(s2[e], 16); s2[e] += __shfl_xor(s2[e], 32); }
        if (fq == 0) {
            *(LAS f32x4*)(red + (F.wave * 2 + 0) * 128 + 8 * chunk) = (f32x4){s1[0], s1[1], s1[2], s1[3]}; *(LAS f32x4*)(red + (F.wave * 2 + 0) * 128 + 8 * chunk + 4) = (f32x4){s1[4], s1[5], s1[6], s1[7]};
            *(LAS f32x4*)(red + (F.wave * 2 + 1) * 128 + 8 * chunk) = (f32x4){s2[0], s2[1], s2[2], s2[3]}; *(LAS f32x4*)(red + (F.wave * 2 + 1) * 128 + 8 * chunk + 4) = (f32x4){s2[4], s2[5], s2[6], s2[7]};
        }
        lds_sync();
        if (F.tid < 128) { float a1 = 0.f, a2 = 0.f;
#pragma unroll
            for (int w = 0; w < 8; ++w) { a1 += red[(w * 2 + 0) * 128 + F.tid]; a2 += red[(w * 2 + 1) * 128 + F.tid]; }
            const float mean = a1 * (1.f / 128.f); const float var = fmaxf(a2 * (1.f / 128.f) - mean * mean, 0.f);
            stat[2 * F.tid] = mean; stat[2 * F.tid + 1] = __builtin_amdgcn_rsqf(var + LN_EPS); }
        lds_sync();
        {
            float mu[8], rs[8];
#pragma unroll
            for (int e = 0; e < 8; e += 2) { const f32x4 st4 = *(const LAS f32x4*)(stat + 2 * (8 * chunk + e)); mu[e] = st4[0]; rs[e] = st4[1]; mu[e + 1] = st4[2]; rs[e + 1] = st4[3]; }
#pragma unroll
            for (int j = 0; j < 4; ++j) { u32x4 o;
                o.x = cvt_pk_bf16((x[j][0] - mu[0]) * rs[0] * gam[j] + bet[j], (x[j][1] - mu[1]) * rs[1] * gam[j] + bet[j]);
                o.y = cvt_pk_bf16((x[j][2] - mu[2]) * rs[2] * gam[j] + bet[j], (x[j][3] - mu[3]) * rs[3] * gam[j] + bet[j]);
                o.z = cvt_pk_bf16((x[j][4] - mu[4]) * rs[4] * gam[j] + bet[j], (x[j][5] - mu[5]) * rs[5] * gam[j] + bet[j]);
                o.w = cvt_pk_bf16((x[j][6] - mu[6]) * rs[6] * gam[j] + bet[j], (x[j][7] - mu[7]) * rs[7] * gam[j] + bet[j]);
                *(LAS u32x4*)(vt + (rq + 32 * j) * SG_LDP + 8 * chunk) = o; }
        }
        lds_sync();
        {
            bf16x8 af[4];
#pragma unroll
            for (int ks = 0; ks < 4; ++ks) af[ks] = *(const LAS bf16x8*)(vt + (16 * F.wave + fr) * SG_LDP + 32 * ks + 8 * fq);
#pragma unroll
            for (int nt = 0; nt < 8; ++nt) {
                f32x4 acc = {0.f, 0.f, 0.f, 0.f};
#pragma unroll
                for (int ks = 0; ks < 4; ++ks) { const bf16x8 bfrag = *(const LAS bf16x8*)(wl + (16 * nt + fr) * SG_LDP + 32 * ks + 8 * fq);
                    acc = __builtin_amdgcn_mfma_f32_16x16x32_bf16(af[ks], bfrag, acc, 0, 0, 0); }
                const int p = 16 * nt + fr;
                const float bs = bl[p];
                LAS u32x2* gp = (LAS u32x2*)(gy + p * SG_LDP + 16 * F.wave + 4 * fq);
                const u32x2 gaw = *gp;
                u32x2 o; o.x = cvt_pk_bf16(bf_lo(gaw.x) * (acc[0] + bs), bf_hi(gaw.x) * (acc[1] + bs)); o.y = cvt_pk_bf16(bf_lo(gaw.y) * (acc[2] + bs), bf_hi(gaw.y) * (acc[3] + bs));
                *gp = o;
            }
        }
        lds_sync();
#pragma unroll
        for (int j = 0; j < 4; ++j) { const int p = rq + 32 * j; *(u32x4*)(YC + (m0 + p) * D + g * 128 + 8 * chunk) = *(const LAS u32x4*)(gy + p * SG_LDP + 8 * chunk); }
    };
    int ii = 0, g_cur = -1;
    while (ii < n_my - 1) {
        const int g = (s0 + ii) / (T / 128);
        lds_sync();
        load_group(g); g_cur = g;
        for (bool first = true; ii < n_my - 1 && (s0 + ii) / (T / 128) == g; ++ii, first = false) { if (!first) lds_sync(); item_body(s0 + ii, g, BoolTag<false>{}); }
    }
    if (n_my > 0) { const int s = s0 + n_my - 1, g = s / (T / 128);
        lds_sync();
        if (g != g_cur) load_group(g);
        item_body(s, g, BoolTag<true>{}); }
    else attn_issue<false>(F, AP, F.vcu, A);
    __syncthreads();
}

__device__ __forceinline__ void attn_phase(const Frame& F, const AttnPtrs& P, int l, AttnPre& A) {
    const int kwr = (F.tid >> 3) * 128 + (((F.tid & 7) ^ kswz(F.tid >> 3)) << 4);
    const LAS float* rp = (const LAS float*)(F.lds + ATT_BIAS_OFF);
    for (int item = F.vcu; item < BATCH * NH * 8; item += F.G) {
        const int bh = item >> 3, r0 = 16 * (item & 7), b = bh >> 4, h = bh & 15;
        const size_t hb = (size_t)bh * T;
        attn_issue<true>(F, P, item, A);
        __syncthreads();
        { const int lo = rstart(r0), hi = rstart(r0 + 1) + 8;
#pragma unroll
            for (int i = 0; i < 9; ++i) if (lo + i < hi) { const int slot = (lo + i) % 9;
                *(LAS u32x4*)(F.lds + AK_OFF + slot * 8192 + kwr) = A.kv[i]; *(LAS u32x4*)(F.lds + AV_OFF + slot * 8192 + F.tid * 16) = A.vv[i]; } }
        int lane_ = F.lane; asm volatile("" : "+v"(lane_));
        const int fr = lane_ & 15, fq = lane_ >> 4, cb = F.wave & 3, rsel = F.wave >> 2;
        const int bs = min(max(16 * cb - 8, 0), 32);
        const int qcol = 16 * cb + fr;
        const int wst = min(max(qcol - 8, 0), 48);
        int ci[2][4];
#pragma unroll
        for (int X = 0; X < 2; ++X)
#pragma unroll
            for (int e = 0; e < 4; ++e) { const int kc = bs + 8 * fq + 4 * X + e; ci[X][e] = ((kc >= wst) && (kc < wst + 16)) ? min(max(kc - qcol + 15, 0), 30) : 31; }
        int koff[2][2];
#pragma unroll
        for (int X = 0; X < 2; ++X) { const int key = bs + 8 * (fr >> 2) + 4 * X + (fr & 3);
#pragma unroll
            for (int ks = 0; ks < 2; ++ks) koff[X][ks] = key * 128 + (((ks * 4 + fq) ^ kswz(key)) << 4); }
        const int voff = (((bs >> 3) + fq) * 64 + fr) * 16;
        const bf16_t* Kg = P.Kb + hb * 64 + F.tid * 8;
        const bf16_t* Vg = P.VT + hb * 64 + F.tid * 8;
        bf16_t* yb = P.YC + ((size_t)b * T + qcol) * D + DS + h * 64 + 4 * fq;
        for (int i = F.tid; i < 15 * 32; i += 512) ((LAS float*)(F.lds + ATT_BIAS_OFF))[i] = (i & 31) == 31 ? -1.0e30f : P.rpb[((size_t)l * NH + h) * 15 * 31 + (i >> 5) * 31 + (i & 31)] * 1.4426950408889634f;
        bf16x8 qf[2]; u32x2 zw[4];
        { const size_t tk = hb + (r0 + rsel) * 64 + qcol;
#pragma unroll
            for (int ks = 0; ks < 2; ++ks) qf[ks] = *(const bf16x8*)(P.Qb + tk * 64 + 32 * ks + 8 * fq);
#pragma unroll
            for (int d = 0; d < 4; ++d) zw[d] = *(const u32x2*)(P.ZB + tk * 64 + 16 * d + 4 * fq); }
        u32x2 yw[4];
        __syncthreads();
        for (int st = 0; st < 8; ++st) {
            const int ra = r0 + 2 * st, r = ra + rsel, rs = rstart(r);
            if (st > 0) {
#pragma unroll
                for (int d = 0; d < 4; ++d) *(u32x2*)(yb + (size_t)(r - 2) * 64 * D + 16 * d) = yw[d]; }
            const int nlo = rstart(ra + 1) + 8, nhi = (st < 7) ? rstart(ra + 3) + 7 : -1;
            const int kr0 = min(nlo, T / 64 - 1), kr1 = min(nlo + 1, T / 64 - 1);
            const u32x4 pk0 = *(const u32x4*)(Kg + (size_t)kr0 * 4096), pv0 = *(const u32x4*)(Vg + (size_t)kr0 * 4096);
            const u32x4 pk1 = *(const u32x4*)(Kg + (size_t)kr1 * 4096), pv1 = *(const u32x4*)(Vg + (size_t)kr1 * 4096);
            const size_t tkn = hb + min(r + 2, T / 64 - 1) * 64 + qcol;
            bf16x8 qn[2]; u32x2 zn[4];
#pragma unroll
            for (int ks = 0; ks < 2; ++ks) qn[ks] = *(const bf16x8*)(P.Qb + tkn * 64 + 32 * ks + 8 * fq);
#pragma unroll
            for (int d = 0; d < 4; ++d) zn[d] = *(const u32x2*)(P.ZB + tkn * 64 + 16 * d + 4 * fq);
            float s[8][2][4];
            float mx = -3.0e38f;
#pragma unroll
            for (int i = 0; i < 8; ++i) {
                const LAS float* rpi = rp + (rs + i - r + 7) * 32;
                const LAS unsigned char* kb = F.lds + AK_OFF + ((rs + i) % 9) * 8192;
#pragma unroll
                for (int X = 0; X < 2; ++X) {
                    f32x4 c = {rpi[ci[X][0]], rpi[ci[X][1]], rpi[ci[X][2]], rpi[ci[X][3]]};
#pragma unroll
                    for (int ks = 0; ks < 2; ++ks) c = __builtin_amdgcn_mfma_f32_16x16x32_bf16(*(const LAS bf16x8*)(kb + koff[X][ks]), qf[ks], c, 0, 0, 0);
                    s[i][X][0] = c[0]; s[i][X][1] = c[1]; s[i][X][2] = c[2]; s[i][X][3] = c[3];
                    mx = fmaxf(fmaxf(mx, c[0]), c[1]); mx = fmaxf(fmaxf(mx, c[2]), c[3]);
                }
            }
            mx = fmaxf(mx, __shfl_xor(mx, 16)); mx = fmaxf(mx, __shfl_xor(mx, 32));
#pragma unroll
            for (int i = 0; i < 8; ++i)
#pragma unroll
                for (int X = 0; X < 2; ++X)
#pragma unroll
                    for (int e = 0; e < 4; ++e) s[i][X][e] = __builtin_amdgcn_exp2f(s[i][X][e] - mx);
            f32x4 o[4], osum = {0.f, 0.f, 0.f, 0.f};
#pragma unroll
            for (int d = 0; d < 4; ++d) o[d] = (f32x4){0.f, 0.f, 0.f, 0.f};
            const bf16x8 ones = {0x3F80, 0x3F80, 0x3F80, 0x3F80, 0x3F80, 0x3F80, 0x3F80, 0x3F80};
#pragma unroll
            for (int i = 0; i < 8; ++i) {
                union { u32x4 u; bf16x8 v; } pb;
                pb.u.x = cvt_pk_bf16(s[i][0][0], s[i][0][1]); pb.u.y = cvt_pk_bf16(s[i][0][2], s[i][0][3]); pb.u.z = cvt_pk_bf16(s[i][1][0], s[i][1][1]); pb.u.w = cvt_pk_bf16(s[i][1][2], s[i][1][3]);
                const LAS unsigned char* vb = F.lds + AV_OFF + ((rs + i) % 9) * 8192 + voff;
#pragma unroll
                for (int d = 0; d < 4; ++d) o[d] = __builtin_amdgcn_mfma_f32_16x16x32_bf16(*(const LAS bf16x8*)(vb + d * 256), pb.v, o[d], 0, 0, 0);
                osum = __builtin_amdgcn_mfma_f32_16x16x32_bf16(ones, pb.v, osum, 0, 0, 0);
            }
            const float sum = osum[0];
            const float inv = 1.0f / sum;
#pragma unroll
            for (int d = 0; d < 4; ++d) {
                yw[d].x = cvt_pk_bf16(o[d][0] * inv * bf_lo(zw[d].x), o[d][1] * inv * bf_hi(zw[d].x)); yw[d].y = cvt_pk_bf16(o[d][2] * inv * bf_lo(zw[d].y), o[d][3] * inv * bf_hi(zw[d].y)); }
            __syncthreads();
            if (nlo <= nhi) { const int slot = nlo % 9; *(LAS u32x4*)(F.lds + AK_OFF + slot * 8192 + kwr) = pk0; *(LAS u32x4*)(F.lds + AV_OFF + slot * 8192 + F.tid * 16) = pv0; }
            if (nlo + 1 <= nhi) { const int slot = (nlo + 1) % 9; *(LAS u32x4*)(F.lds + AK_OFF + slot * 8192 + kwr) = pk1; *(LAS u32x4*)(F.lds + AV_OFF + slot * 8192 + F.tid * 16) = pv1; }
            __syncthreads();
            qf[0] = qn[0]; qf[1] = qn[1];
#pragma unroll
            for (int d = 0; d < 4; ++d) zw[d] = zn[d];
        }
#pragma unroll
        for (int d = 0; d < 4; ++d) *(u32x2*)(yb + (size_t)(r0 + 14 + rsel) * 64 * D + 16 * d) = yw[d];
        if (item + F.G < BATCH * NH * 8) attn_issue<false>(F, P, item + F.G, A);
    }
    __syncthreads();
}

struct Args { const float* in[13]; float* out; unsigned char* ws; int ph_lo, ph_hi; };
constexpr int N_PHASES = 2 + 4 * DEPTH;

typedef const __attribute__((address_space(4))) Args* ArgsP;
__device__ __forceinline__ ArgsP fresh_args() { ArgsP p = (ArgsP)__builtin_amdgcn_kernarg_segment_ptr(); asm volatile("" : "+s"(p)); return p; }
#ifndef MK_MASK
#define MK_MASK 63
#endif
#ifndef MK_REP
#define MK_REP 0
#endif
__global__ void __launch_bounds__(512, 2) mk_fwd(Args args) {
    extern __shared__ __attribute__((aligned(16))) unsigned char lds[];
    { LAS unsigned* z = (LAS unsigned*)((LAS unsigned char*)lds + LDSCTL_OFF); for (int u = threadIdx.x; u < (LDS_BYTES - LDSCTL_OFF) / 4; u += 512) z[u] = 0u; }
    __syncthreads();
    const int lo = args.ph_lo, hi = args.ph_hi;
    const unsigned half_ = ((blockIdx.x & 7u) >> 2) & 1u;
    XcdBarrier bar, barh; bar.bar = (unsigned*)(args.ws + WS_CTL) + CW_BAR; bar.x = 0; bar.st = nullptr; bar.expect = gridDim.x; barh = bar;
    if (hi - lo > 1) {
        bar = xcd_barrier_post((unsigned*)(args.ws + WS_CTL) + CW_BAR, (volatile LAS unsigned*)((LAS unsigned char*)lds + MISC_OFF) + 8, gridDim.x);
        barh = xcd_barrier_post((unsigned*)(args.ws + WS_CTL) + CW_BAR + (1 + half_) * XCD_BAR_WORDS, (volatile LAS unsigned*)((LAS unsigned char*)lds + MISC_OFF) + 10, gridDim.x / 2);
    }
    const bool split_ok = (gridDim.x % 16) == 0;

    for (int ph = lo; ph < hi; ++ph) {
      const int kind_ = ph == 0 ? 1 : (ph == 1 ? 2 : (((ph - 2) & 3) == 0 ? 4 : (((ph - 2) & 3) == 1 ? 64 : (((ph - 2) & 3) == 2 ? 32 : 2))));
      const int nrep_ = (MK_REP & kind_) ? 2 : 1;
      for (int rep_ = 0; rep_ < nrep_; ++rep_) {
        ArgsP ap = fresh_args();
        unsigned char* ws = ap->ws;
        int tid_ = threadIdx.x, bx = blockIdx.x, G_ = gridDim.x;
        asm volatile("" : "+v"(tid_)); asm volatile("" : "+s"(bx), "+s"(G_));
        Frame F; F.lds = (LAS unsigned char*)lds; F.tid = tid_; F.lane = tid_ & 63; F.wave = __builtin_amdgcn_readfirstlane(tid_ >> 6);
        F.G = G_; F.vcu = (G_ % 8 == 0) ? (bx % 8) * (G_ / 8) + bx / 8 : bx;
        if (ph == 0) {
            if (MK_MASK & 1) p0_prologue(F, ap->in[1], ap->in[2], ap->in[3], ap->in[4], ap->in[10], ap->in[7], (float*)(ws + WS_MOD), (bf16_t*)(ws + WS_WIN), (bf16_t*)(ws + WS_WOUT), (bf16_t*)(ws + WS_WSB));
        } else if (ph == 1) {
            if (split_ok && half_ == 1u) {
                __syncthreads();
                p0_weights(F, ap->in[4], ap->in[10], (bf16_t*)(ws + WS_WIN), (bf16_t*)(ws + WS_WOUT), 1, (F.vcu - F.G / 2) * 8 + F.wave, (F.G / 2) * 8);
                __syncthreads();
            } else if (!split_ok) { __syncthreads(); p0_weights(F, ap->in[4], ap->in[10], (bf16_t*)(ws + WS_WIN), (bf16_t*)(ws + WS_WOUT), 1, F.vcu * 8 + F.wave, F.G * 8); __syncthreads(); }
            if (MK_MASK & 2) ln_phase(F, ap->in[0], LnStage{nullptr, nullptr, nullptr}, LnStage{nullptr, nullptr, nullptr}, nullptr, true, (const float*)(ws + WS_MOD), (bf16_t*)(ws + WS_H));
        } else {
            const int l = (ph - 2) >> 2, k = (ph - 2) & 3;
            if (k == 0) { if (MK_MASK & 4) {
                const bf16_t* H = (const bf16_t*)(ws + WS_H); const bf16_t* W = (const bf16_t*)(ws + WS_WIN) + (size_t)l * DIN * D;
                pg8::Gemm g{H, W, W + (size_t)5120 * D, H, D};
                pg8::ProjOrder S; S.init(F.G, bx);
                pg8::EpiProj E{(bf16_t*)(ws + WS_GA), (bf16_t*)(ws + WS_VG), (bf16_t*)(ws + WS_Q), (bf16_t*)(ws + WS_VT)};
                pg8::gemm_phase<pg8::EpiProj, pg8::ProjOrder>(F.lds, F.tid, g, S, E); }
            } else if (k == 1) {
                const AttnPtrs P{ap->in[9], (const bf16_t*)(ws + WS_Q), (const bf16_t*)(ws + WS_K), (const bf16_t*)(ws + WS_VT), (const bf16_t*)(ws + WS_ZB), (bf16_t*)(ws + WS_H)};
                AttnPre pre;
                sgu_phase(F, l, ap->in[5], ap->in[6], ap->in[8], (const bf16_t*)(ws + WS_WSB), (const bf16_t*)(ws + WS_VG), (const bf16_t*)(ws + WS_GA), (bf16_t*)(ws + WS_H), P, pre);
                attn_phase(F, P, l, pre);
            } else if (k == 2) { if (MK_MASK & 32) {
                pg8::Gemm g{(const bf16_t*)(ws + WS_H), (const bf16_t*)(ws + WS_WOUT) + (size_t)l * D * D, nullptr, nullptr, D};
                pg8::StaticOrder S; S.init(M, D, F.G, bx);
                LAS float* g1 = (LAS float*)(F.lds + pg8::STAGE_BYTES);
                { const float* gsrc = (const float*)(ws + WS_MOD) + (size_t)l * BATCH * NMOD + 2 * D;
                  for (int i = F.tid; i < BATCH * D / 4; i += 512) { const int b = i / (D / 4), c4 = i % (D / 4); *(LAS f32x4*)(g1 + b * D + c4 * 4) = *(const f32x4*)(gsrc + (size_t)b * NMOD + c4 * 4) + 1.0f; }
                  __syncthreads(); }
                pg8::EpiOut E{g1, (bf16_t*)(ws + (l == 0 ? WS_Y0 : WS_Y))};
                pg8::gemm_phase<pg8::EpiOut, pg8::StaticOrder>(F.lds, F.tid, g, S, E); }
            } else {
                const LnStage s0{(const bf16_t*)(ws + WS_Y0), ap->in[11], ap->in[12]};
                if (l == 0) { if (MK_MASK & 2) ln_phase(F, ap->in[0], s0, LnStage{nullptr, nullptr, nullptr}, nullptr, true, (const float*)(ws + WS_MOD) + (size_t)BATCH * NMOD, (bf16_t*)(ws + WS_H)); }
                else { const LnStage s1{(const bf16_t*)(ws + WS_Y), ap->in[11] + D, ap->in[12] + D};
                    if (MK_MASK & 2) ln_phase(F, ap->in[0], s0, s1, ap->out, false, nullptr, nullptr); }
            }
        }
        if (ph + 1 < hi || rep_ + 1 < nrep_) {
            if (ph == 0 || !split_ok) xcd_barrier(bar);
            else {
                if (ph == 5 && half_ == 0u && threadIdx.x == 0) {
                    unsigned* hc = (unsigned*)(ws + WS_CTL) + CW_HANDOFF; unsigned sp = 0;
                    while (xb_ld(hc) < gridDim.x / 2) { __builtin_amdgcn_s_sleep(2); if (++sp > (1u << 22)) break; }
                }
                xcd_barrier(barh);
                if (ph == 1 && half_ == 1u && threadIdx.x == 0 && rep_ == 0) xb_add((unsigned*)(ws + WS_CTL) + CW_HANDOFF, 1u);
            }
        }
      }
    }
}

extern "C" void kernel_launch(void* const* d_in, const int* in_sizes, int n_in, void* d_out, int out_size, void* d_ws, size_t ws_size, hipStream_t stream) {
    static int grid = 0;
    if (grid == 0) {
        if (n_in != 13 || out_size != M * D || ws_size < WS_END) { fprintf(stderr, "kernel_launch: unexpected shapes (n_in %d, out %d, ws %zu)\n", n_in, out_size, ws_size); grid = -1; return; }
        int dev = 0, cus = 0, per_cu = 0;
        if (hipGetDevice(&dev) != hipSuccess || hipDeviceGetAttribute(&cus, hipDeviceAttributeMultiprocessorCount, dev) != hipSuccess) { grid = -1; return; }
        if (hipFuncSetAttribute((const void*)mk_fwd, hipFuncAttributeMaxDynamicSharedMemorySize, LDS_BYTES) != hipSuccess) { fprintf(stderr, "kernel_launch: hipFuncSetAttribute failed\n"); grid = -1; return; }
        if (hipOccupancyMaxActiveBlocksPerMultiprocessor(&per_cu, (const void*)mk_fwd, 512, LDS_BYTES) != hipSuccess || per_cu < 1) { fprintf(stderr, "kernel_launch: occupancy query reports %d blocks per CU\n", per_cu); per_cu = 1; }
        (void)hipGetLastError();
        grid = cus;
    }
    if (grid < 0) return;
    (void)hipMemsetAsync((char*)d_ws + WS_CTL, 0, CTL_ZERO_BYTES, stream);
    Args a{};
    for (int i = 0; i < 13; ++i) a.in[i] = (const float*)d_in[i];
    a.out = (float*)d_out; a.ws = (unsigned char*)d_ws;
    if (MK_N_LAUNCHES == 1) { a.ph_lo = 0; a.ph_hi = N_PHASES; hipLaunchKernelGGL(mk_fwd, dim3(grid), dim3(512), LDS_BYTES, stream, a); }
    else { for (int p = 0; p < N_PHASES; ++p) { a.ph_lo = p; a.ph_hi = p + 1; hipLaunchKernelGGL(mk_fwd, dim3(grid), dim3(512), LDS_BYTES, stream, a); } }
}
```

```cpp
#include <hip/hip_runtime.h>
#include <cstdio>
#include <cstdint>

#ifndef MK_N_LAUNCHES
#define MK_N_LAUNCHES 1
#endif

#define LAS __attribute__((address_space(3)))
#define GAS __attribute__((address_space(1)))
typedef unsigned short bf16_t;
typedef short bf16x8 __attribute__((ext_vector_type(8)));
typedef float f32x4 __attribute__((ext_vector_type(4)));
typedef float f32x2 __attribute__((ext_vector_type(2)));
typedef unsigned u32x4 __attribute__((ext_vector_type(4)));
typedef unsigned u32x2 __attribute__((ext_vector_type(2)));

constexpr int BATCH = 2, T = 8192, D = 2048, M = BATCH * T, DIN = 7168, DS = 1024, NG = 8, NH = 16, DEPTH = 2;
constexpr int NMOD = 3 * D;
constexpr float LN_EPS = 1e-5f;
constexpr float DN_ALPHA = 1.4142135623730951f;

typedef __bf16 bf16v2 __attribute__((ext_vector_type(2)));
__device__ __forceinline__ unsigned cvt_pk_bf16(float lo, float hi) { const f32x2 v = {lo, hi}; const bf16v2 r = __builtin_convertvector(v, bf16v2); return __builtin_bit_cast(unsigned, r); }
__device__ __forceinline__ float bf_lo(unsigned w) { return __builtin_bit_cast(float, w << 16); }
__device__ __forceinline__ float bf_hi(unsigned w) { return __builtin_bit_cast(float, w & 0xffff0000u); }
__device__ __forceinline__ float silu_f(float x) { return x * __builtin_amdgcn_rcpf(1.0f + __builtin_amdgcn_exp2f(-1.4426950408889634f * x)); }
__device__ __forceinline__ f32x2 gelu_pk(f32x2 v) {
    f32x2 c; c.x = __builtin_amdgcn_fmed3f(v.x, -4.0f, 4.0f); c.y = __builtin_amdgcn_fmed3f(v.y, -4.0f, 4.0f);
    const f32x2 s = c * c;
    f32x2 r = s * 7.0374646370e-11f + (-6.2872893160e-09f);
    r = r * s + 2.5093203053e-07f; r = r * s + (-5.9760889818e-06f); r = r * s + 9.6085055597e-05f; r = r * s + (-1.1195942566e-03f);
    r = r * s + 9.8383713455e-03f; r = r * s + (-6.6361911043e-02f); r = r * s + 3.9890514886e-01f;
    return v * (c * r + 0.5f);
}
__device__ __forceinline__ f32x4 gelu4(f32x4 v) { f32x2 a = gelu_pk((f32x2){v[0], v[1]}), b = gelu_pk((f32x2){v[2], v[3]}); return (f32x4){a.x, a.y, b.x, b.y}; }
__device__ __forceinline__ f32x2 silu_pk(f32x2 v) { const f32x2 a = v * (-1.4426950408889634f); f32x2 e; e.x = __builtin_amdgcn_exp2f(a.x); e.y = __builtin_amdgcn_exp2f(a.y);
    const f32x2 d = e + 1.0f; f32x2 r; r.x = __builtin_amdgcn_rcpf(d.x); r.y = __builtin_amdgcn_rcpf(d.y); return v * r; }
__device__ __forceinline__ f32x4 silu4(f32x4 v) { const f32x2 a = silu_pk((f32x2){v[0], v[1]}), b = silu_pk((f32x2){v[2], v[3]}); return (f32x4){a.x, a.y, b.x, b.y}; }
#ifndef MK_REP
#define MK_REP 0
#endif
__device__ __forceinline__ void store8(bf16_t* p, f32x4 a, f32x4 b) { u32x4 w; w.x = cvt_pk_bf16(a[0], a[1]); w.y = cvt_pk_bf16(a[2], a[3]); w.z = cvt_pk_bf16(b[0], b[1]); w.w = cvt_pk_bf16(b[2], b[3]); *(u32x4*)p = w;
    if (MK_REP & 128) { asm volatile("" ::: "memory"); *(u32x4*)p = w; asm volatile("" ::: "memory"); } }

namespace pg8 {
constexpr int BM = 256, BK = 64, HALF = 128, HTB = HALF * BK * 2, STAGE_BYTES = 8 * HTB, NXCD = 8, WGM = 2;
__host__ __device__ __forceinline__ int lds_byte(int r, int c) { const int st = (r >> 4) * 2 + (c >> 5), rr = r & 15, cc = c & 31, ob = rr * 64 + cc * 2; return st * 1024 + (ob ^ (((ob >> 9) & 1) << 5)); }
__host__ __device__ __forceinline__ void stage_rc(int b, int& R, int& C) { const int st = b / 1024, sb = b % 1024, swz = sb ^ (((sb >> 9) & 1) << 5); R = (st >> 1) * 16 + swz / 64; C = (st & 1) * 32 + (swz % 64) / 2; }
__host__ __device__ __forceinline__ int perm32(int rho) { const int n = rho >> 4, i = rho & 15; return 8 * (i >> 2) + 4 * n + (i & 3); }

struct Unit { int pm, pn, kind; };
struct Gemm { const bf16_t* A0; const bf16_t* B0; const bf16_t* A1; const bf16_t* B1; int K; };

struct StaticOrder {
    int nM, nN, nwg, G, c;
    __device__ void init(int M_, int N_, int G_, int c_) { nM = M_ / BM; nN = N_ / BM; nwg = nM * nN; G = G_; c = c_; }
    __device__ __forceinline__ void map(int wgid, Unit& u) const {
        { const int q = nwg / NXCD, r = nwg % NXCD, xcd = wgid % NXCD, off = wgid / NXCD; wgid = (xcd < r ? xcd * (q + 1) : r * (q + 1) + (xcd - r) * q) + off; }
        const int nig = WGM * nN, gid = wgid / nig, fm = gid * WGM, gsz = (nM - fm) < WGM ? (nM - fm) : WGM;
        u.pm = fm + ((wgid % nig) % gsz); u.pn = (wgid % nig) / gsz; u.kind = 0;
    }
    __device__ __forceinline__ bool next(int i, Unit& u) const { const long L = (long)i * G + c; if (L >= nwg) return false; map((int)L, u); return true; }
};
struct ProjOrder {
    StaticOrder S; int nswap;
    __device__ void init(int G_, int c_) { S.init(M, 5120, G_, c_); nswap = 512; }
    __device__ __forceinline__ bool next(int i, Unit& u) const {
        const long L = (long)i * S.G + S.c;
        if (L < S.nwg) { S.map((int)L, u); return true; }
        const int idx = (int)(L - S.nwg); if (idx >= nswap) return false;
        const int x = idx % 8, t = idx / 8, rnd = t >> 5, j = t & 31;
        u.pm = (j + 4 * rnd) & 7; u.pn = 8 * x + 4 * rnd + (j >> 3); u.kind = 1; return true;
    }
};

struct EpiProj {
    static constexpr bool PERM = true;
    bf16_t *GA, *VGT, *Qb, *VT;
    __device__ __forceinline__ void operator()(const f32x4 (&acc)[2][2][4][2], const Unit& u, int wr, int wc, int fr, int fq) const {
        const int rl = wr * 64 + fr, cl = wc * 32 + 8 * fq;
        if (u.kind == 1) {
            const int tok0 = u.pn * 256 + cl;
            if (u.pm < 4) {
#pragma unroll
                for (int ai = 0; ai < 2; ++ai)
#pragma unroll
                    for (int m = 0; m < 4; ++m) { const int ch = u.pm * 256 + rl + ai * HALF + m * 16;
#pragma unroll
                        for (int bj = 0; bj < 2; ++bj) { const int tk = tok0 + bj * HALF;
                            store8(VGT + ((size_t)(tk >> 7) * DS + ch) * 128 + (tk & 127), gelu4(acc[ai][bj][m][0]), gelu4(acc[ai][bj][m][1])); } }
            } else {
                const int bb = tok0 >> 13;
#pragma unroll
                for (int ai = 0; ai < 2; ++ai)
#pragma unroll
                    for (int m = 0; m < 4; ++m) { const int ch = (u.pm - 4) * 256 + rl + ai * HALF + m * 16;
                        bf16_t* rowp = VT + ((size_t)(bb * NH + (ch >> 6)) * (T / 8) * 64 + (ch & 63)) * 8;
#pragma unroll
                        for (int bj = 0; bj < 2; ++bj) store8(rowp + (size_t)(((tok0 + bj * HALF) & (T - 1)) >> 3) * 512, acc[ai][bj][m][0], acc[ai][bj][m][1]); }
            }
        } else if (u.pn < 8) {
            bf16_t* base = GA + (size_t)(u.pm * 256 + rl) * DS + u.pn * 128 + cl;
#pragma unroll
            for (int ai = 0; ai < 2; ++ai)
#pragma unroll
                for (int m = 0; m < 4; ++m) {
                    const f32x4 r0 = gelu4(acc[ai][0][m][0]) * silu4(acc[ai][1][m][0]), r1 = gelu4(acc[ai][0][m][1]) * silu4(acc[ai][1][m][1]);
                    store8(base + (size_t)(ai * HALF + m * 16) * DS, r0, r1); }
        } else {
            const int t = (u.pn - 8) >> 2, colt = ((u.pn - 8) & 3) * 256;
            bf16_t* out = Qb + (size_t)t * ((size_t)M * DS);
            const int row0 = u.pm * 256 + rl;
            const int bb = row0 >> 13, t0 = row0 & (T - 1);
#define EPI_QKZ(XFORM) _Pragma("unroll") for (int bj = 0; bj < 2; ++bj) { const int col = colt + bj * HALF + cl; \
                bf16_t* base = out + ((size_t)(bb * NH + (col >> 6)) * T + t0) * 64 + (col & 63); \
                _Pragma("unroll") for (int ai = 0; ai < 2; ++ai) _Pragma("unroll") for (int m = 0; m < 4; ++m) { f32x4 v0 = acc[ai][bj][m][0], v1 = acc[ai][bj][m][1]; XFORM; \
                        store8(base + (size_t)(ai * HALF + m * 16) * 64, v0, v1); } }
            if (t == 0) { EPI_QKZ(v0 = v0 * 0.18033688011112042f; v1 = v1 * 0.18033688011112042f) }
            else if (t == 2) { EPI_QKZ(v0 = silu4(v0); v1 = silu4(v1)) }
            else { EPI_QKZ((void)0) }
#undef EPI_QKZ
        }
    }
};
struct EpiOut {
    static constexpr bool PERM = true;
    const LAS float* gate1; bf16_t* Y;
    __device__ __forceinline__ void operator()(const f32x4 (&acc)[2][2][4][2], const Unit& u, int wr, int wc, int fr, int fq) const {
        const int row0 = u.pm * BM + wr * 64 + fr, col0 = u.pn * BM + wc * 32 + 8 * fq;
        const LAS float* gp = gate1 + (u.pm >= (T / BM) ? D : 0) + col0;
        f32x4 g4[2][2];
#pragma unroll
        for (int bj = 0; bj < 2; ++bj)
#pragma unroll
            for (int n = 0; n < 2; ++n) g4[bj][n] = *(const LAS f32x4*)(gp + bj * HALF + n * 4);
#pragma unroll
        for (int ai = 0; ai < 2; ++ai)
#pragma unroll
            for (int m = 0; m < 4; ++m) { bf16_t* rowp = Y + (size_t)(row0 + ai * HALF + m * 16) * D + col0;
#pragma unroll
                for (int bj = 0; bj < 2; ++bj) store8(rowp + bj * HALF, g4[bj][0] * acc[ai][bj][m][0], g4[bj][1] * acc[ai][bj][m][1]); }
    }
};

template <class Epi, class Sched>
__device__ __forceinline__ void gemm_phase(LAS unsigned char* lds, const int tid, const Gemm g, const Sched& S, const Epi& E) {
    const int wid = __builtin_amdgcn_readfirstlane(tid >> 6), lane = tid & 63, wr = wid >> 2, wc = wid & 3, fr = lane & 15, fq = lane >> 4;
    const int K = g.K, nt = K / BK;
    unsigned voffA[2], voffB[2];
#pragma unroll
    for (int i = 0; i < 2; ++i) { int R, C; stage_rc(tid * 16 + i * 8192, R, C); const int Rb = Epi::PERM ? ((R & ~31) + perm32(R & 31)) : R;
        voffA[i] = (unsigned)(R * K + C) * 2u; voffB[i] = (unsigned)(Rb * K + C) * 2u; }
    const size_t kstep = (size_t)(BK * 2);
    const size_t hstep = (size_t)HALF * K * 2;
    const size_t tstep = 2 * hstep;
    const unsigned ldsw = (unsigned)wid * 1024u;
    const int aoff = lds_byte(wr * 64 + fr, fq * 8), boff = lds_byte(wc * 32 + fr, fq * 8);
#define PG8_SA(b, h) (((b) * 2 + (h)) * HTB)
#define PG8_SB(b, h) ((4 + (b) * 2 + (h)) * HTB)
#define PG8_STAGE(bufoff, gbase, voff) do { _Pragma("unroll") for (int _i = 0; _i < 2; ++_i) \
        __builtin_amdgcn_global_load_lds((const unsigned*)((const char*)(gbase) + (voff)[_i]), (LAS unsigned*)(lds + (bufoff) + ldsw + _i * 8192), 16, 0, 0); } while (0)
#define PG8_LDA(dst, b, h) do { _Pragma("unroll") for (int m = 0; m < 4; ++m) _Pragma("unroll") for (int k = 0; k < 2; ++k) dst[m][k] = *(const LAS bf16x8*)(lds + PG8_SA(b, h) + aoff + m * 2048 + k * 1024); } while (0)
#define PG8_LDB(dst, b, h) do { _Pragma("unroll") for (int n = 0; n < 2; ++n) _Pragma("unroll") for (int k = 0; k < 2; ++k) dst[n][k] = *(const LAS bf16x8*)(lds + PG8_SB(b, h) + boff + n * 2048 + k * 1024); } while (0)
#define PG8_MMA(ai, bj, At, Bt) do { __builtin_amdgcn_sched_barrier(0); _Pragma("unroll") for (int m = 0; m < 4; ++m) _Pragma("unroll") for (int n = 0; n < 2; ++n) _Pragma("unroll") for (int k = 0; k < 2; ++k) \
        acc[ai][bj][m][n] = __builtin_amdgcn_mfma_f32_16x16x32_bf16(Bt[n][k], At[m][k], acc[ai][bj][m][n], 0, 0, 0); __builtin_amdgcn_sched_barrier(0); } while (0)
#define PG8_WAIT_V(n) asm volatile("s_waitcnt vmcnt(" #n ")" ::: "memory")
#define PG8_WAIT_L(n) asm volatile("s_waitcnt lgkmcnt(" #n ")" ::: "memory")
#define PG8_BAR __builtin_amdgcn_s_barrier()
#define PG8_SCHED __builtin_amdgcn_sched_barrier(0)
#define PG8_UA(u) ((const char*)((u).kind ? g.A1 : g.A0) + (size_t)(u).pm * tstep)
#define PG8_UB(u) ((const char*)((u).kind ? g.B1 : g.B0) + (size_t)(u).pn * tstep)
    Unit cur, nxt; int ui = 0;
    if (!S.next(0, cur)) return;
    f32x4 acc[2][2][4][2];
#pragma unroll
    for (int a = 0; a < 2; ++a)
#pragma unroll
        for (int b = 0; b < 2; ++b)
#pragma unroll
            for (int m = 0; m < 4; ++m)
#pragma unroll
                for (int n = 0; n < 2; ++n) acc[a][b][m][n] = (f32x4){0.f, 0.f, 0.f, 0.f};
    bf16x8 At[4][2], B0[2][2], B1[2][2];
    const char* cA = PG8_UA(cur); const char* cB = PG8_UB(cur);
    PG8_STAGE(PG8_SB(0, 0), cB, voffB); PG8_STAGE(PG8_SB(0, 1), cB + hstep, voffB); PG8_STAGE(PG8_SA(0, 0), cA, voffA); PG8_STAGE(PG8_SA(0, 1), cA + hstep, voffA);
    if (wr == 1) PG8_BAR;
    PG8_WAIT_V(2); PG8_BAR;
    PG8_STAGE(PG8_SB(1, 0), cB + kstep, voffB); PG8_STAGE(PG8_SA(1, 0), cA + kstep, voffA); PG8_STAGE(PG8_SB(1, 1), cB + hstep + kstep, voffB);
    PG8_WAIT_V(6); PG8_BAR;
    for (;;) {
        const bool has_next = S.next(ui + 1, nxt);
        const char* nA = has_next ? PG8_UA(nxt) : cA; const char* nB = has_next ? PG8_UB(nxt) : cB;
        for (int t = 0; t < nt; t += 2) {
            const bool last = (t == nt - 2);
            const char* a1 = cA + (size_t)(t + 1) * kstep;
            const char* a2 = last ? nA : cA + (size_t)(t + 2) * kstep; const char* b2 = last ? nB : cB + (size_t)(t + 2) * kstep;
            const char* a3 = a2 + kstep; const char* b3 = b2 + kstep;
            PG8_LDB(B0, 0, 0); PG8_LDB(B1, 0, 1); PG8_SCHED; PG8_LDA(At, 0, 0); PG8_STAGE(PG8_SA(1, 1), a1 + hstep, voffA);
            PG8_WAIT_V(8); PG8_WAIT_L(0); PG8_BAR; PG8_MMA(0, 0, At, B0); PG8_MMA(0, 1, At, B1); PG8_BAR; PG8_SCHED;
            PG8_LDA(At, 0, 1); PG8_STAGE(PG8_SB(0, 0), b2, voffB); PG8_STAGE(PG8_SB(0, 1), b2 + hstep, voffB); PG8_STAGE(PG8_SA(0, 0), a2, voffA);
            PG8_WAIT_V(8); PG8_WAIT_L(0); PG8_BAR; PG8_MMA(1, 0, At, B0); PG8_MMA(1, 1, At, B1); PG8_BAR; PG8_SCHED;
            PG8_LDB(B0, 1, 0); PG8_LDB(B1, 1, 1); PG8_SCHED; PG8_LDA(At, 1, 0); PG8_STAGE(PG8_SA(0, 1), a2 + hstep, voffA);
            PG8_WAIT_V(8); PG8_WAIT_L(0); PG8_BAR; PG8_MMA(0, 0, At, B0); PG8_MMA(0, 1, At, B1); PG8_BAR; PG8_SCHED;
            PG8_LDA(At, 1, 1); PG8_STAGE(PG8_SB(1, 0), b3, voffB); PG8_STAGE(PG8_SB(1, 1), b3 + hstep, voffB); PG8_STAGE(PG8_SA(1, 0), a3, voffA);
            PG8_WAIT_V(8); PG8_WAIT_L(0); PG8_BAR; PG8_MMA(1, 0, At, B0); PG8_MMA(1, 1, At, B1); PG8_BAR; PG8_SCHED;
        }
        if (wr == 0) PG8_BAR;
        E(acc, cur, wr, wc, fr, fq);
        if (!has_next) break;
#pragma unroll
        for (int a = 0; a < 2; ++a)
#pragma unroll
            for (int b = 0; b < 2; ++b)
#pragma unroll
                for (int m = 0; m < 4; ++m)
#pragma unroll
                    for (int n = 0; n < 2; ++n) acc[a][b][m][n] = (f32x4){0.f, 0.f, 0.f, 0.f};
        cur = nxt; cA = nA; cB = nB; ++ui;
        if (wr == 1) PG8_BAR;
    }
    PG8_WAIT_V(0);
    PG8_BAR;
#undef PG8_SA
#undef PG8_SB
#undef PG8_STAGE
#undef PG8_LDA
#undef PG8_LDB
#undef PG8_MMA
#undef PG8_WAIT_V
#undef PG8_WAIT_L
#undef PG8_BAR
#undef PG8_SCHED
#undef PG8_UA
#undef PG8_UB
}
}

constexpr size_t MiB = 1u << 20;
constexpr size_t WS_CTL = 0, CTL_ZERO_BYTES = 64 * 1024;
constexpr size_t WS_MOD = 1 * MiB;
constexpr size_t WS_WSB = 1 * MiB + 512 * 1024;
constexpr size_t WS_WIN = 2 * MiB;
constexpr size_t WS_WOUT = 58 * MiB;
constexpr size_t WS_H = 80 * MiB;
constexpr size_t WS_GA = 144 * MiB, WS_VG = 176 * MiB, WS_Q = 208 * MiB, WS_K = 240 * MiB, WS_ZB = 272 * MiB, WS_VT = 304 * MiB;
constexpr size_t WS_Y = 144 * MiB;
constexpr size_t WS_Y0 = 336 * MiB;
constexpr size_t WS_END = 400 * MiB;
static_assert(WS_K - WS_Q == (size_t)M * DS * 2 && WS_ZB - WS_K == (size_t)M * DS * 2, "EpiProj indexes Q|K|ZB as one array");
static_assert((4096 + 3 * 3456) * 4 <= 64 * 1024, "control words inside the memset region");
constexpr int CW_BAR = 4096, CW_HANDOFF = 64;

constexpr int RING_BYTES = 131072, LDS_BYTES = 163840, LDSCTL_OFF = LDS_BYTES - 1024, MISC_OFF = LDSCTL_OFF + 320;

typedef GAS unsigned gu32;
#define RLX_AGENT __ATOMIC_RELAXED, __HIP_MEMORY_SCOPE_AGENT
#define LDS_WAIT() asm volatile("s_waitcnt lgkmcnt(0)" ::: "memory")

#define XB_TMO      128
#define XB_XCNT(j)  (256  + 64 * (j))
#define XB_XSUB(j)  (1280 + 64 * (j))
#define XB_XGEN(j)  (2304 + 64 * (j))
#define XB_TOP      3328
#define XB_TOPGEN   3392
#define XCD_BAR_WORDS 3456
#define XB_SPIN_CAP (1u << 18)
__device__ __forceinline__ unsigned xb_ld(unsigned* p)              { return __hip_atomic_load(p, __ATOMIC_RELAXED, __HIP_MEMORY_SCOPE_AGENT); }
__device__ __forceinline__ unsigned xb_add(unsigned* p, unsigned v) { return __hip_atomic_fetch_add(p, v, __ATOMIC_RELAXED, __HIP_MEMORY_SCOPE_AGENT); }
__device__ __forceinline__ unsigned xb_xcc_id() { return (unsigned)__builtin_amdgcn_s_getreg((3 << 11) | 20) & 0xFu; }
#define XB_SPIN(cond, bar) do { unsigned _sp = 0; while (cond) { __builtin_amdgcn_s_sleep(1); \
    if ((++_sp & 255u) == 0u) { if (xb_ld(&(bar)[XB_TMO])) break; if (_sp > XB_SPIN_CAP) { atomicAdd(&(bar)[XB_TMO], 1u); break; } } } } while (0)
struct XcdBarrier { unsigned* bar; unsigned x; volatile LAS unsigned* st; unsigned expect; };
__device__ __forceinline__ XcdBarrier xcd_barrier_post(unsigned* bar, volatile LAS unsigned* st, unsigned expect) {
    XcdBarrier b; b.bar = bar; b.x = xb_xcc_id(); b.st = st; b.expect = expect;
    if (threadIdx.x == 0) (void)xb_add(&bar[XB_XCNT(b.x)], 1u);
    return b;
}
__device__ __forceinline__ void xcd_barrier_complete(unsigned* bar, unsigned x, unsigned G, unsigned& nloc, unsigned& nx) {
    unsigned sum, cnt, mine, sp = 0u;
    for (;;) {
        sum = 0u; cnt = 0u; mine = 0u;
#pragma unroll
        for (unsigned j = 0; j < 16; ++j) { const unsigned c = xb_ld(&bar[XB_XCNT(j)]); sum += c; cnt += (c > 0u) ? 1u : 0u; mine = (j == x) ? c : mine; }
        if (sum == G) break;
        __builtin_amdgcn_s_sleep(1);
        if ((++sp & 255u) == 0u) { if (xb_ld(&bar[XB_TMO])) break; if (sp > XB_SPIN_CAP) { atomicAdd(&bar[XB_TMO], 1u); break; } }
    }
    nloc = mine > 0u ? mine : 1u; nx = cnt > 0u ? cnt : 1u;
}
__device__ __forceinline__ void xcd_barrier(const XcdBarrier& b) {
    asm volatile("s_waitcnt vmcnt(0)" ::: "memory");
    __syncthreads();
    if (threadIdx.x == 0) {
        unsigned* bar = b.bar;
        __builtin_amdgcn_s_waitcnt(0);
        unsigned nloc = b.st[0], nx = b.st[1];
        if (nloc == 0u) { xcd_barrier_complete(bar, b.x, b.expect, nloc, nx); b.st[0] = nloc; b.st[1] = nx; }
        const unsigned old = xb_add(&bar[XB_XSUB(b.x)], 1u);
        const unsigned gen = old / nloc;
        if (old + 1u == (gen + 1u) * nloc) {
            __builtin_amdgcn_fence(__ATOMIC_RELEASE, "agent");
            asm volatile("s_waitcnt vmcnt(0)" ::: "memory");
            const unsigned og = xb_add(&bar[XB_TOP], 1u);
            const unsigned tg = og / nx;
            if (og + 1u == (tg + 1u) * nx) xb_add(&bar[XB_TOPGEN], 1u);
            else XB_SPIN(xb_ld(&bar[XB_TOPGEN]) == tg, bar);
            __builtin_amdgcn_fence(__ATOMIC_ACQUIRE, "agent");
            xb_add(&bar[XB_XGEN(b.x)], 1u);
            asm volatile("s_waitcnt vmcnt(0)" ::: "memory");
        } else {
            XB_SPIN(xb_ld(&bar[XB_XGEN(b.x)]) == gen, bar);
            __builtin_amdgcn_fence(__ATOMIC_ACQUIRE, "agent");
            asm volatile("s_waitcnt vmcnt(0)" ::: "memory");
        }
    }
    __syncthreads();
}

struct Frame {
    LAS unsigned char* lds;
    int tid, lane, wave, vcu, G;
};

#define DPP_ADD(v, ctrl) ((v) + __builtin_bit_cast(float, __builtin_amdgcn_update_dpp(0, __builtin_bit_cast(int, (v)), (ctrl), 0xf, 0xf, true)))
__device__ __forceinline__ float wave_sum(float v) {
    v = DPP_ADD(v, 0xB1);
    v = DPP_ADD(v, 0x4E);
    v = DPP_ADD(v, 0x141);
    v = DPP_ADD(v, 0x140);
    const int vi = __builtin_bit_cast(int, v);
    const float r0 = __builtin_bit_cast(float, __builtin_amdgcn_readlane(vi, 0)), r1 = __builtin_bit_cast(float, __builtin_amdgcn_readlane(vi, 16));
    const float r2 = __builtin_bit_cast(float, __builtin_amdgcn_readlane(vi, 32)), r3 = __builtin_bit_cast(float, __builtin_amdgcn_readlane(vi, 48));
    return (r0 + r1) + (r2 + r3);
}

__device__ __forceinline__ void p0_transpose_item(const float* W, int N, bf16_t* WT, int K, int k0, int n0, int drow0, LAS float* scr, int lane) {
#pragma unroll 8
    for (int i = 0; i < 32; ++i) { const int kk = 2 * i + (lane >> 5); scr[kk * 33 + (lane & 31)] = __builtin_nontemporal_load(W + (size_t)(k0 + kk) * N + n0 + (lane & 31)); }
    LDS_WAIT(); asm volatile("" ::: "memory");
    const int c = lane & 7;
#pragma unroll
    for (int j = 0; j < 4; ++j) { const int n = (lane >> 3) + 8 * j; const LAS float* s = scr + (8 * c) * 33 + n;
        u32x4 o; o.x = cvt_pk_bf16(s[0 * 33], s[1 * 33]); o.y = cvt_pk_bf16(s[2 * 33], s[3 * 33]); o.z = cvt_pk_bf16(s[4 * 33], s[5 * 33]); o.w = cvt_pk_bf16(s[6 * 33], s[7 * 33]);
        *(u32x4*)(WT + (size_t)(drow0 + n) * K + k0 + 8 * c) = o; }
    LDS_WAIT(); asm volatile("" ::: "memory");
}
__device__ __forceinline__ int win_dest_row(int n0) {
    const int s = n0 >> 10, ch = n0 & 1023;
    switch (s) {
        case 0: return 256 * (ch >> 7) + (ch & 127);
        case 1: return 5120 + ch;
        case 2: return 256 * (ch >> 7) + 128 + (ch & 127);
        case 3: return 2048 + ch;
        case 4: return 3072 + ch;
        case 5: return 6144 + ch;
        default: return 4096 + ch;
    }
}
__device__ __forceinline__ void p0_weights(const Frame& F, const float* w_in, const float* w_out, bf16_t* WIN, bf16_t* WOUT, int l, int gw, int NGW) {
    LAS float* scr = (LAS float*)(F.lds + F.wave * 16384);
    constexpr int I_IN = (D / 64) * (DIN / 32), I_OUT = (D / 64) * (D / 32), I_L = I_IN + I_OUT;
    for (int it = gw; it < I_L; it += NGW) {
        int r = it;
        if (r < I_IN) { const int kb = r / (DIN / 32), nb = r % (DIN / 32);
            p0_transpose_item(w_in + (size_t)l * D * DIN, DIN, WIN + (size_t)l * DIN * D, D, 64 * kb, 32 * nb, win_dest_row(32 * nb), scr, F.lane); }
        else { r -= I_IN; const int kb = r / (D / 32), nb = r % (D / 32);
            p0_transpose_item(w_out + (size_t)l * D * D, D, WOUT + (size_t)l * D * D, D, 64 * kb, 32 * nb, 32 * nb, scr, F.lane); }
    }
}
__device__ __forceinline__ void p0_prologue(const Frame& F, const float* c_in, const float* w_ada, const float* b_ada, const float* w_in, const float* w_out, const float* w_sp,
                                            float* MOD, bf16_t* WIN, bf16_t* WOUT, bf16_t* WSB) {
    LAS float* sc = (LAS float*)F.lds;
    LAS float* red = (LAS float*)(F.lds + 16384);
    constexpr int NCH = 48, NIT = NMOD / NCH;
    for (int it = F.vcu; it < DEPTH * NIT; it += F.G) {
        for (int i = F.tid; i < BATCH * D; i += 512) sc[i] = silu_f(c_in[i]);
        __syncthreads();
        const int l = it / NIT, n0 = (it % NIT) * NCH;
        const int ln = F.lane < NCH ? F.lane : NCH - 1;
        const float* W = w_ada + (size_t)l * D * NMOD + n0 + ln;
        const int k0 = F.wave * 256;
        float a0 = 0.f, a1 = 0.f;
#pragma unroll 16
        for (int k = 0; k < 256; ++k) { const float w = __builtin_nontemporal_load(W + (size_t)(k0 + k) * NMOD); a0 += sc[k0 + k] * w; a1 += sc[D + k0 + k] * w; }
        red[(F.wave * 2 + 0) * 64 + F.lane] = a0; red[(F.wave * 2 + 1) * 64 + F.lane] = a1;
        __syncthreads();
        if (F.tid < 128 && (F.tid & 63) < NCH) { const int b = F.tid >> 6, lc = F.tid & 63; float s = 0.f;
#pragma unroll
            for (int w = 0; w < 8; ++w) s += red[(w * 2 + b) * 64 + lc];
            MOD[(size_t)(l * BATCH + b) * NMOD + n0 + lc] = s + b_ada[(size_t)l * NMOD + n0 + lc]; }
        __syncthreads();
    }
    p0_weights(F, w_in, w_out, WIN, WOUT, 0, F.vcu * 8 + F.wave, F.G * 8);
    const int gw = F.vcu * 8 + F.wave, NGW = F.G * 8;
    for (int i = (gw * 64 + F.lane) * 4; i < DEPTH * NG * 128 * 128; i += NGW * 64 * 4) { const f32x4 v = *(const f32x4*)(w_sp + i); u32x2 o; o.x = cvt_pk_bf16(v[0], v[1]); o.y = cvt_pk_bf16(v[2], v[3]); *(u32x2*)(WSB + i) = o; }
}

__device__ __forceinline__ void lds_sync() { asm volatile("s_waitcnt lgkmcnt(0)" ::: "memory"); __builtin_amdgcn_s_barrier(); asm volatile("" ::: "memory"); }
struct LnStage { const bf16_t* y; const float* g; const float* b; };
__device__ __forceinline__ void ln_row_norm(f32x4 (&v)[8], float& rstd) {
    float s = 0.f;
#pragma unroll
    for (int j = 0; j < 8; ++j) s += (v[j][0] + v[j][1]) + (v[j][2] + v[j][3]);
    const float mean = wave_sum(s) * (1.f / D); float s2 = 0.f;
#pragma unroll
    for (int j = 0; j < 8; ++j) { v[j] = v[j] - mean; s2 += (v[j][0] * v[j][0] + v[j][1] * v[j][1]) + (v[j][2] * v[j][2] + v[j][3] * v[j][3]); }
    rstd = __builtin_amdgcn_rsqf(wave_sum(s2) * (1.f / D) + LN_EPS);
}
__device__ __forceinline__ void ln_phase(const Frame& F, const float* src, const LnStage sa, const LnStage sb, float* xout, bool has_h, const float* modn, bf16_t* H) {
    LAS float* tga = (LAS float*)F.lds;
    LAS float* tba = tga + D; LAS float* tgb = tba + D; LAS float* tbb = tgb + D; LAS float* ts = tbb + D; LAS float* th = ts + D;
    for (int rb = F.vcu; rb < M / 64; rb += F.G) {
        const int bat = (rb * 64) / T;
        f32x4 vA[8], vB[8]; u32x2 yaA[8], ybA[8], yaB[8], ybB[8];
        auto load_row = [&](f32x4 (&v)[8], u32x2 (&ya)[8], u32x2 (&yb)[8], int i) __attribute__((always_inline)) {
            const size_t row = (size_t)rb * 64 + F.wave * 8 + i;
            const f32x4* xr = (const f32x4*)(src + row * D) + F.lane;
#pragma unroll
            for (int j = 0; j < 8; ++j) v[j] = __builtin_nontemporal_load(xr + 64 * j);
            if (sa.y) { const u32x2* yr = (const u32x2*)(sa.y + row * D) + F.lane;
#pragma unroll
                for (int j = 0; j < 8; ++j) ya[j] = yr[64 * j]; }
            if (sb.y) { const u32x2* yr = (const u32x2*)(sb.y + row * D) + F.lane;
#pragma unroll
                for (int j = 0; j < 8; ++j) yb[j] = yr[64 * j]; }
        };
        auto do_row = [&](f32x4 (&v)[8], u32x2 (&ya)[8], u32x2 (&yb)[8], int i) __attribute__((always_inline)) {
            const size_t row = (size_t)rb * 64 + F.wave * 8 + i;
            const LAS float* tl = tga + 4 * F.lane; asm volatile("" : "+v"(tl));
            if (sa.y) {
#pragma unroll
                for (int j = 0; j < 8; ++j) v[j] = v[j] * DN_ALPHA + (f32x4){bf_lo(ya[j].x), bf_hi(ya[j].x), bf_lo(ya[j].y), bf_hi(ya[j].y)};
                float rstd; ln_row_norm(v, rstd);
#pragma unroll
                for (int j = 0; j < 8; ++j) v[j] = v[j] * rstd * *(const LAS f32x4*)(tl + 256 * j) + *(const LAS f32x4*)(tl + D + 256 * j);
            }
            if (sb.y) {
#pragma unroll
                for (int j = 0; j < 8; ++j) v[j] = v[j] * DN_ALPHA + (f32x4){bf_lo(yb[j].x), bf_hi(yb[j].x), bf_lo(yb[j].y), bf_hi(yb[j].y)};
                float rstd; ln_row_norm(v, rstd);
#pragma unroll
                for (int j = 0; j < 8; ++j) v[j] = v[j] * rstd * *(const LAS f32x4*)(tl + 2 * D + 256 * j) + *(const LAS f32x4*)(tl + 3 * D + 256 * j);
            }
            if (xout) { f32x4* xo = (f32x4*)(xout + row * D) + F.lane;
#pragma unroll
                for (int j = 0; j < 8; ++j) __builtin_nontemporal_store(v[j], xo + 64 * j); }
            if (has_h) {
                float rstd; ln_row_norm(v, rstd);
                u32x2* ho = (u32x2*)(H + row * D) + F.lane;
#pragma unroll
                for (int j = 0; j < 8; ++j) { const f32x4 o = v[j] * rstd * *(const LAS f32x4*)(tl + 4 * D + 256 * j) + *(const LAS f32x4*)(tl + 5 * D + 256 * j);
                    u32x2 w; w.x = cvt_pk_bf16(o[0], o[1]); w.y = cvt_pk_bf16(o[2], o[3]); ho[64 * j] = w; }
            }
        };
        __syncthreads();
        {
            float tv[4][6];
#pragma unroll
            for (int q = 0; q < 4; ++q) { const int i = F.tid + 512 * q;
                if (sa.y) { tv[q][0] = sa.g[i]; tv[q][1] = sa.b[i]; }
                if (sb.y) { tv[q][2] = sb.g[i]; tv[q][3] = sb.b[i]; }
                if (has_h) { tv[q][4] = modn[(size_t)bat * NMOD + i]; tv[q][5] = modn[(size_t)bat * NMOD + D + i]; } }
            load_row(vA, yaA, ybA, 0);
#pragma unroll
            for (int q = 0; q < 4; ++q) { const int i = F.tid + 512 * q;
                if (sa.y) { tga[i] = tv[q][0]; tba[i] = tv[q][1]; }
                if (sb.y) { tgb[i] = tv[q][2]; tbb[i] = tv[q][3]; }
                if (has_h) { th[i] = tv[q][4]; ts[i] = 1.0f + tv[q][5]; } }
        }
        lds_sync();
        for (int i = 0; i < 6; i += 2) { load_row(vB, yaB, ybB, i + 1); do_row(vA, yaA, ybA, i); load_row(vA, yaA, ybA, i + 2); do_row(vB, yaB, ybB, i + 1); }
        load_row(vB, yaB, ybB, 7); do_row(vA, yaA, ybA, 6); do_row(vB, yaB, ybB, 7);
    }
    __syncthreads();
}

struct AttnPtrs { const float* rpb; const bf16_t *Qb, *Kb, *VT, *ZB; bf16_t* YC; };
constexpr int AK_OFF = 0, AV_OFF = 73728, ATT_BIAS_OFF = 147456;
static_assert(ATT_BIAS_OFF + 15 * 32 * 4 <= LDSCTL_OFF, "attention LDS map");
static_assert(DEPTH == 2, "the LN phases chain exactly two DeepNorm stages");
__device__ __forceinline__ int kswz(int key) { return ((key >> 1) & 1) | (((key >> 3) & 3) << 1); }
__device__ __forceinline__ int rstart(int r) { return min(max(r - 4, 0), 120); }
struct AttnPre { u32x4 kv[9], vv[9]; };
template <bool VPART>
__device__ __forceinline__ void attn_issue(const Frame& F, const AttnPtrs& P, int item, AttnPre& A) {
    const int bh = item >> 3, r0 = 16 * (item & 7);
    const bf16_t* g = (VPART ? P.VT : P.Kb) + (size_t)bh * T * 64 + F.tid * 8;
    const int lo = rstart(r0);
#pragma unroll
    for (int i = 0; i < 9; ++i) { const int kr = min(lo + i, T / 64 - 1); const u32x4 w = *(const u32x4*)(g + (size_t)kr * 4096); if (VPART) A.vv[i] = w; else A.kv[i] = w; }
}

constexpr int SG_LDP = 136;
constexpr int SG_W_OFF = 0, SG_VT_OFF = 34816, SG_GY_OFF = 69632, SG_RED_OFF = 104448, SG_STAT_OFF = SG_RED_OFF + 8192;
template <bool B> struct BoolTag { static constexpr bool value = B; };
__device__ __forceinline__ void sgu_phase(const Frame& F, int l, const float* sgu_g, const float* sgu_b, const float* b_sp, const bf16_t* WSB, const bf16_t* VGT, const bf16_t* GA, bf16_t* YC, const AttnPtrs& AP, AttnPre& A) {
    LAS bf16_t* wl = (LAS bf16_t*)(F.lds + SG_W_OFF);
    LAS bf16_t* vt = (LAS bf16_t*)(F.lds + SG_VT_OFF);
    LAS bf16_t* gy = (LAS bf16_t*)(F.lds + SG_GY_OFF);
    LAS float* red = (LAS float*)(F.lds + SG_RED_OFF);
    LAS float* stat = (LAS float*)(F.lds + SG_STAT_OFF);
    const int fr = F.lane & 15, fq = F.lane >> 4;
    const int chunk = F.tid & 15, rq = F.tid >> 4;
    const int hG = F.G / 2, hf = F.vcu / hG, vl = F.vcu % hG, nitems = NG * (T / 128);
    const int per = (nitems + hG - 1) / hG;
    const int s0 = vl * per, n_my = max(0, min(per, nitems - s0));
    u32x4 vw[4], gv[4];
    float gam[4], bet[4];
    LAS float* bl = stat + 256;
    { const int sc = min(s0, nitems - 1), g = sc / (T / 128), bn = hf * (T / 128) + sc % (T / 128);
#pragma unroll
      for (int j = 0; j < 4; ++j) { vw[j] = *(const u32x4*)(VGT + ((size_t)bn * DS + g * 128 + rq + 32 * j) * 128 + 8 * chunk); gv[j] = *(const u32x4*)(GA + ((size_t)bn * 128 + rq + 32 * j) * DS + g * 128 + 8 * chunk); } }
    auto load_group = [&](int g) __attribute__((always_inline)) {
            const bf16_t* Wg = WSB + ((size_t)l * NG + g) * 128 * 128;
            u32x4 wv[4];
#pragma unroll
            for (int j = 0; j < 4; ++j) wv[j] = *(const u32x4*)(Wg + (rq + 32 * j) * 128 + 8 * chunk);
#pragma unroll
            for (int j = 0; j < 4; ++j) { gam[j] = sgu_g[(size_t)l * DS + g * 128 + rq + 32 * j]; bet[j] = sgu_b[(size_t)l * DS + g * 128 + rq + 32 * j]; }
            if (F.tid < 128) bl[F.tid] = b_sp[((size_t)l * NG + g) * 128 + F.tid];
#pragma unroll
            for (int j = 0; j < 4; ++j) *(LAS u32x4*)(wl + (rq + 32 * j) * SG_LDP + 8 * chunk) = wv[j];
    };
    auto item_body = [&](int s, int g, auto last_tag) __attribute__((always_inline)) {
        const int bn = hf * (T / 128) + s % (T / 128);
        const size_t m0 = (size_t)bn * 128;
#pragma unroll
        for (int j = 0; j < 4; ++j) *(LAS u32x4*)(gy + (rq + 32 * j) * SG_LDP + 8 * chunk) = gv[j];
        float x[4][8], s1[8], s2[8];
#pragma unroll
        for (int j = 0; j < 4; ++j) { x[j][0] = bf_lo(vw[j].x); x[j][1] = bf_hi(vw[j].x); x[j][2] = bf_lo(vw[j].y); x[j][3] = bf_hi(vw[j].y); x[j][4] = bf_lo(vw[j].z); x[j][5] = bf_hi(vw[j].z); x[j][6] = bf_lo(vw[j].w); x[j][7] = bf_hi(vw[j].w); }
        if constexpr (decltype(last_tag)::value) attn_issue<false>(F, AP, F.vcu, A);
        else { const int sn = s + 1, gn = sn / (T / 128), bnn = hf * (T / 128) + sn % (T / 128);
#pragma unroll
          for (int j = 0; j < 4; ++j) { vw[j] = *(const u32x4*)(VGT + ((size_t)bnn * DS + gn * 128 + rq + 32 * j) * 128 + 8 * chunk); gv[j] = *(const u32x4*)(GA + ((size_t)bnn * 128 + rq + 32 * j) * DS + gn * 128 + 8 * chunk); } }
#pragma unroll
        for (int e = 0; e < 8; ++e) { s1[e] = (x[0][e] + x[1][e]) + (x[2][e] + x[3][e]); s2[e] = (x[0][e] * x[0][e] + x[1][e] * x[1][e]) + (x[2][e] * x[2][e] + x[3][e] * x[3][e]);
            s1[e] += __shfl_xor(s1[e], 16); s1[e] += __shfl_xor(s1[e], 32); s2[e] += __shfl_xor(s2[e], 16); s2[e] += __shfl_xor(s2[e], 32); }
        if (fq == 0) {
            *(LAS f32x4*)(red + (F.wave * 2 + 0) * 128 + 8 * chunk) = (f32x4){s1[0], s1[1], s1[2], s1[3]}; *(LAS f32x4*)(red + (F.wave * 2 + 0) * 128 + 8 * chunk + 4) = (f32x4){s1[4], s1[5], s1[6], s1[7]};
            *(LAS f32x4*)(red + (F.wave * 2 + 1) * 128 + 8 * chunk) = (f32x4){s2[0], s2[1], s2[2], s2[3]}; *(LAS f32x4*)(red + (F.wave * 2 + 1) * 128 + 8 * chunk + 4) = (f32x4){s2[4], s2[5], s2[6], s2[7]};
        }
        lds_sync();
        if (F.tid < 128) { float a1 = 0.f, a2 = 0.f;
#pragma unroll
            for (int w = 0; w < 8; ++w) { a1 += red[(w * 2 + 0) * 128 + F.tid]; a2 += red[(w * 2 + 1) * 128 + F.tid]; }
            const float mean = a1 * (1.f / 128.f); const float var = fmaxf(a2 * (1.f / 128.f) - mean * mean, 0.f);
            stat[2 * F.tid] = mean; stat[2 * F.tid + 1] = __builtin_amdgcn_rsqf(var + LN_EPS); }
        lds_sync();
        {
            float mu[8], rs[8];
#pragma unroll
            for (int e = 0; e < 8; e += 2) { const f32x4 st4 = *(const LAS f32x4*)(stat + 2 * (8 * chunk + e)); mu[e] = st4[0]; rs[e] = st4[1]; mu[e + 1] = st4[2]; rs[e + 1] = st4[3]; }
#pragma unroll
            for (int j = 0; j < 4; ++j) { u32x4 o;
                o.x = cvt_pk_bf16((x[j][0] - mu[0]) * rs[0] * gam[j] + bet[j], (x[j][1] - mu[1]) * rs[1] * gam[j] + bet[j]);
                o.y = cvt_pk_bf16((x[j][2] - mu[2]) * rs[2] * gam[j] + bet[j], (x[j][3] - mu[3]) * rs[3] * gam[j] + bet[j]);
                o.z = cvt_pk_bf16((x[j][4] - mu[4]) * rs[4] * gam[j] + bet[j], (x[j][5] - mu[5]) * rs[5] * gam[j] + bet[j]);
                o.w = cvt_pk_bf16((x[j][6] - mu[6]) * rs[6] * gam[j] + bet[j], (x[j][7] - mu[7]) * rs[7] * gam[j] + bet[j]);
                *(LAS u32x4*)(vt + (rq + 32 * j) * SG_LDP + 8 * chunk) = o; }
        }
        lds_sync();
        {
            bf16x8 af[4];
#pragma unroll
            for (int ks = 0; ks < 4; ++ks) af[ks] = *(const LAS bf16x8*)(vt + (16 * F.wave + fr) * SG_LDP + 32 * ks + 8 * fq);
#pragma unroll
            for (int nt = 0; nt < 8; ++nt) {
                f32x4 acc = {0.f, 0.f, 0.f, 0.f};
#pragma unroll
                for (int ks = 0; ks < 4; ++ks) { const bf16x8 bfrag = *(const LAS bf16x8*)(wl + (16 * nt + fr) * SG_LDP + 32 * ks + 8 * fq);
                    acc = __builtin_amdgcn_mfma_f32_16x16x32_bf16(af[ks], bfrag, acc, 0, 0, 0); }
                const int p = 16 * nt + fr;
                const float bs = bl[p];
                LAS u32x2* gp = (LAS u32x2*)(gy + p * SG_LDP + 16 * F.wave + 4 * fq);
                const u32x2 gaw = *gp;
                u32x2 o; o.x = cvt_pk_bf16(bf_lo(gaw.x) * (acc[0] + bs), bf_hi(gaw.x) * (acc[1] + bs)); o.y = cvt_pk_bf16(bf_lo(gaw.y) * (acc[2] + bs), bf_hi(gaw.y) * (acc[3] + bs));
                *gp = o;
            }
        }
        lds_sync();
#pragma unroll
        for (int j = 0; j < 4; ++j) { const int p = rq + 32 * j; *(u32x4*)(YC + (m0 + p) * D + g * 128 + 8 * chunk) = *(const LAS u32x4*)(gy + p * SG_LDP + 8 * chunk); }
    };
    int ii = 0, g_cur = -1;
    while (ii < n_my - 1) {
        const int g = (s0 + ii) / (T / 128);
        lds_sync();
        load_group(g); g_cur = g;
        for (bool first = true; ii < n_my - 1 && (s0 + ii) / (T / 128) == g; ++ii, first = false) { if (!first) lds_sync(); item_body(s0 + ii, g, BoolTag<false>{}); }
    }
    if (n_my > 0) { const int s = s0 + n_my - 1, g = s / (T / 128);
        lds_sync();
        if (g != g_cur) load_group(g);
        item_body(s, g, BoolTag<true>{}); }
    else attn_issue<false>(F, AP, F.vcu, A);
    __syncthreads();
}

__device__ __forceinline__ void attn_phase(const Frame& F, const AttnPtrs& P, int l, AttnPre& A) {
    const int kwr = (F.tid >> 3) * 128 + (((F.tid & 7) ^ kswz(F.tid >> 3)) << 4);
    const LAS float* rp = (const LAS float*)(F.lds + ATT_BIAS_OFF);
    for (int item = F.vcu; item < BATCH * NH * 8; item += F.G) {
        const int bh = item >> 3, r0 = 16 * (item & 7), b = bh >> 4, h = bh & 15;
        const size_t hb = (size_t)bh * T;
        attn_issue<true>(F, P, item, A);
        __syncthreads();
        { const int lo = rstart(r0), hi = rstart(r0 + 1) + 8;
#pragma unroll
            for (int i = 0; i < 9; ++i) if (lo + i < hi) { const int slot = (lo + i) % 9;
                *(LAS u32x4*)(F.lds + AK_OFF + slot * 8192 + kwr) = A.kv[i]; *(LAS u32x4*)(F.lds + AV_OFF + slot * 8192 + F.tid * 16) = A.vv[i]; } }
        int lane_ = F.lane; asm volatile("" : "+v"(lane_));
        const int fr = lane_ & 15, fq = lane_ >> 4, cb = F.wave & 3, rsel = F.wave >> 2;
        const int bs = min(max(16 * cb - 8, 0), 32);
        const int qcol = 16 * cb + fr;
        const int wst = min(max(qcol - 8, 0), 48);
        int ci[2][4];
#pragma unroll
        for (int X = 0; X < 2; ++X)
#pragma unroll
            for (int e = 0; e < 4; ++e) { const int kc = bs + 8 * fq + 4 * X + e; ci[X][e] = ((kc >= wst) && (kc < wst + 16)) ? min(max(kc - qcol + 15, 0), 30) : 31; }
        int koff[2][2];
#pragma unroll
        for (int X = 0; X < 2; ++X) { const int key = bs + 8 * (fr >> 2) + 4 * X + (fr & 3);
#pragma unroll
            for (int ks = 0; ks < 2; ++ks) koff[X][ks] = key * 128 + (((ks * 4 + fq) ^ kswz(key)) << 4); }
        const int voff = (((bs >> 3) + fq) * 64 + fr) * 16;
        const bf16_t* Kg = P.Kb + hb * 64 + F.tid * 8;
        const bf16_t* Vg = P.VT + hb * 64 + F.tid * 8;
        bf16_t* yb = P.YC + ((size_t)b * T + qcol) * D + DS + h * 64 + 4 * fq;
        for (int i = F.tid; i < 15 * 32; i += 512) ((LAS float*)(F.lds + ATT_BIAS_OFF))[i] = (i & 31) == 31 ? -1.0e30f : P.rpb[((size_t)l * NH + h) * 15 * 31 + (i >> 5) * 31 + (i & 31)] * 1.4426950408889634f;
        bf16x8 qf[2]; u32x2 zw[4];
        { const size_t tk = hb + (r0 + rsel) * 64 + qcol;
#pragma unroll
            for (int ks = 0; ks < 2; ++ks) qf[ks] = *(const bf16x8*)(P.Qb + tk * 64 + 32 * ks + 8 * fq);
#pragma unroll
            for (int d = 0; d < 4; ++d) zw[d] = *(const u32x2*)(P.ZB + tk * 64 + 16 * d + 4 * fq); }
        u32x2 yw[4];
        __syncthreads();
        for (int st = 0; st < 8; ++st) {
            const int ra = r0 + 2 * st, r = ra + rsel, rs = rstart(r);
            if (st > 0) {
#pragma unroll
                for (int d = 0; d < 4; ++d) *(u32x2*)(yb + (size_t)(r - 2) * 64 * D + 16 * d) = yw[d]; }
            const int nlo = rstart(ra + 1) + 8, nhi = (st < 7) ? rstart(ra + 3) + 7 : -1;
            const int kr0 = min(nlo, T / 64 - 1), kr1 = min(nlo + 1, T / 64 - 1);
            const u32x4 pk0 = *(const u32x4*)(Kg + (size_t)kr0 * 4096), pv0 = *(const u32x4*)(Vg + (size_t)kr0 * 4096);
            const u32x4 pk1 = *(const u32x4*)(Kg + (size_t)kr1 * 4096), pv1 = *(const u32x4*)(Vg + (size_t)kr1 * 4096);
            const size_t tkn = hb + min(r + 2, T / 64 - 1) * 64 + qcol;
            bf16x8 qn[2]; u32x2 zn[4];
#pragma unroll
            for (int ks = 0; ks < 2; ++ks) qn[ks] = *(const bf16x8*)(P.Qb + tkn * 64 + 32 * ks + 8 * fq);
#pragma unroll
            for (int d = 0; d < 4; ++d) zn[d] = *(const u32x2*)(P.ZB + tkn * 64 + 16 * d + 4 * fq);
            float s[8][2][4];
            float mx = -3.0e38f;
#pragma unroll
            for (int i = 0; i < 8; ++i) {
                const LAS float* rpi = rp + (rs + i - r + 7) * 32;
                const LAS unsigned char* kb = F.lds + AK_OFF + ((rs + i) % 9) * 8192;
#pragma unroll
                for (int X = 0; X < 2; ++X) {
                    f32x4 c = {rpi[ci[X][0]], rpi[ci[X][1]], rpi[ci[X][2]], rpi[ci[X][3]]};
#pragma unroll
                    for (int ks = 0; ks < 2; ++ks) c = __builtin_amdgcn_mfma_f32_16x16x32_bf16(*(const LAS bf16x8*)(kb + koff[X][ks]), qf[ks], c, 0, 0, 0);
                    s[i][X][0] = c[0]; s[i][X][1] = c[1]; s[i][X][2] = c[2]; s[i][X][3] = c[3];
                    mx = fmaxf(fmaxf(mx, c[0]), c[1]); mx = fmaxf(fmaxf(mx, c[2]), c[3]);
                }
            }
            mx = fmaxf(mx, __shfl_xor(mx, 16)); mx = fmaxf(mx, __shfl_xor(mx, 32));
#pragma unroll
            for (int i = 0; i < 8; ++i)
#pragma unroll
                for (int X = 0; X < 2; ++X)
#pragma unroll
                    for (int e = 0; e < 4; ++e) s[i][X][e] = __builtin_amdgcn_exp2f(s[i][X][e] - mx);
            f32x4 o[4], osum = {0.f, 0.f, 0.f, 0.f};
#pragma unroll
            for (int d = 0; d < 4; ++d) o[d] = (f32x4){0.f, 0.f, 0.f, 0.f};
            const bf16x8 ones = {0x3F80, 0x3F80, 0x3F80, 0x3F80, 0x3F80, 0x3F80, 0x3F80, 0x3F80};
#pragma unroll
            for (int i = 0; i < 8; ++i) {
                union { u32x4 u; bf16x8 v; } pb;
                pb.u.x = cvt_pk_bf16(s[i][0][0], s[i][0][1]); pb.u.y = cvt_pk_bf16(s[i][0][2], s[i][0][3]); pb.u.z = cvt_pk_bf16(s[i][1][0], s[i][1][1]); pb.u.w = cvt_pk_bf16(s[i][1][2], s[i][1][3]);
                const LAS unsigned char* vb = F.lds + AV_OFF + ((rs + i) % 9) * 8192 + voff;
#pragma unroll
                for (int d = 0; d < 4; ++d) o[d] = __builtin_amdgcn_mfma_f32_16x16x32_bf16(*(const LAS bf16x8*)(vb + d * 256), pb.v, o[d], 0, 0, 0);
                osum = __builtin_amdgcn_mfma_f32_16x16x32_bf16(ones, pb.v, osum, 0, 0, 0);
            }
            const float sum = osum[0];
            const float inv = 1.0f / sum;
#pragma unroll
            for (int d = 0; d < 4; ++d) {
                yw[d].x = cvt_pk_bf16(o[d][0] * inv * bf_lo(zw[d].x), o[d][1] * inv * bf_hi(zw[d].x)); yw[d].y = cvt_pk_bf16(o[d][2] * inv * bf_lo(zw[d].y), o[d][3] * inv * bf_hi(zw[d].y)); }
            __syncthreads();
            if (nlo <= nhi) { const int slot = nlo % 9; *(LAS u32x4*)(F.lds + AK_OFF + slot * 8192 + kwr) = pk0; *(LAS u32x4*)(F.lds + AV_OFF + slot * 8192 + F.tid * 16) = pv0; }
            if (nlo + 1 <= nhi) { const int slot = (nlo + 1) % 9; *(LAS u32x4*)(F.lds + AK_OFF + slot * 8192 + kwr) = pk1; *(LAS u32x4*)(F.lds + AV_OFF + slot * 8192 + F.tid * 16) = pv1; }
            __syncthreads();
            qf[0] = qn[0]; qf[1] = qn[1];
#pragma unroll
            for (int d = 0; d < 4; ++d) zw[d] = zn[d];
        }
#pragma unroll
        for (int d = 0; d < 4; ++d) *(u32x2*)(yb + (size_t)(r0 + 14 + rsel) * 64 * D + 16 * d) = yw[d];
        if (item + F.G < BATCH * NH * 8) attn_issue<false>(F, P, item + F.G, A);
    }
    __syncthreads();
}

struct Args { const float* in[13]; float* out; unsigned char* ws; int ph_lo, ph_hi; };
constexpr int N_PHASES = 2 + 4 * DEPTH;

typedef const __attribute__((address_space(4))) Args* ArgsP;
__device__ __forceinline__ ArgsP fresh_args() { ArgsP p = (ArgsP)__builtin_amdgcn_kernarg_segment_ptr(); asm volatile("" : "+s"(p)); return p; }
#ifndef MK_MASK
#define MK_MASK 63
#endif
#ifndef MK_REP
#define MK_REP 0
#endif
__global__ void __launch_bounds__(512, 2) mk_fwd(Args args) {
    extern __shared__ __attribute__((aligned(16))) unsigned char lds[];
    { LAS unsigned* z = (LAS unsigned*)((LAS unsigned char*)lds + LDSCTL_OFF); for (int u = threadIdx.x; u < (LDS_BYTES - LDSCTL_OFF) / 4; u += 512) z[u] = 0u; }
    __syncthreads();
    const int lo = args.ph_lo, hi = args.ph_hi;
    const unsigned half_ = ((blockIdx.x & 7u) >> 2) & 1u;
    XcdBarrier bar, barh; bar.bar = (unsigned*)(args.ws + WS_CTL) + CW_BAR; bar.x = 0; bar.st = nullptr; bar.expect = gridDim.x; barh = bar;
    if (hi - lo > 1) {
        bar = xcd_barrier_post((unsigned*)(args.ws + WS_CTL) + CW_BAR, (volatile LAS unsigned*)((LAS unsigned char*)lds + MISC_OFF) + 8, gridDim.x);
        barh = xcd_barrier_post((unsigned*)(args.ws + WS_CTL) + CW_BAR + (1 + half_) * XCD_BAR_WORDS, (volatile LAS unsigned*)((LAS unsigned char*)lds + MISC_OFF) + 10, gridDim.x / 2);
    }
    const bool split_ok = (gridDim.x % 16) == 0;

    for (int ph = lo; ph < hi; ++ph) {
      const int kind_ = ph == 0 ? 1 : (ph == 1 ? 2 : (((ph - 2) & 3) == 0 ? 4 : (((ph - 2) & 3) == 1 ? 64 : (((ph - 2) & 3) == 2 ? 32 : 2))));
      const int nrep_ = (MK_REP & kind_) ? 2 : 1;
      for (int rep_ = 0; rep_ < nrep_; ++rep_) {
        ArgsP ap = fresh_args();
        unsigned char* ws = ap->ws;
        int tid_ = threadIdx.x, bx = blockIdx.x, G_ = gridDim.x;
        asm volatile("" : "+v"(tid_)); asm volatile("" : "+s"(bx), "+s"(G_));
        Frame F; F.lds = (LAS unsigned char*)lds; F.tid = tid_; F.lane = tid_ & 63; F.wave = __builtin_amdgcn_readfirstlane(tid_ >> 6);
        F.G = G_; F.vcu = (G_ % 8 == 0) ? (bx % 8) * (G_ / 8) + bx / 8 : bx;
        if (ph == 0) {
            if (MK_MASK & 1) p0_prologue(F, ap->in[1], ap->in[2], ap->in[3], ap->in[4], ap->in[10], ap->in[7], (float*)(ws + WS_MOD), (bf16_t*)(ws + WS_WIN), (bf16_t*)(ws + WS_WOUT), (bf16_t*)(ws + WS_WSB));
        } else if (ph == 1) {
            if (split_ok && half_ == 1u) {
                __syncthreads();
                p0_weights(F, ap->in[4], ap->in[10], (bf16_t*)(ws + WS_WIN), (bf16_t*)(ws + WS_WOUT), 1, (F.vcu - F.G / 2) * 8 + F.wave, (F.G / 2) * 8);
                __syncthreads();
            } else if (!split_ok) { __syncthreads(); p0_weights(F, ap->in[4], ap->in[10], (bf16_t*)(ws + WS_WIN), (bf16_t*)(ws + WS_WOUT), 1, F.vcu * 8 + F.wave, F.G * 8); __syncthreads(); }
            if (MK_MASK & 2) ln_phase(F, ap->in[0], LnStage{nullptr, nullptr, nullptr}, LnStage{nullptr, nullptr, nullptr}, nullptr, true, (const float*)(ws + WS_MOD), (bf16_t*)(ws + WS_H));
        } else {
            const int l = (ph - 2) >> 2, k = (ph - 2) & 3;
            if (k == 0) { if (MK_MASK & 4) {
                const bf16_t* H = (const bf16_t*)(ws + WS_H); const bf16_t* W = (const bf16_t*)(ws + WS_WIN) + (size_t)l * DIN * D;
                pg8::Gemm g{H, W, W + (size_t)5120 * D, H, D};
                pg8::ProjOrder S; S.init(F.G, bx);
                pg8::EpiProj E{(bf16_t*)(ws + WS_GA), (bf16_t*)(ws + WS_VG), (bf16_t*)(ws + WS_Q), (bf16_t*)(ws + WS_VT)};
                pg8::gemm_phase<pg8::EpiProj, pg8::ProjOrder>(F.lds, F.tid, g, S, E); }
            } else if (k == 1) {
                const AttnPtrs P{ap->in[9], (const bf16_t*)(ws + WS_Q), (const bf16_t*)(ws + WS_K), (const bf16_t*)(ws + WS_VT), (const bf16_t*)(ws + WS_ZB), (bf16_t*)(ws + WS_H)};
                AttnPre pre;
                sgu_phase(F, l, ap->in[5], ap->in[6], ap->in[8], (const bf16_t*)(ws + WS_WSB), (const bf16_t*)(ws + WS_VG), (const bf16_t*)(ws + WS_GA), (bf16_t*)(ws + WS_H), P, pre);
                attn_phase(F, P, l, pre);
            } else if (k == 2) { if (MK_MASK & 32) {
                pg8::Gemm g{(const bf16_t*)(ws + WS_H), (const bf16_t*)(ws + WS_WOUT) + (size_t)l * D * D, nullptr, nullptr, D};
                pg8::StaticOrder S; S.init(M, D, F.G, bx);
                LAS float* g1 = (LAS float*)(F.lds + pg8::STAGE_BYTES);
                { const float* gsrc = (const float*)(ws + WS_MOD) + (size_t)l * BATCH * NMOD + 2 * D;
                  for (int i = F.tid; i < BATCH * D / 4; i += 512) { const int b = i / (D / 4), c4 = i % (D / 4); *(LAS f32x4*)(g1 + b * D + c4 * 4) = *(const f32x4*)(gsrc + (size_t)b * NMOD + c4 * 4) + 1.0f; }
                  __syncthreads(); }
                pg8::EpiOut E{g1, (bf16_t*)(ws + (l == 0 ? WS_Y0 : WS_Y))};
                pg8::gemm_phase<pg8::EpiOut, pg8::StaticOrder>(F.lds, F.tid, g, S, E); }
            } else {
                const LnStage s0{(const bf16_t*)(ws + WS_Y0), ap->in[11], ap->in[12]};
                if (l == 0) { if (MK_MASK & 2) ln_phase(F, ap->in[0], s0, LnStage{nullptr, nullptr, nullptr}, nullptr, true, (const float*)(ws + WS_MOD) + (size_t)BATCH * NMOD, (bf16_t*)(ws + WS_H)); }
                else { const LnStage s1{(const bf16_t*)(ws + WS_Y), ap->in[11] + D, ap->in[12] + D};
                    if (MK_MASK & 2) ln_phase(F, ap->in[0], s0, s1, ap->out, false, nullptr, nullptr); }
            }
        }
        if (ph + 1 < hi || rep_ + 1 < nrep_) {
            if (ph == 0 || !split_ok) xcd_barrier(bar);
            else {
                if (ph == 5 && half_ == 0u && threadIdx.x == 0) {
                    unsigned* hc = (unsigned*)(ws + WS_CTL) + CW_HANDOFF; unsigned sp = 0;
                    while (xb_ld(hc) < gridDim.x / 2) { __builtin_amdgcn_s_sleep(2); if (++sp > (1u << 22)) break; }
                }
                xcd_barrier(barh);
                if (ph == 1 && half_ == 1u && threadIdx.x == 0 && rep_ == 0) xb_add((unsigned*)(ws + WS_CTL) + CW_HANDOFF, 1u);
            }
        }
      }
    }
}

extern "C" void kernel_launch(void* const* d_in, const int* in_sizes, int n_in, void* d_out, int out_size, void* d_ws, size_t ws_size, hipStream_t stream) {
    static int grid = 0;
    if (grid == 0) {
        if (n_in != 13 || out_size != M * D || ws_size < WS_END) { fprintf(stderr, "kernel_launch: unexpected shapes (n_in %d, out %d, ws %zu)\n", n_in, out_size, ws_size); grid = -1; return; }
        int dev = 0, cus = 0, per_cu = 0;
        if (hipGetDevice(&dev) != hipSuccess || hipDeviceGetAttribute(&cus, hipDeviceAttributeMultiprocessorCount, dev) != hipSuccess) { grid = -1; return; }
        if (hipFuncSetAttribute((const void*)mk_fwd, hipFuncAttributeMaxDynamicSharedMemorySize, LDS_BYTES) != hipSuccess) { fprintf(stderr, "kernel_launch: hipFuncSetAttribute failed\n"); grid = -1; return; }
        if (hipOccupancyMaxActiveBlocksPerMultiprocessor(&per_cu, (const void*)mk_fwd, 512, LDS_BYTES) != hipSuccess || per_cu < 1) { fprintf(stderr, "kernel_launch: occupancy query reports %d blocks per CU\n", per_cu); per_cu = 1; }
        (void)hipGetLastError();
        grid = cus;
    }
    if (grid < 0) return;
    (void)hipMemsetAsync((char*)d_ws + WS_CTL, 0, CTL_ZERO_BYTES, stream);
    Args a{};
    for (int i = 0; i < 13; ++i) a.in[i] = (const float*)d_in[i];
    a.out = (float*)d_out; a.ws = (unsigned char*)d_ws;
    if (MK_N_LAUNCHES == 1) { a.ph_lo = 0; a.ph_hi = N_PHASES; hipLaunchKernelGGL(mk_fwd, dim3(grid), dim3(512), LDS_BYTES, stream, a); }
    else { for (int p = 0; p < N_PHASES; ++p) { a.ph_lo = p; a.ph_hi = p + 1; hipLaunchKernelGGL(mk_fwd, dim3(grid), dim3(512), LDS_BYTES, stream, a); } }
}
```

```cpp
#include <hip/hip_runtime.h>
#include <cstdio>
#include <cstdint>

#ifndef MK_N_LAUNCHES
#define MK_N_LAUNCHES 1
#endif

#define LAS __attribute__((address_space(3)))
#define GAS __attribute__((address_space(1)))
typedef unsigned short bf16_t;
typedef short bf16x8 __attribute__((ext_vector_type(8)));
typedef float f32x4 __attribute__((ext_vector_type(4)));
typedef float f32x2 __attribute__((ext_vector_type(2)));
typedef unsigned u32x4 __attribute__((ext_vector_type(4)));
typedef unsigned u32x2 __attribute__((ext_vector_type(2)));

constexpr int BATCH = 2, T = 8192, D = 2048, M = BATCH * T, DIN = 7168, DS = 1024, NG = 8, NH = 16, DEPTH = 2;
constexpr int NMOD = 3 * D;
constexpr float LN_EPS = 1e-5f;
constexpr float DN_ALPHA = 1.4142135623730951f;

typedef __bf16 bf16v2 __attribute__((ext_vector_type(2)));
__device__ __forceinline__ unsigned cvt_pk_bf16(float lo, float hi) { const f32x2 v = {lo, hi}; const bf16v2 r = __builtin_convertvector(v, bf16v2); return __builtin_bit_cast(unsigned, r); }
__device__ __forceinline__ float bf_lo(unsigned w) { return __builtin_bit_cast(float, w << 16); }
__device__ __forceinline__ float bf_hi(unsigned w) { return __builtin_bit_cast(float, w & 0xffff0000u); }
__device__ __forceinline__ float silu_f(float x) { return x * __builtin_amdgcn_rcpf(1.0f + __builtin_amdgcn_exp2f(-1.4426950408889634f * x)); }
__device__ __forceinline__ f32x2 gelu_pk(f32x2 v) {
    f32x2 c; c.x = __builtin_amdgcn_fmed3f(v.x, -4.0f, 4.0f); c.y = __builtin_amdgcn_fmed3f(v.y, -4.0f, 4.0f);
    const f32x2 s = c * c;
    f32x2 r = s * 7.0374646370e-11f + (-6.2872893160e-09f);
    r = r * s + 2.5093203053e-07f; r = r * s + (-5.9760889818e-06f); r = r * s + 9.6085055597e-05f; r = r * s + (-1.1195942566e-03f);
    r = r * s + 9.8383713455e-03f; r = r * s + (-6.6361911043e-02f); r = r * s + 3.9890514886e-01f;
    return v * (c * r + 0.5f);
}
__device__ __forceinline__ f32x4 gelu4(f32x4 v) { f32x2 a = gelu_pk((f32x2){v[0], v[1]}), b = gelu_pk((f32x2){v[2], v[3]}); return (f32x4){a.x, a.y, b.x, b.y}; }
__device__ __forceinline__ f32x2 silu_pk(f32x2 v) { const f32x2 a = v * (-1.4426950408889634f); f32x2 e; e.x = __builtin_amdgcn_exp2f(a.x); e.y = __builtin_amdgcn_exp2f(a.y);
    const f32x2 d = e + 1.0f; f32x2 r; r.x = __builtin_amdgcn_rcpf(d.x); r.y = __builtin_amdgcn_rcpf(d.y); return v * r; }
__device__ __forceinline__ f32x4 silu4(f32x4 v) { const f32x2 a = silu_pk((f32x2){v[0], v[1]}), b = silu_pk((f32x2){v[2], v[3]}); return (f32x4){a.x, a.y, b.x, b.y}; }
#ifndef MK_REP
#define MK_REP 0
#endif
__device__ __forceinline__ void store8(bf16_t* p, f32x4 a, f32x4 b) { u32x4 w; w.x = cvt_pk_bf16(a[0], a[1]); w.y = cvt_pk_bf16(a[2], a[3]); w.z = cvt_pk_bf16(b[0], b[1]); w.w = cvt_pk_bf16(b[2], b[3]); *(u32x4*)p = w;
    if (MK_REP & 128) { asm volatile("" ::: "memory"); *(u32x4*)p = w; asm volatile("" ::: "memory"); } }

namespace pg8 {
constexpr int BM = 256, BK = 64, HALF = 128, HTB = HALF * BK * 2, STAGE_BYTES = 8 * HTB, NXCD = 8, WGM = 2;
__host__ __device__ __forceinline__ int lds_byte(int r, int c) { const int st = (r >> 4) * 2 + (c >> 5), rr = r & 15, cc = c & 31, ob = rr * 64 + cc * 2; return st * 1024 + (ob ^ (((ob >> 9) & 1) << 5)); }
__host__ __device__ __forceinline__ void stage_rc(int b, int& R, int& C) { const int st = b / 1024, sb = b % 1024, swz = sb ^ (((sb >> 9) & 1) << 5); R = (st >> 1) * 16 + swz / 64; C = (st & 1) * 32 + (swz % 64) / 2; }
__host__ __device__ __forceinline__ int perm32(int rho) { const int n = rho >> 4, i = rho & 15; return 8 * (i >> 2) + 4 * n + (i & 3); }

struct Unit { int pm, pn, kind; };
struct Gemm { const bf16_t* A0; const bf16_t* B0; const bf16_t* A1; const bf16_t* B1; int K; };

struct StaticOrder {
    int nM, nN, nwg, G, c;
    __device__ void init(int M_, int N_, int G_, int c_) { nM = M_ / BM; nN = N_ / BM; nwg = nM * nN; G = G_; c = c_; }
    __device__ __forceinline__ void map(int wgid, Unit& u) const {
        { const int q = nwg / NXCD, r = nwg % NXCD, xcd = wgid % NXCD, off = wgid / NXCD; wgid = (xcd < r ? xcd * (q + 1) : r * (q + 1) + (xcd - r) * q) + off; }
        const int nig = WGM * nN, gid = wgid / nig, fm = gid * WGM, gsz = (nM - fm) < WGM ? (nM - fm) : WGM;
        u.pm = fm + ((wgid % nig) % gsz); u.pn = (wgid % nig) / gsz; u.kind = 0;
    }
    __device__ __forceinline__ bool next(int i, Unit& u) const { const long L = (long)i * G + c; if (L >= nwg) return false; map((int)L, u); return true; }
};
struct ProjOrder {
    StaticOrder S; int nswap;
    __device__ void init(int G_, int c_) { S.init(M, 5120, G_, c_); nswap = 512; }
    __device__ __forceinline__ bool next(int i, Unit& u) const {
        const long L = (long)i * S.G + S.c;
        if (L < S.nwg) { S.map((int)L, u); return true; }
        const int idx = (int)(L - S.nwg); if (idx >= nswap) return false;
        const int x = idx % 8, t = idx / 8, rnd = t >> 5, j = t & 31;
        u.pm = (j + 4 * rnd) & 7; u.pn = 8 * x + 4 * rnd + (j >> 3); u.kind = 1; return true;
    }
};

struct EpiProj {
    static constexpr bool PERM = true;
    __device__ __forceinline__ void stage(int) const {}
    bf16_t *GA, *VGT, *Qb, *VT;
    __device__ __forceinline__ void operator()(const f32x4 (&acc)[2][2][4][2], const Unit& u, int wr, int wc, int fr, int fq) const {
        const int rl = wr * 64 + fr, cl = wc * 32 + 8 * fq;
        if (u.kind == 1) {
            const int tok0 = u.pn * 256 + cl;
            if (u.pm < 4) {
#pragma unroll
                for (int ai = 0; ai < 2; ++ai)
#pragma unroll
                    for (int m = 0; m < 4; ++m) { const int ch = u.pm * 256 + rl + ai * HALF + m * 16;
#pragma unroll
                        for (int bj = 0; bj < 2; ++bj) { const int tk = tok0 + bj * HALF;
                            store8(VGT + ((size_t)(tk >> 7) * DS + ch) * 128 + (tk & 127), gelu4(acc[ai][bj][m][0]), gelu4(acc[ai][bj][m][1])); } }
            } else {
                const int bb = tok0 >> 13;
#pragma unroll
                for (int ai = 0; ai < 2; ++ai)
#pragma unroll
                    for (int m = 0; m < 4; ++m) { const int ch = (u.pm - 4) * 256 + rl + ai * HALF + m * 16;
                        bf16_t* rowp = VT + ((size_t)(bb * NH + (ch >> 6)) * (T / 8) * 64 + (ch & 63)) * 8;
#pragma unroll
                        for (int bj = 0; bj < 2; ++bj) store8(rowp + (size_t)(((tok0 + bj * HALF) & (T - 1)) >> 3) * 512, acc[ai][bj][m][0], acc[ai][bj][m][1]); }
            }
        } else if (u.pn < 8) {
            bf16_t* base = GA + (size_t)(u.pm * 256 + rl) * DS + u.pn * 128 + cl;
#pragma unroll
            for (int ai = 0; ai < 2; ++ai)
#pragma unroll
                for (int m = 0; m < 4; ++m) {
                    const f32x4 r0 = gelu4(acc[ai][0][m][0]) * silu4(acc[ai][1][m][0]), r1 = gelu4(acc[ai][0][m][1]) * silu4(acc[ai][1][m][1]);
                    store8(base + (size_t)(ai * HALF + m * 16) * DS, r0, r1); }
        } else {
            const int t = (u.pn - 8) >> 2, colt = ((u.pn - 8) & 3) * 256;
            bf16_t* out = Qb + (size_t)t * ((size_t)M * DS);
            const int row0 = u.pm * 256 + rl;
            const int bb = row0 >> 13, t0 = row0 & (T - 1);
#define EPI_QKZ(XFORM) _Pragma("unroll") for (int bj = 0; bj < 2; ++bj) { const int col = colt + bj * HALF + cl; \
                bf16_t* base = out + ((size_t)(bb * NH + (col >> 6)) * T + t0) * 64 + (col & 63); \
                _Pragma("unroll") for (int ai = 0; ai < 2; ++ai) _Pragma("unroll") for (int m = 0; m < 4; ++m) { f32x4 v0 = acc[ai][bj][m][0], v1 = acc[ai][bj][m][1]; XFORM; \
                        store8(base + (size_t)(ai * HALF + m * 16) * 64, v0, v1); } }
            if (t == 0) { EPI_QKZ(v0 = v0 * 0.18033688011112042f; v1 = v1 * 0.18033688011112042f) }
            else if (t == 2) { EPI_QKZ(v0 = silu4(v0); v1 = silu4(v1)) }
            else { EPI_QKZ((void)0) }
#undef EPI_QKZ
        }
    }
};
struct EpiOut {
    static constexpr bool PERM = true;
    LAS float* gate1; bf16_t* Y;
    f32x4 gr0, gr1;
    __device__ __forceinline__ void stage(int tid) const { *(LAS f32x4*)(gate1 + tid * 4) = gr0 + 1.0f; *(LAS f32x4*)(gate1 + (512 + tid) * 4) = gr1 + 1.0f; }
    __device__ __forceinline__ void operator()(const f32x4 (&acc)[2][2][4][2], const Unit& u, int wr, int wc, int fr, int fq) const {
        const int row0 = u.pm * BM + wr * 64 + fr, col0 = u.pn * BM + wc * 32 + 8 * fq;
        const LAS float* gp = gate1 + (u.pm >= (T / BM) ? D : 0) + col0;
        f32x4 g4[2][2];
#pragma unroll
        for (int bj = 0; bj < 2; ++bj)
#pragma unroll
            for (int n = 0; n < 2; ++n) g4[bj][n] = *(const LAS f32x4*)(gp + bj * HALF + n * 4);
#pragma unroll
        for (int ai = 0; ai < 2; ++ai)
#pragma unroll
            for (int m = 0; m < 4; ++m) { bf16_t* rowp = Y + (size_t)(row0 + ai * HALF + m * 16) * D + col0;
#pragma unroll
                for (int bj = 0; bj < 2; ++bj) store8(rowp + bj * HALF, g4[bj][0] * acc[ai][bj][m][0], g4[bj][1] * acc[ai][bj][m][1]); }
    }
};

template <class Epi, class Sched>
__device__ __forceinline__ void gemm_phase(LAS unsigned char* lds, const int tid, const Gemm g, const Sched& S, const Epi& E) {
    const int wid = __builtin_amdgcn_readfirstlane(tid >> 6), lane = tid & 63, wr = wid >> 2, wc = wid & 3, fr = lane & 15, fq = lane >> 4;
    const int K = g.K, nt = K / BK;
    unsigned voffA[2], voffB[2];
#pragma unroll
    for (int i = 0; i < 2; ++i) { int R, C; stage_rc(tid * 16 + i * 8192, R, C); const int Rb = Epi::PERM ? ((R & ~31) + perm32(R & 31)) : R;
        voffA[i] = (unsigned)(R * K + C) * 2u; voffB[i] = (unsigned)(Rb * K + C) * 2u; }
    const size_t kstep = (size_t)(BK * 2);
    const size_t hstep = (size_t)HALF * K * 2;
    const size_t tstep = 2 * hstep;
    const unsigned ldsw = (unsigned)wid * 1024u;
    const int aoff = lds_byte(wr * 64 + fr, fq * 8), boff = lds_byte(wc * 32 + fr, fq * 8);
#define PG8_SA(b, h) (((b) * 2 + (h)) * HTB)
#define PG8_SB(b, h) ((4 + (b) * 2 + (h)) * HTB)
#define PG8_STAGE(bufoff, gbase, voff) do { _Pragma("unroll") for (int _i = 0; _i < 2; ++_i) \
        __builtin_amdgcn_global_load_lds((const unsigned*)((const char*)(gbase) + (voff)[_i]), (LAS unsigned*)(lds + (bufoff) + ldsw + _i * 8192), 16, 0, 0); } while (0)
#define PG8_LDA(dst, b, h) do { _Pragma("unroll") for (int m = 0; m < 4; ++m) _Pragma("unroll") for (int k = 0; k < 2; ++k) dst[m][k] = *(const LAS bf16x8*)(lds + PG8_SA(b, h) + aoff + m * 2048 + k * 1024); } while (0)
#define PG8_LDB(dst, b, h) do { _Pragma("unroll") for (int n = 0; n < 2; ++n) _Pragma("unroll") for (int k = 0; k < 2; ++k) dst[n][k] = *(const LAS bf16x8*)(lds + PG8_SB(b, h) + boff + n * 2048 + k * 1024); } while (0)
#define PG8_MMA(ai, bj, At, Bt) do { __builtin_amdgcn_sched_barrier(0); _Pragma("unroll") for (int m = 0; m < 4; ++m) _Pragma("unroll") for (int n = 0; n < 2; ++n) _Pragma("unroll") for (int k = 0; k < 2; ++k) \
        acc[ai][bj][m][n] = __builtin_amdgcn_mfma_f32_16x16x32_bf16(Bt[n][k], At[m][k], acc[ai][bj][m][n], 0, 0, 0); __builtin_amdgcn_sched_barrier(0); } while (0)
#define PG8_WAIT_V(n) asm volatile("s_waitcnt vmcnt(" #n ")" ::: "memory")
#define PG8_WAIT_L(n) asm volatile("s_waitcnt lgkmcnt(" #n ")" ::: "memory")
#define PG8_BAR __builtin_amdgcn_s_barrier()
#define PG8_SCHED __builtin_amdgcn_sched_barrier(0)
#define PG8_UA(u) ((const char*)((u).kind ? g.A1 : g.A0) + (size_t)(u).pm * tstep)
#define PG8_UB(u) ((const char*)((u).kind ? g.B1 : g.B0) + (size_t)(u).pn * tstep)
    Unit cur, nxt; int ui = 0;
    if (!S.next(0, cur)) return;
    f32x4 acc[2][2][4][2];
#pragma unroll
    for (int a = 0; a < 2; ++a)
#pragma unroll
        for (int b = 0; b < 2; ++b)
#pragma unroll
            for (int m = 0; m < 4; ++m)
#pragma unroll
                for (int n = 0; n < 2; ++n) acc[a][b][m][n] = (f32x4){0.f, 0.f, 0.f, 0.f};
    bf16x8 At[4][2], B0[2][2], B1[2][2];
    const char* cA = PG8_UA(cur); const char* cB = PG8_UB(cur);
    PG8_STAGE(PG8_SB(0, 0), cB, voffB); PG8_STAGE(PG8_SB(0, 1), cB + hstep, voffB); PG8_STAGE(PG8_SA(0, 0), cA, voffA); PG8_STAGE(PG8_SA(0, 1), cA + hstep, voffA);
    E.stage(tid);
    if (wr == 1) PG8_BAR;
    PG8_WAIT_V(2); PG8_BAR;
    PG8_STAGE(PG8_SB(1, 0), cB + kstep, voffB); PG8_STAGE(PG8_SA(1, 0), cA + kstep, voffA); PG8_STAGE(PG8_SB(1, 1), cB + hstep + kstep, voffB);
    PG8_WAIT_V(6); PG8_BAR;
    for (;;) {
        const bool has_next = S.next(ui + 1, nxt);
        const char* nA = has_next ? PG8_UA(nxt) : cA; const char* nB = has_next ? PG8_UB(nxt) : cB;
        for (int t = 0; t < nt; t += 2) {
            const bool last = (t == nt - 2);
            const char* a1 = cA + (size_t)(t + 1) * kstep;
            const char* a2 = last ? nA : cA + (size_t)(t + 2) * kstep; const char* b2 = last ? nB : cB + (size_t)(t + 2) * kstep;
            const char* a3 = a2 + kstep; const char* b3 = b2 + kstep;
            PG8_LDB(B0, 0, 0); PG8_LDB(B1, 0, 1); PG8_SCHED; PG8_LDA(At, 0, 0); PG8_STAGE(PG8_SA(1, 1), a1 + hstep, voffA);
            PG8_WAIT_V(8); PG8_WAIT_L(0); PG8_BAR; PG8_MMA(0, 0, At, B0); PG8_MMA(0, 1, At, B1); PG8_BAR; PG8_SCHED;
            PG8_LDA(At, 0, 1); PG8_STAGE(PG8_SB(0, 0), b2, voffB); PG8_STAGE(PG8_SB(0, 1), b2 + hstep, voffB); PG8_STAGE(PG8_SA(0, 0), a2, voffA);
            PG8_WAIT_V(8); PG8_WAIT_L(0); PG8_BAR; PG8_MMA(1, 0, At, B0); PG8_MMA(1, 1, At, B1); PG8_BAR; PG8_SCHED;
            PG8_LDB(B0, 1, 0); PG8_LDB(B1, 1, 1); PG8_SCHED; PG8_LDA(At, 1, 0); PG8_STAGE(PG8_SA(0, 1), a2 + hstep, voffA);
            PG8_WAIT_V(8); PG8_WAIT_L(0); PG8_BAR; PG8_MMA(0, 0, At, B0); PG8_MMA(0, 1, At, B1); PG8_BAR; PG8_SCHED;
            PG8_LDA(At, 1, 1); PG8_STAGE(PG8_SB(1, 0), b3, voffB); PG8_STAGE(PG8_SB(1, 1), b3 + hstep, voffB); PG8_STAGE(PG8_SA(1, 0), a3, voffA);
            PG8_WAIT_V(8); PG8_WAIT_L(0); PG8_BAR; PG8_MMA(1, 0, At, B0); PG8_MMA(1, 1, At, B1); PG8_BAR; PG8_SCHED;
        }
        if (wr == 0) PG8_BAR;
        E(acc, cur, wr, wc, fr, fq);
        if (!has_next) break;
#pragma unroll
        for (int a = 0; a < 2; ++a)
#pragma unroll
            for (int b = 0; b < 2; ++b)
#pragma unroll
                for (int m = 0; m < 4; ++m)
#pragma unroll
                    for (int n = 0; n < 2; ++n) acc[a][b][m][n] = (f32x4){0.f, 0.f, 0.f, 0.f};
        cur = nxt; cA = nA; cB = nB; ++ui;
        if (wr == 1) PG8_BAR;
    }
    PG8_WAIT_V(0);
    PG8_BAR;
#undef PG8_SA
#undef PG8_SB
#undef PG8_STAGE
#undef PG8_LDA
#undef PG8_LDB
#undef PG8_MMA
#undef PG8_WAIT_V
#undef PG8_WAIT_L
#undef PG8_BAR
#undef PG8_SCHED
#undef PG8_UA
#undef PG8_UB
}
}

constexpr size_t MiB = 1u << 20;
constexpr size_t WS_CTL = 0, CTL_ZERO_BYTES = 64 * 1024;
constexpr size_t WS_MOD = 1 * MiB;
constexpr size_t WS_WSB = 1 * MiB + 512 * 1024;
constexpr size_t WS_WIN = 2 * MiB;
constexpr size_t WS_WOUT = 58 * MiB;
constexpr size_t WS_H = 80 * MiB;
constexpr size_t WS_GA = 144 * MiB, WS_VG = 176 * MiB, WS_Q = 208 * MiB, WS_K = 240 * MiB, WS_ZB = 272 * MiB, WS_VT = 304 * MiB;
constexpr size_t WS_Y = 144 * MiB;
constexpr size_t WS_Y0 = 336 * MiB;
constexpr size_t WS_END = 400 * MiB;
static_assert(WS_K - WS_Q == (size_t)M * DS * 2 && WS_ZB - WS_K == (size_t)M * DS * 2, "EpiProj indexes Q|K|ZB as one array");
static_assert((4096 + 3 * 3456) * 4 <= 64 * 1024, "control words inside the memset region");
constexpr int CW_BAR = 4096, CW_HANDOFF = 64;

constexpr int RING_BYTES = 131072, LDS_BYTES = 163840, LDSCTL_OFF = LDS_BYTES - 1024, MISC_OFF = LDSCTL_OFF + 320;

typedef GAS unsigned gu32;
#define RLX_AGENT __ATOMIC_RELAXED, __HIP_MEMORY_SCOPE_AGENT
#define LDS_WAIT() asm volatile("s_waitcnt lgkmcnt(0)" ::: "memory")

#define XB_TMO      128
#define XB_XCNT(j)  (256  + 64 * (j))
#define XB_XSUB(j)  (1280 + 64 * (j))
#define XB_XGEN(j)  (2304 + 64 * (j))
#define XB_TOP      3328
#define XB_TOPGEN   3392
#define XCD_BAR_WORDS 3456
#define XB_SPIN_CAP (1u << 18)
__device__ __forceinline__ unsigned xb_ld(unsigned* p)              { return __hip_atomic_load(p, __ATOMIC_RELAXED, __HIP_MEMORY_SCOPE_AGENT); }
__device__ __forceinline__ unsigned xb_add(unsigned* p, unsigned v) { return __hip_atomic_fetch_add(p, v, __ATOMIC_RELAXED, __HIP_MEMORY_SCOPE_AGENT); }
__device__ __forceinline__ unsigned xb_xcc_id() { return (unsigned)__builtin_amdgcn_s_getreg((3 << 11) | 20) & 0xFu; }
#define XB_SPIN(cond, bar) do { unsigned _sp = 0; while (cond) { __builtin_amdgcn_s_sleep(1); \
    if ((++_sp & 255u) == 0u) { if (xb_ld(&(bar)[XB_TMO])) break; if (_sp > XB_SPIN_CAP) { atomicAdd(&(bar)[XB_TMO], 1u); break; } } } } while (0)
struct XcdBarrier { unsigned* bar; unsigned x; volatile LAS unsigned* st; unsigned expect; };
__device__ __forceinline__ XcdBarrier xcd_barrier_post(unsigned* bar, volatile LAS unsigned* st, unsigned expect) {
    XcdBarrier b; b.bar = bar; b.x = xb_xcc_id(); b.st = st; b.expect = expect;
    if (threadIdx.x == 0) (void)xb_add(&bar[XB_XCNT(b.x)], 1u);
    return b;
}
__device__ __forceinline__ void xcd_barrier_complete(unsigned* bar, unsigned x, unsigned G, unsigned& nloc, unsigned& nx) {
    unsigned sum, cnt, mine, sp = 0u;
    for (;;) {
        sum = 0u; cnt = 0u; mine = 0u;
#pragma unroll
        for (unsigned j = 0; j < 16; ++j) { const unsigned c = xb_ld(&bar[XB_XCNT(j)]); sum += c; cnt += (c > 0u) ? 1u : 0u; mine = (j == x) ? c : mine; }
        if (sum == G) break;
        __builtin_amdgcn_s_sleep(1);
        if ((++sp & 255u) == 0u) { if (xb_ld(&bar[XB_TMO])) break; if (sp > XB_SPIN_CAP) { atomicAdd(&bar[XB_TMO], 1u); break; } }
    }
    nloc = mine > 0u ? mine : 1u; nx = cnt > 0u ? cnt : 1u;
}
__device__ __forceinline__ void xcd_barrier(const XcdBarrier& b) {
    asm volatile("s_waitcnt vmcnt(0)" ::: "memory");
    __syncthreads();
    if (threadIdx.x == 0) {
        unsigned* bar = b.bar;
        __builtin_amdgcn_s_waitcnt(0);
        unsigned nloc = b.st[0], nx = b.st[1];
        if (nloc == 0u) { xcd_barrier_complete(bar, b.x, b.expect, nloc, nx); b.st[0] = nloc; b.st[1] = nx; }
        const unsigned old = xb_add(&bar[XB_XSUB(b.x)], 1u);
        const unsigned gen = old / nloc;
        if (old + 1u == (gen + 1u) * nloc) {
            __builtin_amdgcn_fence(__ATOMIC_RELEASE, "agent");
            asm volatile("s_waitcnt vmcnt(0)" ::: "memory");
            const unsigned og = xb_add(&bar[XB_TOP], 1u);
            const unsigned tg = og / nx;
            if (og + 1u == (tg + 1u) * nx) xb_add(&bar[XB_TOPGEN], 1u);
            else XB_SPIN(xb_ld(&bar[XB_TOPGEN]) == tg, bar);
            __builtin_amdgcn_fence(__ATOMIC_ACQUIRE, "agent");
            xb_add(&bar[XB_XGEN(b.x)], 1u);
            asm volatile("s_waitcnt vmcnt(0)" ::: "memory");
        } else {
            XB_SPIN(xb_ld(&bar[XB_XGEN(b.x)]) == gen, bar);
            __builtin_amdgcn_fence(__ATOMIC_ACQUIRE, "agent");
            asm volatile("s_waitcnt vmcnt(0)" ::: "memory");
        }
    }
    __syncthreads();
}

struct Frame {
    LAS unsigned char* lds;
    int tid, lane, wave, vcu, G;
};

#define DPP_ADD(v, ctrl) ((v) + __builtin_bit_cast(float, __builtin_amdgcn_update_dpp(0, __builtin_bit_cast(int, (v)), (ctrl), 0xf, 0xf, true)))
__device__ __forceinline__ float wave_sum(float v) {
    v = DPP_ADD(v, 0xB1);
    v = DPP_ADD(v, 0x4E);
    v = DPP_ADD(v, 0x141);
    v = DPP_ADD(v, 0x140);
    const int vi = __builtin_bit_cast(int, v);
    const float r0 = __builtin_bit_cast(float, __builtin_amdgcn_readlane(vi, 0)), r1 = __builtin_bit_cast(float, __builtin_amdgcn_readlane(vi, 16));
    const float r2 = __builtin_bit_cast(float, __builtin_amdgcn_readlane(vi, 32)), r3 = __builtin_bit_cast(float, __builtin_amdgcn_readlane(vi, 48));
    return (r0 + r1) + (r2 + r3);
}

__device__ __forceinline__ void p0_transpose_item(const float* W, int N, bf16_t* WT, int K, int k0, int n0, int drow0, LAS float* scr, int lane) {
#pragma unroll 8
    for (int i = 0; i < 32; ++i) { const int kk = 2 * i + (lane >> 5); scr[kk * 33 + (lane & 31)] = __builtin_nontemporal_load(W + (size_t)(k0 + kk) * N + n0 + (lane & 31)); }
    LDS_WAIT(); asm volatile("" ::: "memory");
    const int c = lane & 7;
#pragma unroll
    for (int j = 0; j < 4; ++j) { const int n = (lane >> 3) + 8 * j; const LAS float* s = scr + (8 * c) * 33 + n;
        u32x4 o; o.x = cvt_pk_bf16(s[0 * 33], s[1 * 33]); o.y = cvt_pk_bf16(s[2 * 33], s[3 * 33]); o.z = cvt_pk_bf16(s[4 * 33], s[5 * 33]); o.w = cvt_pk_bf16(s[6 * 33], s[7 * 33]);
        *(u32x4*)(WT + (size_t)(drow0 + n) * K + k0 + 8 * c) = o; }
    LDS_WAIT(); asm volatile("" ::: "memory");
}
__device__ __forceinline__ int win_dest_row(int n0) {
    const int s = n0 >> 10, ch = n0 & 1023;
    switch (s) {
        case 0: return 256 * (ch >> 7) + (ch & 127);
        case 1: return 5120 + ch;
        case 2: return 256 * (ch >> 7) + 128 + (ch & 127);
        case 3: return 2048 + ch;
        case 4: return 3072 + ch;
        case 5: return 6144 + ch;
        default: return 4096 + ch;
    }
}
__device__ __forceinline__ void p0_weights(const Frame& F, const float* w_in, const float* w_out, bf16_t* WIN, bf16_t* WOUT, int l, int gw, int NGW) {
    LAS float* scr = (LAS float*)(F.lds + F.wave * 16384);
    constexpr int I_IN = (D / 64) * (DIN / 32), I_OUT = (D / 64) * (D / 32), I_L = I_IN + I_OUT;
    for (int it = gw; it < I_L; it += NGW) {
        int r = it;
        if (r < I_IN) { const int kb = r / (DIN / 32), nb = r % (DIN / 32);
            p0_transpose_item(w_in + (size_t)l * D * DIN, DIN, WIN + (size_t)l * DIN * D, D, 64 * kb, 32 * nb, win_dest_row(32 * nb), scr, F.lane); }
        else { r -= I_IN; const int kb = r / (D / 32), nb = r % (D / 32);
            p0_transpose_item(w_out + (size_t)l * D * D, D, WOUT + (size_t)l * D * D, D, 64 * kb, 32 * nb, 32 * nb, scr, F.lane); }
    }
}
__device__ __forceinline__ void p0_prologue(const Frame& F, const float* c_in, const float* w_ada, const float* b_ada, const float* w_in, const float* w_out, const float* w_sp,
                                            float* MOD, bf16_t* WIN, bf16_t* WOUT, bf16_t* WSB) {
    LAS float* sc = (LAS float*)F.lds;
    LAS float* red = (LAS float*)(F.lds + 16384);
    constexpr int NCH = 48, NIT = NMOD / NCH;
    for (int it = F.vcu; it < DEPTH * NIT; it += F.G) {
        for (int i = F.tid; i < BATCH * D; i += 512) sc[i] = silu_f(c_in[i]);
        __syncthreads();
        const int l = it / NIT, n0 = (it % NIT) * NCH;
        const int ln = F.lane < NCH ? F.lane : NCH - 1;
        const float* W = w_ada + (size_t)l * D * NMOD + n0 + ln;
        const int k0 = F.wave * 256;
        float a0 = 0.f, a1 = 0.f;
#pragma unroll 16
        for (int k = 0; k < 256; ++k) { const float w = __builtin_nontemporal_load(W + (size_t)(k0 + k) * NMOD); a0 += sc[k0 + k] * w; a1 += sc[D + k0 + k] * w; }
        red[(F.wave * 2 + 0) * 64 + F.lane] = a0; red[(F.wave * 2 + 1) * 64 + F.lane] = a1;
        __syncthreads();
        if (F.tid < 128 && (F.tid & 63) < NCH) { const int b = F.tid >> 6, lc = F.tid & 63; float s = 0.f;
#pragma unroll
            for (int w = 0; w < 8; ++w) s += red[(w * 2 + b) * 64 + lc];
            MOD[(size_t)(l * BATCH + b) * NMOD + n0 + lc] = s + b_ada[(size_t)l * NMOD + n0 + lc]; }
        __syncthreads();
    }
    p0_weights(F, w_in, w_out, WIN, WOUT, 0, F.vcu * 8 + F.wave, F.G * 8);
    const int gw = F.vcu * 8 + F.wave, NGW = F.G * 8;
    for (int i = (gw * 64 + F.lane) * 4; i < DEPTH * NG * 128 * 128; i += NGW * 64 * 4) { const f32x4 v = *(const f32x4*)(w_sp + i); u32x2 o; o.x = cvt_pk_bf16(v[0], v[1]); o.y = cvt_pk_bf16(v[2], v[3]); *(u32x2*)(WSB + i) = o; }
}

__device__ __forceinline__ void lds_sync() { asm volatile("s_waitcnt lgkmcnt(0)" ::: "memory"); __builtin_amdgcn_s_barrier(); asm volatile("" ::: "memory"); }
struct LnStage { const bf16_t* y; const float* g; const float* b; };
__device__ __forceinline__ void ln_row_norm(f32x4 (&v)[8], float& rstd) {
    float s = 0.f;
#pragma unroll
    for (int j = 0; j < 8; ++j) s += (v[j][0] + v[j][1]) + (v[j][2] + v[j][3]);
    const float mean = wave_sum(s) * (1.f / D); float s2 = 0.f;
#pragma unroll
    for (int j = 0; j < 8; ++j) { v[j] = v[j] - mean; s2 += (v[j][0] * v[j][0] + v[j][1] * v[j][1]) + (v[j][2] * v[j][2] + v[j][3] * v[j][3]); }
    rstd = __builtin_amdgcn_rsqf(wave_sum(s2) * (1.f / D) + LN_EPS);
}
__device__ __forceinline__ void ln_phase(const Frame& F, const float* src, const LnStage sa, const LnStage sb, float* xout, bool has_h, const float* modn, bf16_t* H) {
    LAS float* tga = (LAS float*)F.lds;
    LAS float* tba = tga + D; LAS float* tgb = tba + D; LAS float* tbb = tgb + D; LAS float* ts = tbb + D; LAS float* th = ts + D;
    for (int rb = F.vcu; rb < M / 64; rb += F.G) {
        const int bat = (rb * 64) / T;
        f32x4 vA[8], vB[8]; u32x2 yaA[8], ybA[8], yaB[8], ybB[8];
        auto load_row = [&](f32x4 (&v)[8], u32x2 (&ya)[8], u32x2 (&yb)[8], int i) __attribute__((always_inline)) {
            const size_t row = (size_t)rb * 64 + F.wave * 8 + i;
            const f32x4* xr = (const f32x4*)(src + row * D) + F.lane;
#pragma unroll
            for (int j = 0; j < 8; ++j) v[j] = __builtin_nontemporal_load(xr + 64 * j);
            if (sa.y) { const u32x2* yr = (const u32x2*)(sa.y + row * D) + F.lane;
#pragma unroll
                for (int j = 0; j < 8; ++j) ya[j] = yr[64 * j]; }
            if (sb.y) { const u32x2* yr = (const u32x2*)(sb.y + row * D) + F.lane;
#pragma unroll
                for (int j = 0; j < 8; ++j) yb[j] = yr[64 * j]; }
        };
        auto do_row = [&](f32x4 (&v)[8], u32x2 (&ya)[8], u32x2 (&yb)[8], int i) __attribute__((always_inline)) {
            const size_t row = (size_t)rb * 64 + F.wave * 8 + i;
            const LAS float* tl = tga + 4 * F.lane; asm volatile("" : "+v"(tl));
            if (sa.y) {
#pragma unroll
                for (int j = 0; j < 8; ++j) v[j] = v[j] * DN_ALPHA + (f32x4){bf_lo(ya[j].x), bf_hi(ya[j].x), bf_lo(ya[j].y), bf_hi(ya[j].y)};
                float rstd; ln_row_norm(v, rstd);
#pragma unroll
                for (int j = 0; j < 8; ++j) v[j] = v[j] * rstd * *(const LAS f32x4*)(tl + 256 * j) + *(const LAS f32x4*)(tl + D + 256 * j);
            }
            if (sb.y) {
#pragma unroll
                for (int j = 0; j < 8; ++j) v[j] = v[j] * DN_ALPHA + (f32x4){bf_lo(yb[j].x), bf_hi(yb[j].x), bf_lo(yb[j].y), bf_hi(yb[j].y)};
                float rstd; ln_row_norm(v, rstd);
#pragma unroll
                for (int j = 0; j < 8; ++j) v[j] = v[j] * rstd * *(const LAS f32x4*)(tl + 2 * D + 256 * j) + *(const LAS f32x4*)(tl + 3 * D + 256 * j);
            }
            if (xout) { f32x4* xo = (f32x4*)(xout + row * D) + F.lane;
#pragma unroll
                for (int j = 0; j < 8; ++j) __builtin_nontemporal_store(v[j], xo + 64 * j); }
            if (has_h) {
                float rstd; ln_row_norm(v, rstd);
                u32x2* ho = (u32x2*)(H + row * D) + F.lane;
#pragma unroll
                for (int j = 0; j < 8; ++j) { const f32x4 o = v[j] * rstd * *(const LAS f32x4*)(tl + 4 * D + 256 * j) + *(const LAS f32x4*)(tl + 5 * D + 256 * j);
                    u32x2 w; w.x = cvt_pk_bf16(o[0], o[1]); w.y = cvt_pk_bf16(o[2], o[3]); ho[64 * j] = w; }
            }
        };
        __syncthreads();
        {
            float tv[4][6];
#pragma unroll
            for (int q = 0; q < 4; ++q) { const int i = F.tid + 512 * q;
                if (sa.y) { tv[q][0] = sa.g[i]; tv[q][1] = sa.b[i]; }
                if (sb.y) { tv[q][2] = sb.g[i]; tv[q][3] = sb.b[i]; }
                if (has_h) { tv[q][4] = modn[(size_t)bat * NMOD + i]; tv[q][5] = modn[(size_t)bat * NMOD + D + i]; } }
            load_row(vA, yaA, ybA, 0);
#pragma unroll
            for (int q = 0; q < 4; ++q) { const int i = F.tid + 512 * q;
                if (sa.y) { tga[i] = tv[q][0]; tba[i] = tv[q][1]; }
                if (sb.y) { tgb[i] = tv[q][2]; tbb[i] = tv[q][3]; }
                if (has_h) { th[i] = tv[q][4]; ts[i] = 1.0f + tv[q][5]; } }
        }
        lds_sync();
        for (int i = 0; i < 6; i += 2) { load_row(vB, yaB, ybB, i + 1); do_row(vA, yaA, ybA, i); load_row(vA, yaA, ybA, i + 2); do_row(vB, yaB, ybB, i + 1); }
        load_row(vB, yaB, ybB, 7); do_row(vA, yaA, ybA, 6); do_row(vB, yaB, ybB, 7);
    }
    __syncthreads();
}

struct AttnPtrs { const float* rpb; const bf16_t *Qb, *Kb, *VT, *ZB; bf16_t* YC; };
constexpr int AK_OFF = 0, AV_OFF = 73728, ATT_BIAS_OFF = 147456;
static_assert(ATT_BIAS_OFF + 15 * 32 * 4 <= LDSCTL_OFF, "attention LDS map");
static_assert(DEPTH == 2, "the LN phases chain exactly two DeepNorm stages");
__device__ __forceinline__ int kswz(int key) { return ((key >> 1) & 1) | (((key >> 3) & 3) << 1); }
__device__ __forceinline__ int rstart(int r) { return min(max(r - 4, 0), 120); }
struct AttnPre { u32x4 kv[9], vv[9]; };
template <bool VPART>
__device__ __forceinline__ void attn_issue(const Frame& F, const AttnPtrs& P, int item, AttnPre& A) {
    const int bh = item >> 3, r0 = 16 * (item & 7);
    const bf16_t* g = (VPART ? P.VT : P.Kb) + (size_t)bh * T * 64 + F.tid * 8;
    const int lo = rstart(r0);
#pragma unroll
    for (int i = 0; i < 9; ++i) { const int kr = min(lo + i, T / 64 - 1); const u32x4 w = *(const u32x4*)(g + (size_t)kr * 4096); if (VPART) A.vv[i] = w; else A.kv[i] = w; }
}

constexpr int SG_LDP = 136;
constexpr int SG_W_OFF = 0, SG_VT_OFF = 34816, SG_GY_OFF = 69632, SG_RED_OFF = 104448, SG_STAT_OFF = SG_RED_OFF + 8192;
template <bool B> struct BoolTag { static constexpr bool value = B; };
__device__ __forceinline__ void sgu_phase(const Frame& F, int l, const float* sgu_g, const float* sgu_b, const float* b_sp, const bf16_t* WSB, const bf16_t* VGT, const bf16_t* GA, bf16_t* YC, const AttnPtrs& AP, AttnPre& A) {
    LAS bf16_t* wl = (LAS bf16_t*)(F.lds + SG_W_OFF);
    LAS bf16_t* vt = (LAS bf16_t*)(F.lds + SG_VT_OFF);
    LAS bf16_t* gy = (LAS bf16_t*)(F.lds + SG_GY_OFF);
    LAS float* red = (LAS float*)(F.lds + SG_RED_OFF);
    LAS float* stat = (LAS float*)(F.lds + SG_STAT_OFF);
    const int fr = F.lane & 15, fq = F.lane >> 4;
    const int chunk = F.tid & 15, rq = F.tid >> 4;
    const int hG = F.G / 2, hf = F.vcu / hG, vl = F.vcu % hG, nitems = NG * (T / 128);
    const int per = (nitems + hG - 1) / hG;
    const int s0 = vl * per, n_my = max(0, min(per, nitems - s0));
    u32x4 vw[4], gv[4];
    float gam[4], bet[4];
    LAS float* bl = stat + 256;
    { const int sc = min(s0, nitems - 1), g = sc / (T / 128), bn = hf * (T / 128) + sc % (T / 128);
#pragma unroll
      for (int j = 0; j < 4; ++j) { vw[j] = *(const u32x4*)(VGT + ((size_t)bn * DS + g * 128 + rq + 32 * j) * 128 + 8 * chunk); gv[j] = *(const u32x4*)(GA + ((size_t)bn * 128 + rq + 32 * j) * DS + g * 128 + 8 * chunk); } }
    auto load_group = [&](int g) __attribute__((always_inline)) {
            const bf16_t* Wg = WSB + ((size_t)l * NG + g) * 128 * 128;
            u32x4 wv[4];
#pragma unroll
            for (int j = 0; j < 4; ++j) wv[j] = *(const u32x4*)(Wg + (rq + 32 * j) * 128 + 8 * chunk);
#pragma unroll
            for (int j = 0; j < 4; ++j) { gam[j] = sgu_g[(size_t)l * DS + g * 128 + rq + 32 * j]; bet[j] = sgu_b[(size_t)l * DS + g * 128 + rq + 32 * j]; }
            if (F.tid < 128) bl[F.tid] = b_sp[((size_t)l * NG + g) * 128 + F.tid];
#pragma unroll
            for (int j = 0; j < 4; ++j) *(LAS u32x4*)(wl + (rq + 32 * j) * SG_LDP + 8 * chunk) = wv[j];
    };
    auto item_body = [&](int s, int g, auto last_tag) __attribute__((always_inline)) {
        const int bn = hf * (T / 128) + s % (T / 128);
        const size_t m0 = (size_t)bn * 128;
#pragma unroll
        for (int j = 0; j < 4; ++j) *(LAS u32x4*)(gy + (rq + 32 * j) * SG_LDP + 8 * chunk) = gv[j];
        float x[4][8], s1[8], s2[8];
#pragma unroll
        for (int j = 0; j < 4; ++j) { x[j][0] = bf_lo(vw[j].x); x[j][1] = bf_hi(vw[j].x); x[j][2] = bf_lo(vw[j].y); x[j][3] = bf_hi(vw[j].y); x[j][4] = bf_lo(vw[j].z); x[j][5] = bf_hi(vw[j].z); x[j][6] = bf_lo(vw[j].w); x[j][7] = bf_hi(vw[j].w); }
        if constexpr (decltype(last_tag)::value) attn_issue<false>(F, AP, F.vcu, A);
        else { const int sn = s + 1, gn = sn / (T / 128), bnn = hf * (T / 128) + sn % (T / 128);
#pragma unroll
          for (int j = 0; j < 4; ++j) { vw[j] = *(const u32x4*)(VGT + ((size_t)bnn * DS + gn * 128 + rq + 32 * j) * 128 + 8 * chunk); gv[j] = *(const u32x4*)(GA + ((size_t)bnn * 128 + rq + 32 * j) * DS + gn * 128 + 8 * chunk); } }
#pragma unroll
        for (int e = 0; e < 8; ++e) { s1[e] = (x[0][e] + x[1][e]) + (x[2][e] + x[3][e]); s2[e] = (x[0][e] * x[0][e] + x[1][e] * x[1][e]) + (x[2][e] * x[2][e] + x[3][e] * x[3][e]);
            s1[e] += __shfl_xor(s1[e], 16); s1[e] += __shfl_xor(s1[e], 32); s2[e] += __shfl_xor(s2[e], 16); s2[e] += __shfl_xor(s2[e], 32); }
        if (fq == 0) {
            *(LAS f32x4*)(red + (F.wave * 2 + 0) * 128 + 8 * chunk) = (f32x4){s1[0], s1[1], s1[2], s1[3]}; *(LAS f32x4*)(red + (F.wave * 2 + 0) * 128 + 8 * chunk + 4) = (f32x4){s1[4], s1[5], s1[6], s1[7]};
            *(LAS f32x4*)(red + (F.wave * 2 + 1) * 128 + 8 * chunk) = (f32x4){s2[0], s2[1], s2[2], s2[3]}; *(LAS f32x4*)(red + (F.wave * 2 + 1) * 128 + 8 * chunk + 4) = (f32x4){s2[4], s2[5], s2[6], s2[7]};
        }
        lds_sync();
        if (F.tid < 128) { float a1 = 0.f, a2 = 0.f;
#pragma unroll
            for (int w = 0; w < 8; ++w) { a1 += red[(w * 2 + 0) * 128 + F.tid]; a2 += red[(w * 2 + 1) * 128 + F.tid]; }
            const float mean = a1 * (1.f / 128.f); const float var = fmaxf(a2 * (1.f / 128.f) - mean * mean, 0.f);
            stat[2 * F.tid] = mean; stat[2 * F.tid + 1] = __builtin_amdgcn_rsqf(var + LN_EPS); }
        lds_sync();
        {
            float mu[8], rs[8];
#pragma unroll
            for (int e = 0; e < 8; e += 2) { const f32x4 st4 = *(const LAS f32x4*)(stat + 2 * (8 * chunk + e)); mu[e] = st4[0]; rs[e] = st4[1]; mu[e + 1] = st4[2]; rs[e + 1] = st4[3]; }
#pragma unroll
            for (int j = 0; j < 4; ++j) { u32x4 o;
                o.x = cvt_pk_bf16((x[j][0] - mu[0]) * rs[0] * gam[j] + bet[j], (x[j][1] - mu[1]) * rs[1] * gam[j] + bet[j]);
                o.y = cvt_pk_bf16((x[j][2] - mu[2]) * rs[2] * gam[j] + bet[j], (x[j][3] - mu[3]) * rs[3] * gam[j] + bet[j]);
                o.z = cvt_pk_bf16((x[j][4] - mu[4]) * rs[4] * gam[j] + bet[j], (x[j][5] - mu[5]) * rs[5] * gam[j] + bet[j]);
                o.w = cvt_pk_bf16((x[j][6] - mu[6]) * rs[6] * gam[j] + bet[j], (x[j][7] - mu[7]) * rs[7] * gam[j] + bet[j]);
                *(LAS u32x4*)(vt + (rq + 32 * j) * SG_LDP + 8 * chunk) = o; }
        }
        lds_sync();
        {
            bf16x8 af[4];
#pragma unroll
            for (int ks = 0; ks < 4; ++ks) af[ks] = *(const LAS bf16x8*)(vt + (16 * F.wave + fr) * SG_LDP + 32 * ks + 8 * fq);
#pragma unroll
            for (int nt = 0; nt < 8; ++nt) {
                f32x4 acc = {0.f, 0.f, 0.f, 0.f};
#pragma unroll
                for (int ks = 0; ks < 4; ++ks) { const bf16x8 bfrag = *(const LAS bf16x8*)(wl + (16 * nt + fr) * SG_LDP + 32 * ks + 8 * fq);
                    acc = __builtin_amdgcn_mfma_f32_16x16x32_bf16(af[ks], bfrag, acc, 0, 0, 0); }
                const int p = 16 * nt + fr;
                const float bs = bl[p];
                LAS u32x2* gp = (LAS u32x2*)(gy + p * SG_LDP + 16 * F.wave + 4 * fq);
                const u32x2 gaw = *gp;
                u32x2 o; o.x = cvt_pk_bf16(bf_lo(gaw.x) * (acc[0] + bs), bf_hi(gaw.x) * (acc[1] + bs)); o.y = cvt_pk_bf16(bf_lo(gaw.y) * (acc[2] + bs), bf_hi(gaw.y) * (acc[3] + bs));
                *gp = o;
            }
        }
        lds_sync();
#pragma unroll
        for (int j = 0; j < 4; ++j) { const int p = rq + 32 * j; *(u32x4*)(YC + (m0 + p) * D + g * 128 + 8 * chunk) = *(const LAS u32x4*)(gy + p * SG_LDP + 8 * chunk); }
    };
    int ii = 0, g_cur = -1;
    while (ii < n_my - 1) {
        const int g = (s0 + ii) / (T / 128);
        lds_sync();
        load_group(g); g_cur = g;
        for (bool first = true; ii < n_my - 1 && (s0 + ii) / (T / 128) == g; ++ii, first = false) { if (!first) lds_sync(); item_body(s0 + ii, g, BoolTag<false>{}); }
    }
    if (n_my > 0) { const int s = s0 + n_my - 1, g = s / (T / 128);
        lds_sync();
        if (g != g_cur) load_group(g);
        item_body(s, g, BoolTag<true>{}); }
    else attn_issue<false>(F, AP, F.vcu, A);
    __syncthreads();
}

__device__ __forceinline__ void attn_phase(const Frame& F, const AttnPtrs& P, int l, AttnPre& A) {
    const int kwr = (F.tid >> 3) * 128 + (((F.tid & 7) ^ kswz(F.tid >> 3)) << 4);
    const LAS float* rp = (const LAS float*)(F.lds + ATT_BIAS_OFF);
    for (int item = F.vcu; item < BATCH * NH * 8; item += F.G) {
        const int bh = item >> 3, r0 = 16 * (item & 7), b = bh >> 4, h = bh & 15;
        const size_t hb = (size_t)bh * T;
        attn_issue<true>(F, P, item, A);
        __syncthreads();
        { const int lo = rstart(r0), hi = rstart(r0 + 1) + 8;
#pragma unroll
            for (int i = 0; i < 9; ++i) if (lo + i < hi) { const int slot = (lo + i) % 9;
                *(LAS u32x4*)(F.lds + AK_OFF + slot * 8192 + kwr) = A.kv[i]; *(LAS u32x4*)(F.lds + AV_OFF + slot * 8192 + F.tid * 16) = A.vv[i]; } }
        int lane_ = F.lane; asm volatile("" : "+v"(lane_));
        const int fr = lane_ & 15, fq = lane_ >> 4, cb = F.wave & 3, rsel = F.wave >> 2;
        const int bs = min(max(16 * cb - 8, 0), 32);
        const int qcol = 16 * cb + fr;
        const int wst = min(max(qcol - 8, 0), 48);
        int ci[2][4];
#pragma unroll
        for (int X = 0; X < 2; ++X)
#pragma unroll
            for (int e = 0; e < 4; ++e) { const int kc = bs + 8 * fq + 4 * X + e; ci[X][e] = ((kc >= wst) && (kc < wst + 16)) ? min(max(kc - qcol + 15, 0), 30) : 31; }
        int koff[2][2];
#pragma unroll
        for (int X = 0; X < 2; ++X) { const int key = bs + 8 * (fr >> 2) + 4 * X + (fr & 3);
#pragma unroll
            for (int ks = 0; ks < 2; ++ks) koff[X][ks] = key * 128 + (((ks * 4 + fq) ^ kswz(key)) << 4); }
        const int voff = (((bs >> 3) + fq) * 64 + fr) * 16;
        const bf16_t* Kg = P.Kb + hb * 64 + F.tid * 8;
        const bf16_t* Vg = P.VT + hb * 64 + F.tid * 8;
        bf16_t* yb = P.YC + ((size_t)b * T + qcol) * D + DS + h * 64 + 4 * fq;
        for (int i = F.tid; i < 15 * 32; i += 512) ((LAS float*)(F.lds + ATT_BIAS_OFF))[i] = (i & 31) == 31 ? -1.0e30f : P.rpb[((size_t)l * NH + h) * 15 * 31 + (i >> 5) * 31 + (i & 31)] * 1.4426950408889634f;
        bf16x8 qf[2]; u32x2 zw[4];
        { const size_t tk = hb + (r0 + rsel) * 64 + qcol;
#pragma unroll
            for (int ks = 0; ks < 2; ++ks) qf[ks] = *(const bf16x8*)(P.Qb + tk * 64 + 32 * ks + 8 * fq);
#pragma unroll
            for (int d = 0; d < 4; ++d) zw[d] = *(const u32x2*)(P.ZB + tk * 64 + 16 * d + 4 * fq); }
        u32x2 yw[4];
        __syncthreads();
        for (int st = 0; st < 8; ++st) {
            const int ra = r0 + 2 * st, r = ra + rsel, rs = rstart(r);
            if (st > 0) {
#pragma unroll
                for (int d = 0; d < 4; ++d) *(u32x2*)(yb + (size_t)(r - 2) * 64 * D + 16 * d) = yw[d]; }
            const int nlo = rstart(ra + 1) + 8, nhi = (st < 7) ? rstart(ra + 3) + 7 : -1;
            const int kr0 = min(nlo, T / 64 - 1), kr1 = min(nlo + 1, T / 64 - 1);
            const u32x4 pk0 = *(const u32x4*)(Kg + (size_t)kr0 * 4096), pv0 = *(const u32x4*)(Vg + (size_t)kr0 * 4096);
            const u32x4 pk1 = *(const u32x4*)(Kg + (size_t)kr1 * 4096), pv1 = *(const u32x4*)(Vg + (size_t)kr1 * 4096);
            const size_t tkn = hb + min(r + 2, T / 64 - 1) * 64 + qcol;
            bf16x8 qn[2]; u32x2 zn[4];
#pragma unroll
            for (int ks = 0; ks < 2; ++ks) qn[ks] = *(const bf16x8*)(P.Qb + tkn * 64 + 32 * ks + 8 * fq);
#pragma unroll
            for (int d = 0; d < 4; ++d) zn[d] = *(const u32x2*)(P.ZB + tkn * 64 + 16 * d + 4 * fq);
            float s[8][2][4];
            float mx = -3.0e38f;
#pragma unroll
            for (int i = 0; i < 8; ++i) {
                const LAS float* rpi = rp + (rs + i - r + 7) * 32;
                const LAS unsigned char* kb = F.lds + AK_OFF + ((rs + i) % 9) * 8192;
#pragma unroll
                for (int X = 0; X < 2; ++X) {
                    f32x4 c = {rpi[ci[X][0]], rpi[ci[X][1]], rpi[ci[X][2]], rpi[ci[X][3]]};
#pragma unroll
                    for (int ks = 0; ks < 2; ++ks) c = __builtin_amdgcn_mfma_f32_16x16x32_bf16(*(const LAS bf16x8*)(kb + koff[X][ks]), qf[ks], c, 0, 0, 0);
                    s[i][X][0] = c[0]; s[i][X][1] = c[1]; s[i][X][2] = c[2]; s[i][X][3] = c[3];
                    mx = fmaxf(fmaxf(mx, c[0]), c[1]); mx = fmaxf(fmaxf(mx, c[2]), c[3]);
                }
            }
            mx = fmaxf(mx, __shfl_xor(mx, 16)); mx = fmaxf(mx, __shfl_xor(mx, 32));
#pragma unroll
            for (int i = 0; i < 8; ++i)
#pragma unroll
                for (int X = 0; X < 2; ++X)
#pragma unroll
                    for (int e = 0; e < 4; ++e) s[i][X][e] = __builtin_amdgcn_exp2f(s[i][X][e] - mx);
            f32x4 o[4], osum = {0.f, 0.f, 0.f, 0.f};
#pragma unroll
            for (int d = 0; d < 4; ++d) o[d] = (f32x4){0.f, 0.f, 0.f, 0.f};
            const bf16x8 ones = {0x3F80, 0x3F80, 0x3F80, 0x3F80, 0x3F80, 0x3F80, 0x3F80, 0x3F80};
#pragma unroll
            for (int i = 0; i < 8; ++i) {
                union { u32x4 u; bf16x8 v; } pb;
                pb.u.x = cvt_pk_bf16(s[i][0][0], s[i][0][1]); pb.u.y = cvt_pk_bf16(s[i][0][2], s[i][0][3]); pb.u.z = cvt_pk_bf16(s[i][1][0], s[i][1][1]); pb.u.w = cvt_pk_bf16(s[i][1][2], s[i][1][3]);
                const LAS unsigned char* vb = F.lds + AV_OFF + ((rs + i) % 9) * 8192 + voff;
#pragma unroll
                for (int d = 0; d < 4; ++d) o[d] = __builtin_amdgcn_mfma_f32_16x16x32_bf16(*(const LAS bf16x8*)(vb + d * 256), pb.v, o[d], 0, 0, 0);
                osum = __builtin_amdgcn_mfma_f32_16x16x32_bf16(ones, pb.v, osum, 0, 0, 0);
            }
            const float sum = osum[0];
            const float inv = 1.0f / sum;
#pragma unroll
            for (int d = 0; d < 4; ++d) {
                yw[d].x = cvt_pk_bf16(o[d][0] * inv * bf_lo(zw[d].x), o[d][1] * inv * bf_hi(zw[d].x)); yw[d].y = cvt_pk_bf16(o[d][2] * inv * bf_lo(zw[d].y), o[d][3] * inv * bf_hi(zw[d].y)); }
            __syncthreads();
            if (nlo <= nhi) { const int slot = nlo % 9; *(LAS u32x4*)(F.lds + AK_OFF + slot * 8192 + kwr) = pk0; *(LAS u32x4*)(F.lds + AV_OFF + slot * 8192 + F.tid * 16) = pv0; }
            if (nlo + 1 <= nhi) { const int slot = (nlo + 1) % 9; *(LAS u32x4*)(F.lds + AK_OFF + slot * 8192 + kwr) = pk1; *(LAS u32x4*)(F.lds + AV_OFF + slot * 8192 + F.tid * 16) = pv1; }
            __syncthreads();
            qf[0] = qn[0]; qf[1] = qn[1];
#pragma unroll
            for (int d = 0; d < 4; ++d) zw[d] = zn[d];
        }
#pragma unroll
        for (int d = 0; d < 4; ++d) *(u32x2*)(yb + (size_t)(r0 + 14 + rsel) * 64 * D + 16 * d) = yw[d];
        if (item + F.G < BATCH * NH * 8) attn_issue<false>(F, P, item + F.G, A);
    }
    __syncthreads();
}

struct Args { const float* in[13]; float* out; unsigned char* ws; int ph_lo, ph_hi; };
constexpr int N_PHASES = 2 + 4 * DEPTH;

typedef const __attribute__((address_space(4))) Args* ArgsP;
__device__ __forceinline__ ArgsP fresh_args() { ArgsP p = (ArgsP)__builtin_amdgcn_kernarg_segment_ptr(); asm volatile("" : "+s"(p)); return p; }
#ifndef MK_MASK
#define MK_MASK 63
#endif
#ifndef MK_REP
#define MK_REP 0
#endif
__global__ void __launch_bounds__(512, 2) mk_fwd(Args args) {
    extern __shared__ __attribute__((aligned(16))) unsigned char lds[];
    { LAS unsigned* z = (LAS unsigned*)((LAS unsigned char*)lds + LDSCTL_OFF); for (int u = threadIdx.x; u < (LDS_BYTES - LDSCTL_OFF) / 4; u += 512) z[u] = 0u; }
    __syncthreads();
    const int lo = args.ph_lo, hi = args.ph_hi;
    const unsigned half_ = ((blockIdx.x & 7u) >> 2) & 1u;
    XcdBarrier bar, barh; bar.bar = (unsigned*)(args.ws + WS_CTL) + CW_BAR; bar.x = 0; bar.st = nullptr; bar.expect = gridDim.x; barh = bar;
    if (hi - lo > 1) {
        bar = xcd_barrier_post((unsigned*)(args.ws + WS_CTL) + CW_BAR, (volatile LAS unsigned*)((LAS unsigned char*)lds + MISC_OFF) + 8, gridDim.x);
        barh = xcd_barrier_post((unsigned*)(args.ws + WS_CTL) + CW_BAR + (1 + half_) * XCD_BAR_WORDS, (volatile LAS unsigned*)((LAS unsigned char*)lds + MISC_OFF) + 10, gridDim.x / 2);
    }
    const bool split_ok = (gridDim.x % 16) == 0;

    for (int ph = lo; ph < hi; ++ph) {
      const int kind_ = ph == 0 ? 1 : (ph == 1 ? 2 : (((ph - 2) & 3) == 0 ? 4 : (((ph - 2) & 3) == 1 ? 64 : (((ph - 2) & 3) == 2 ? 32 : 2))));
      const int nrep_ = (MK_REP & kind_) ? 2 : 1;
      for (int rep_ = 0; rep_ < nrep_; ++rep_) {
        ArgsP ap = fresh_args();
        unsigned char* ws = ap->ws;
        int tid_ = threadIdx.x, bx = blockIdx.x, G_ = gridDim.x;
        asm volatile("" : "+v"(tid_)); asm volatile("" : "+s"(bx), "+s"(G_));
        Frame F; F.lds = (LAS unsigned char*)lds; F.tid = tid_; F.lane = tid_ & 63; F.wave = __builtin_amdgcn_readfirstlane(tid_ >> 6);
        F.G = G_; F.vcu = (G_ % 8 == 0) ? (bx % 8) * (G_ / 8) + bx / 8 : bx;
        if (ph == 0) {
            if (MK_MASK & 1) p0_prologue(F, ap->in[1], ap->in[2], ap->in[3], ap->in[4], ap->in[10], ap->in[7], (float*)(ws + WS_MOD), (bf16_t*)(ws + WS_WIN), (bf16_t*)(ws + WS_WOUT), (bf16_t*)(ws + WS_WSB));
        } else if (ph == 1) {
            if (split_ok && half_ == 1u) {
                __syncthreads();
                p0_weights(F, ap->in[4], ap->in[10], (bf16_t*)(ws + WS_WIN), (bf16_t*)(ws + WS_WOUT), 1, (F.vcu - F.G / 2) * 8 + F.wave, (F.G / 2) * 8);
                __syncthreads();
            } else if (!split_ok) { __syncthreads(); p0_weights(F, ap->in[4], ap->in[10], (bf16_t*)(ws + WS_WIN), (bf16_t*)(ws + WS_WOUT), 1, F.vcu * 8 + F.wave, F.G * 8); __syncthreads(); }
            if (MK_MASK & 2) ln_phase(F, ap->in[0], LnStage{nullptr, nullptr, nullptr}, LnStage{nullptr, nullptr, nullptr}, nullptr, true, (const float*)(ws + WS_MOD), (bf16_t*)(ws + WS_H));
        } else {
            const int l = (ph - 2) >> 2, k = (ph - 2) & 3;
            if (k == 0) { if (MK_MASK & 4) {
                const bf16_t* H = (const bf16_t*)(ws + WS_H); const bf16_t* W = (const bf16_t*)(ws + WS_WIN) + (size_t)l * DIN * D;
                pg8::Gemm g{H, W, W + (size_t)5120 * D, H, D};
                pg8::ProjOrder S; S.init(F.G, bx);
                pg8::EpiProj E{(bf16_t*)(ws + WS_GA), (bf16_t*)(ws + WS_VG), (bf16_t*)(ws + WS_Q), (bf16_t*)(ws + WS_VT)};
                pg8::gemm_phase<pg8::EpiProj, pg8::ProjOrder>(F.lds, F.tid, g, S, E); }
            } else if (k == 1) {
                const AttnPtrs P{ap->in[9], (const bf16_t*)(ws + WS_Q), (const bf16_t*)(ws + WS_K), (const bf16_t*)(ws + WS_VT), (const bf16_t*)(ws + WS_ZB), (bf16_t*)(ws + WS_H)};
                AttnPre pre;
                sgu_phase(F, l, ap->in[5], ap->in[6], ap->in[8], (const bf16_t*)(ws + WS_WSB), (const bf16_t*)(ws + WS_VG), (const bf16_t*)(ws + WS_GA), (bf16_t*)(ws + WS_H), P, pre);
                attn_phase(F, P, l, pre);
            } else if (k == 2) { if (MK_MASK & 32) {
                pg8::Gemm g{(const bf16_t*)(ws + WS_H), (const bf16_t*)(ws + WS_WOUT) + (size_t)l * D * D, nullptr, nullptr, D};
                pg8::StaticOrder S; S.init(M, D, F.G, bx);
                LAS float* g1 = (LAS float*)(F.lds + pg8::STAGE_BYTES);
                const float* gsrc = (const float*)(ws + WS_MOD) + (size_t)l * BATCH * NMOD + 2 * D;
                const int gi0 = F.tid, gi1 = 512 + F.tid;
                pg8::EpiOut E{g1, (bf16_t*)(ws + (l == 0 ? WS_Y0 : WS_Y)), *(const f32x4*)(gsrc + (size_t)(gi0 / (D / 4)) * NMOD + (gi0 % (D / 4)) * 4), *(const f32x4*)(gsrc + (size_t)(gi1 / (D / 4)) * NMOD + (gi1 % (D / 4)) * 4)};
                pg8::gemm_phase<pg8::EpiOut, pg8::StaticOrder>(F.lds, F.tid, g, S, E); }
            } else {
                const LnStage s0{(const bf16_t*)(ws + WS_Y0), ap->in[11], ap->in[12]};
                if (l == 0) { if (MK_MASK & 2) ln_phase(F, ap->in[0], s0, LnStage{nullptr, nullptr, nullptr}, nullptr, true, (const float*)(ws + WS_MOD) + (size_t)BATCH * NMOD, (bf16_t*)(ws + WS_H)); }
                else { const LnStage s1{(const bf16_t*)(ws + WS_Y), ap->in[11] + D, ap->in[12] + D};
                    if (MK_MASK & 2) ln_phase(F, ap->in[0], s0, s1, ap->out, false, nullptr, nullptr); }
            }
        }
        if (ph + 1 < hi || rep_ + 1 < nrep_) {
            if (ph == 0 || !split_ok) xcd_barrier(bar);
            else {
                if (ph == 5 && half_ == 0u && threadIdx.x == 0) {
                    unsigned* hc = (unsigned*)(ws + WS_CTL) + CW_HANDOFF; unsigned sp = 0;
                    while (xb_ld(hc) < gridDim.x / 2) { __builtin_amdgcn_s_sleep(2); if (++sp > (1u << 22)) break; }
                }
                xcd_barrier(barh);
                if (ph == 1 && half_ == 1u && threadIdx.x == 0 && rep_ == 0) xb_add((unsigned*)(ws + WS_CTL) + CW_HANDOFF, 1u);
            }
        }
      }
    }
}

extern "C" void kernel_launch(void* const* d_in, const int* in_sizes, int n_in, void* d_out, int out_size, void* d_ws, size_t ws_size, hipStream_t stream) {
    static int grid = 0;
    if (grid == 0) {
        if (n_in != 13 || out_size != M * D || ws_size < WS_END) { fprintf(stderr, "kernel_launch: unexpected shapes (n_in %d, out %d, ws %zu)\n", n_in, out_size, ws_size); grid = -1; return; }
        int dev = 0, cus = 0, per_cu = 0;
        if (hipGetDevice(&dev) != hipSuccess || hipDeviceGetAttribute(&cus, hipDeviceAttributeMultiprocessorCount, dev) != hipSuccess) { grid = -1; return; }
        if (hipFuncSetAttribute((const void*)mk_fwd, hipFuncAttributeMaxDynamicSharedMemorySize, LDS_BYTES) != hipSuccess) { fprintf(stderr, "kernel_launch: hipFuncSetAttribute failed\n"); grid = -1; return; }
        if (hipOccupancyMaxActiveBlocksPerMultiprocessor(&per_cu, (const void*)mk_fwd, 512, LDS_BYTES) != hipSuccess || per_cu < 1) { fprintf(stderr, "kernel_launch: occupancy query reports %d blocks per CU\n", per_cu); per_cu = 1; }
        (void)hipGetLastError();
        grid = cus;
    }
    if (grid < 0) return;
    (void)hipMemsetAsync((char*)d_ws + WS_CTL, 0, CTL_ZERO_BYTES, stream);
    Args a{};
    for (int i = 0; i < 13; ++i) a.in[i] = (const float*)d_in[i];
    a.out = (float*)d_out; a.ws = (unsigned char*)d_ws;
    if (MK_N_LAUNCHES == 1) { a.ph_lo = 0; a.ph_hi = N_PHASES; hipLaunchKernelGGL(mk_fwd, dim3(grid), dim3(512), LDS_BYTES, stream, a); }
    else { for (int p = 0; p < N_PHASES; ++p) { a.ph_lo = p; a.ph_hi = p + 1; hipLaunchKernelGGL(mk_fwd, dim3(grid), dim3(512), LDS_BYTES, stream, a); } }
}
```

```cpp
#include <hip/hip_runtime.h>
#include <cstdio>
#include <cstdint>

#ifndef MK_N_LAUNCHES
#define MK_N_LAUNCHES 1
#endif

#define LAS __attribute__((address_space(3)))
#define GAS __attribute__((address_space(1)))
typedef unsigned short bf16_t;
typedef short bf16x8 __attribute__((ext_vector_type(8)));
typedef float f32x4 __attribute__((ext_vector_type(4)));
typedef float f32x2 __attribute__((ext_vector_type(2)));
typedef unsigned u32x4 __attribute__((ext_vector_type(4)));
typedef unsigned u32x2 __attribute__((ext_vector_type(2)));

constexpr int BATCH = 2, T = 8192, D = 2048, M = BATCH * T, DIN = 7168, DS = 1024, NG = 8, NH = 16, DEPTH = 2;
constexpr int NMOD = 3 * D;
constexpr float LN_EPS = 1e-5f;
constexpr float DN_ALPHA = 1.4142135623730951f;

typedef __bf16 bf16v2 __attribute__((ext_vector_type(2)));
__device__ __forceinline__ unsigned cvt_pk_bf16(float lo, float hi) { const f32x2 v = {lo, hi}; const bf16v2 r = __builtin_convertvector(v, bf16v2); return __builtin_bit_cast(unsigned, r); }
__device__ __forceinline__ float bf_lo(unsigned w) { return __builtin_bit_cast(float, w << 16); }
__device__ __forceinline__ float bf_hi(unsigned w) { return __builtin_bit_cast(float, w & 0xffff0000u); }
__device__ __forceinline__ float silu_f(float x) { return x * __builtin_amdgcn_rcpf(1.0f + __builtin_amdgcn_exp2f(-1.4426950408889634f * x)); }
__device__ __forceinline__ f32x2 gelu_pk(f32x2 v) {
    f32x2 c; c.x = __builtin_amdgcn_fmed3f(v.x, -4.0f, 4.0f); c.y = __builtin_amdgcn_fmed3f(v.y, -4.0f, 4.0f);
    const f32x2 s = c * c;
    f32x2 r = s * 7.0374646370e-11f + (-6.2872893160e-09f);
    r = r * s + 2.5093203053e-07f; r = r * s + (-5.9760889818e-06f); r = r * s + 9.6085055597e-05f; r = r * s + (-1.1195942566e-03f);
    r = r * s + 9.8383713455e-03f; r = r * s + (-6.6361911043e-02f); r = r * s + 3.9890514886e-01f;
    return v * (c * r + 0.5f);
}
__device__ __forceinline__ f32x4 gelu4(f32x4 v) { f32x2 a = gelu_pk((f32x2){v[0], v[1]}), b = gelu_pk((f32x2){v[2], v[3]}); return (f32x4){a.x, a.y, b.x, b.y}; }
__device__ __forceinline__ f32x2 silu_pk(f32x2 v) { const f32x2 a = v * (-1.4426950408889634f); f32x2 e; e.x = __builtin_amdgcn_exp2f(a.x); e.y = __builtin_amdgcn_exp2f(a.y);
    const f32x2 d = e + 1.0f; f32x2 r; r.x = __builtin_amdgcn_rcpf(d.x); r.y = __builtin_amdgcn_rcpf(d.y); return v * r; }
__device__ __forceinline__ f32x4 silu4(f32x4 v) { const f32x2 a = silu_pk((f32x2){v[0], v[1]}), b = silu_pk((f32x2){v[2], v[3]}); return (f32x4){a.x, a.y, b.x, b.y}; }
#ifndef MK_REP
#define MK_REP 0
#endif
__device__ __forceinline__ void store8(bf16_t* p, f32x4 a, f32x4 b) { u32x4 w; w.x = cvt_pk_bf16(a[0], a[1]); w.y = cvt_pk_bf16(a[2], a[3]); w.z = cvt_pk_bf16(b[0], b[1]); w.w = cvt_pk_bf16(b[2], b[3]); *(u32x4*)p = w;
    if (MK_REP & 128) { asm volatile("" ::: "memory"); *(u32x4*)p = w; asm volatile("" ::: "memory"); } }

namespace pg8 {
constexpr int BM = 256, BK = 64, HALF = 128, HTB = HALF * BK * 2, STAGE_BYTES = 8 * HTB, NXCD = 8, WGM = 2;
__host__ __device__ __forceinline__ int lds_byte(int r, int c) { const int st = (r >> 4) * 2 + (c >> 5), rr = r & 15, cc = c & 31, ob = rr * 64 + cc * 2; return st * 1024 + (ob ^ (((ob >> 9) & 1) << 5)); }
__host__ __device__ __forceinline__ void stage_rc(int b, int& R, int& C) { const int st = b / 1024, sb = b % 1024, swz = sb ^ (((sb >> 9) & 1) << 5); R = (st >> 1) * 16 + swz / 64; C = (st & 1) * 32 + (swz % 64) / 2; }
__host__ __device__ __forceinline__ int perm32(int rho) { const int n = rho >> 4, i = rho & 15; return 8 * (i >> 2) + 4 * n + (i & 3); }

struct Unit { int pm, pn, kind; };
struct Gemm { const bf16_t* A0; const bf16_t* B0; const bf16_t* A1; const bf16_t* B1; int K; };

struct StaticOrder {
    int nM, nN, nwg, G, c;
    __device__ void init(int M_, int N_, int G_, int c_) { nM = M_ / BM; nN = N_ / BM; nwg = nM * nN; G = G_; c = c_; }
    __device__ __forceinline__ void map(int wgid, Unit& u) const {
        { const int q = nwg / NXCD, r = nwg % NXCD, xcd = wgid % NXCD, off = wgid / NXCD; wgid = (xcd < r ? xcd * (q + 1) : r * (q + 1) + (xcd - r) * q) + off; }
        const int nig = WGM * nN, gid = wgid / nig, fm = gid * WGM, gsz = (nM - fm) < WGM ? (nM - fm) : WGM;
        u.pm = fm + ((wgid % nig) % gsz); u.pn = (wgid % nig) / gsz; u.kind = 0;
    }
    __device__ __forceinline__ bool next(int i, Unit& u) const { const long L = (long)i * G + c; if (L >= nwg) return false; map((int)L, u); return true; }
};
struct ProjOrder {
    StaticOrder S; int nswap;
    __device__ void init(int G_, int c_) { S.init(M, 5120, G_, c_); nswap = 512; }
    __device__ __forceinline__ bool next(int i, Unit& u) const {
        const long L = (long)i * S.G + S.c;
        if (L < S.nwg) { S.map((int)L, u); return true; }
        const int idx = (int)(L - S.nwg); if (idx >= nswap) return false;
        const int x = idx % 8, t = idx / 8, rnd = t >> 5, j = t & 31;
        u.pm = (j + 4 * rnd) & 7; u.pn = 8 * x + 4 * rnd + (j >> 3); u.kind = 1; return true;
    }
};

struct EpiProj {
    static constexpr bool PERM = true;
    __device__ __forceinline__ void stage(int) const {}
    bf16_t *GA, *VGT, *Qb, *VT;
    __device__ __forceinline__ void operator()(const f32x4 (&acc)[2][2][4][2], const Unit& u, int wr, int wc, int fr, int fq) const {
        const int rl = wr * 64 + fr, cl = wc * 32 + 8 * fq;
        if (u.kind == 1) {
            const int tok0 = u.pn * 256 + cl;
            if (u.pm < 4) {
#pragma unroll
                for (int ai = 0; ai < 2; ++ai)
#pragma unroll
                    for (int m = 0; m < 4; ++m) { const int ch = u.pm * 256 + rl + ai * HALF + m * 16;
#pragma unroll
                        for (int bj = 0; bj < 2; ++bj) { const int tk = tok0 + bj * HALF;
                            store8(VGT + ((size_t)(tk >> 7) * DS + ch) * 128 + (tk & 127), gelu4(acc[ai][bj][m][0]), gelu4(acc[ai][bj][m][1])); } }
            } else {
                const int bb = tok0 >> 13;
#pragma unroll
                for (int ai = 0; ai < 2; ++ai)
#pragma unroll
                    for (int m = 0; m < 4; ++m) { const int ch = (u.pm - 4) * 256 + rl + ai * HALF + m * 16;
                        bf16_t* rowp = VT + ((size_t)(bb * NH + (ch >> 6)) * (T / 8) * 64 + (ch & 63)) * 8;
#pragma unroll
                        for (int bj = 0; bj < 2; ++bj) store8(rowp + (size_t)(((tok0 + bj * HALF) & (T - 1)) >> 3) * 512, acc[ai][bj][m][0], acc[ai][bj][m][1]); }
            }
        } else if (u.pn < 8) {
            bf16_t* base = GA + (size_t)(u.pm * 256 + rl) * DS + u.pn * 128 + cl;
#pragma unroll
            for (int ai = 0; ai < 2; ++ai)
#pragma unroll
                for (int m = 0; m < 4; ++m) {
                    const f32x4 r0 = gelu4(acc[ai][0][m][0]) * silu4(acc[ai][1][m][0]), r1 = gelu4(acc[ai][0][m][1]) * silu4(acc[ai][1][m][1]);
                    store8(base + (size_t)(ai * HALF + m * 16) * DS, r0, r1); }
        } else {
            const int t = (u.pn - 8) >> 2, colt = ((u.pn - 8) & 3) * 256;
            bf16_t* out = Qb + (size_t)t * ((size_t)M * DS);
            const int row0 = u.pm * 256 + rl;
            const int bb = row0 >> 13, t0 = row0 & (T - 1);
#define EPI_QKZ(XFORM) _Pragma("unroll") for (int bj = 0; bj < 2; ++bj) { const int col = colt + bj * HALF + cl; \
                bf16_t* base = out + ((size_t)(bb * NH + (col >> 6)) * T + t0) * 64 + (col & 63); \
                _Pragma("unroll") for (int ai = 0; ai < 2; ++ai) _Pragma("unroll") for (int m = 0; m < 4; ++m) { f32x4 v0 = acc[ai][bj][m][0], v1 = acc[ai][bj][m][1]; XFORM; \
                        store8(base + (size_t)(ai * HALF + m * 16) * 64, v0, v1); } }
            if (t == 0) { EPI_QKZ(v0 = v0 * 0.18033688011112042f; v1 = v1 * 0.18033688011112042f) }
            else if (t == 2) { EPI_QKZ(v0 = silu4(v0); v1 = silu4(v1)) }
            else { EPI_QKZ((void)0) }
#undef EPI_QKZ
        }
    }
};
struct EpiOut {
    static constexpr bool PERM = true;
    LAS float* gate1; bf16_t* Y;
    f32x4 gr0, gr1;
    __device__ __forceinline__ void stage(int tid) const { *(LAS f32x4*)(gate1 + tid * 4) = gr0 + 1.0f; *(LAS f32x4*)(gate1 + (512 + tid) * 4) = gr1 + 1.0f; }
    __device__ __forceinline__ void operator()(const f32x4 (&acc)[2][2][4][2], const Unit& u, int wr, int wc, int fr, int fq) const {
        const int row0 = u.pm * BM + wr * 64 + fr, col0 = u.pn * BM + wc * 32 + 8 * fq;
        const LAS float* gp = gate1 + (u.pm >= (T / BM) ? D : 0) + col0;
        f32x4 g4[2][2];
#pragma unroll
        for (int bj = 0; bj < 2; ++bj)
#pragma unroll
            for (int n = 0; n < 2; ++n) g4[bj][n] = *(const LAS f32x4*)(gp + bj * HALF + n * 4);
#pragma unroll
        for (int ai = 0; ai < 2; ++ai)
#pragma unroll
            for (int m = 0; m < 4; ++m) { bf16_t* rowp = Y + (size_t)(row0 + ai * HALF + m * 16) * D + col0;
#pragma unroll
                for (int bj = 0; bj < 2; ++bj) store8(rowp + bj * HALF, g4[bj][0] * acc[ai][bj][m][0], g4[bj][1] * acc[ai][bj][m][1]); }
    }
};

template <class Epi, class Sched>
__device__ __forceinline__ void gemm_phase(LAS unsigned char* lds, const int tid, const Gemm g, const Sched& S, const Epi& E) {
    const int wid = __builtin_amdgcn_readfirstlane(tid >> 6), lane = tid & 63, wr = wid >> 2, wc = wid & 3, fr = lane & 15, fq = lane >> 4;
    const int K = g.K, nt = K / BK;
    unsigned voffA[2], voffB[2];
#pragma unroll
    for (int i = 0; i < 2; ++i) { int R, C; stage_rc(tid * 16 + i * 8192, R, C); const int Rb = Epi::PERM ? ((R & ~31) + perm32(R & 31)) : R;
        voffA[i] = (unsigned)(R * K + C) * 2u; voffB[i] = (unsigned)(Rb * K + C) * 2u; }
    const size_t kstep = (size_t)(BK * 2);
    const size_t hstep = (size_t)HALF * K * 2;
    const size_t tstep = 2 * hstep;
    const unsigned ldsw = (unsigned)wid * 1024u;
    const int aoff = lds_byte(wr * 64 + fr, fq * 8), boff = lds_byte(wc * 32 + fr, fq * 8);
#define PG8_SA(b, h) (((b) * 2 + (h)) * HTB)
#define PG8_SB(b, h) ((4 + (b) * 2 + (h)) * HTB)
#define PG8_STAGE(bufoff, gbase, voff) do { _Pragma("unroll") for (int _i = 0; _i < 2; ++_i) \
        __builtin_amdgcn_global_load_lds((const unsigned*)((const char*)(gbase) + (voff)[_i]), (LAS unsigned*)(lds + (bufoff) + ldsw + _i * 8192), 16, 0, 0); } while (0)
#define PG8_LDA(dst, b, h) do { _Pragma("unroll") for (int m = 0; m < 4; ++m) _Pragma("unroll") for (int k = 0; k < 2; ++k) dst[m][k] = *(const LAS bf16x8*)(lds + PG8_SA(b, h) + aoff + m * 2048 + k * 1024); } while (0)
#define PG8_LDB(dst, b, h) do { _Pragma("unroll") for (int n = 0; n < 2; ++n) _Pragma("unroll") for (int k = 0; k < 2; ++k) dst[n][k] = *(const LAS bf16x8*)(lds + PG8_SB(b, h) + boff + n * 2048 + k * 1024); } while (0)
#define PG8_MMA(ai, bj, At, Bt) do { __builtin_amdgcn_sched_barrier(0); _Pragma("unroll") for (int m = 0; m < 4; ++m) _Pragma("unroll") for (int n = 0; n < 2; ++n) _Pragma("unroll") for (int k = 0; k < 2; ++k) \
        acc[ai][bj][m][n] = __builtin_amdgcn_mfma_f32_16x16x32_bf16(Bt[n][k], At[m][k], acc[ai][bj][m][n], 0, 0, 0); __builtin_amdgcn_sched_barrier(0); } while (0)
#define PG8_WAIT_V(n) asm volatile("s_waitcnt vmcnt(" #n ")" ::: "memory")
#define PG8_WAIT_L(n) asm volatile("s_waitcnt lgkmcnt(" #n ")" ::: "memory")
#define PG8_BAR __builtin_amdgcn_s_barrier()
#define PG8_SCHED __builtin_amdgcn_sched_barrier(0)
#define PG8_UA(u) ((const char*)((u).kind ? g.A1 : g.A0) + (size_t)(u).pm * tstep)
#define PG8_UB(u) ((const char*)((u).kind ? g.B1 : g.B0) + (size_t)(u).pn * tstep)
    Unit cur, nxt; int ui = 0;
    if (!S.next(0, cur)) return;
    f32x4 acc[2][2][4][2];
#pragma unroll
    for (int a = 0; a < 2; ++a)
#pragma unroll
        for (int b = 0; b < 2; ++b)
#pragma unroll
            for (int m = 0; m < 4; ++m)
#pragma unroll
                for (int n = 0; n < 2; ++n) acc[a][b][m][n] = (f32x4){0.f, 0.f, 0.f, 0.f};
    bf16x8 At[4][2], B0[2][2], B1[2][2];
    const char* cA = PG8_UA(cur); const char* cB = PG8_UB(cur);
    PG8_STAGE(PG8_SB(0, 0), cB, voffB); PG8_STAGE(PG8_SB(0, 1), cB + hstep, voffB); PG8_STAGE(PG8_SA(0, 0), cA, voffA); PG8_STAGE(PG8_SA(0, 1), cA + hstep, voffA);
    E.stage(tid);
    if (wr == 1) PG8_BAR;
    PG8_WAIT_V(2); PG8_BAR;
    PG8_STAGE(PG8_SB(1, 0), cB + kstep, voffB); PG8_STAGE(PG8_SA(1, 0), cA + kstep, voffA); PG8_STAGE(PG8_SB(1, 1), cB + hstep + kstep, voffB);
    PG8_WAIT_V(6); PG8_BAR;
    for (;;) {
        const bool has_next = S.next(ui + 1, nxt);
        const char* nA = has_next ? PG8_UA(nxt) : cA; const char* nB = has_next ? PG8_UB(nxt) : cB;
        for (int t = 0; t < nt; t += 2) {
            const bool last = (t == nt - 2);
            const char* a1 = cA + (size_t)(t + 1) * kstep;
            const char* a2 = last ? nA : cA + (size_t)(t + 2) * kstep; const char* b2 = last ? nB : cB + (size_t)(t + 2) * kstep;
            const char* a3 = a2 + kstep; const char* b3 = b2 + kstep;
            PG8_LDB(B0, 0, 0); PG8_LDB(B1, 0, 1); PG8_SCHED; PG8_LDA(At, 0, 0); PG8_STAGE(PG8_SA(1, 1), a1 + hstep, voffA);
            PG8_WAIT_V(8); PG8_WAIT_L(0); PG8_BAR; PG8_MMA(0, 0, At, B0); PG8_MMA(0, 1, At, B1); PG8_BAR; PG8_SCHED;
            PG8_LDA(At, 0, 1); PG8_STAGE(PG8_SB(0, 0), b2, voffB); PG8_STAGE(PG8_SB(0, 1), b2 + hstep, voffB); PG8_STAGE(PG8_SA(0, 0), a2, voffA);
            PG8_WAIT_V(8); PG8_WAIT_L(0); PG8_BAR; PG8_MMA(1, 0, At, B0); PG8_MMA(1, 1, At, B1); PG8_BAR; PG8_SCHED;
            PG8_LDB(B0, 1, 0); PG8_LDB(B1, 1, 1); PG8_SCHED; PG8_LDA(At, 1, 0); PG8_STAGE(PG8_SA(0, 1), a2 + hstep, voffA);
            PG8_WAIT_V(8); PG8_WAIT_L(0); PG8_BAR; PG8_MMA(0, 0, At, B0); PG8_MMA(0, 1, At, B1); PG8_BAR; PG8_SCHED;
            PG8_LDA(At, 1, 1); PG8_STAGE(PG8_SB(1, 0), b3, voffB); PG8_STAGE(PG8_SB(1, 1), b3 + hstep, voffB); PG8_STAGE(PG8_SA(1, 0), a3, voffA);
            PG8_WAIT_V(8); PG8_WAIT_L(0); PG8_BAR; PG8_MMA(1, 0, At, B0); PG8_MMA(1, 1, At, B1); PG8_BAR; PG8_SCHED;
        }
        if (wr == 0) PG8_BAR;
        E(acc, cur, wr, wc, fr, fq);
        if (!has_next) break;
#pragma unroll
        for (int a = 0; a < 2; ++a)
#pragma unroll
            for (int b = 0; b < 2; ++b)
#pragma unroll
                for (int m = 0; m < 4; ++m)
#pragma unroll
                    for (int n = 0; n < 2; ++n) acc[a][b][m][n] = (f32x4){0.f, 0.f, 0.f, 0.f};
        cur = nxt; cA = nA; cB = nB; ++ui;
        if (wr == 1) PG8_BAR;
    }
    PG8_WAIT_V(0);
    PG8_BAR;
#undef PG8_SA
#undef PG8_SB
#undef PG8_STAGE
#undef PG8_LDA
#undef PG8_LDB
#undef PG8_MMA
#undef PG8_WAIT_V
#undef PG8_WAIT_L
#undef PG8_BAR
#undef PG8_SCHED
#undef PG8_UA
#undef PG8_UB
}
}

constexpr size_t MiB = 1u << 20;
constexpr size_t WS_CTL = 0, CTL_ZERO_BYTES = 64 * 1024;
constexpr size_t WS_MOD = 1 * MiB;
constexpr size_t WS_WSB = 1 * MiB + 512 * 1024;
constexpr size_t WS_WIN = 2 * MiB;
constexpr size_t WS_WOUT = 58 * MiB;
constexpr size_t WS_H = 80 * MiB;
constexpr size_t WS_GA = 144 * MiB, WS_VG = 176 * MiB, WS_Q = 208 * MiB, WS_K = 240 * MiB, WS_ZB = 272 * MiB, WS_VT = 304 * MiB;
constexpr size_t WS_Y = 144 * MiB;
constexpr size_t WS_Y0 = 336 * MiB;
constexpr size_t WS_END = 400 * MiB;
static_assert(WS_K - WS_Q == (size_t)M * DS * 2 && WS_ZB - WS_K == (size_t)M * DS * 2, "EpiProj indexes Q|K|ZB as one array");
static_assert((4096 + 3 * 3456) * 4 <= 64 * 1024, "control words inside the memset region");
constexpr int CW_BAR = 4096, CW_HANDOFF = 64;

constexpr int RING_BYTES = 131072, LDS_BYTES = 163840, LDSCTL_OFF = LDS_BYTES - 1024, MISC_OFF = LDSCTL_OFF + 320;

typedef GAS unsigned gu32;
#define RLX_AGENT __ATOMIC_RELAXED, __HIP_MEMORY_SCOPE_AGENT
#define LDS_WAIT() asm volatile("s_waitcnt lgkmcnt(0)" ::: "memory")

#define XB_TMO      128
#define XB_XCNT(j)  (256  + 64 * (j))
#define XB_XSUB(j)  (1280 + 64 * (j))
#define XB_XGEN(j)  (2304 + 64 * (j))
#define XB_TOP      3328
#define XB_TOPGEN   3392
#define XCD_BAR_WORDS 3456
#define XB_SPIN_CAP (1u << 18)
__device__ __forceinline__ unsigned xb_ld(unsigned* p)              { return __hip_atomic_load(p, __ATOMIC_RELAXED, __HIP_MEMORY_SCOPE_AGENT); }
__device__ __forceinline__ unsigned xb_add(unsigned* p, unsigned v) { return __hip_atomic_fetch_add(p, v, __ATOMIC_RELAXED, __HIP_MEMORY_SCOPE_AGENT); }
__device__ __forceinline__ unsigned xb_xcc_id() { return (unsigned)__builtin_amdgcn_s_getreg((3 << 11) | 20) & 0xFu; }
#define XB_SPIN(cond, bar) do { unsigned _sp = 0; while (cond) { __builtin_amdgcn_s_sleep(1); \
    if ((++_sp & 255u) == 0u) { if (xb_ld(&(bar)[XB_TMO])) break; if (_sp > XB_SPIN_CAP) { atomicAdd(&(bar)[XB_TMO], 1u); break; } } } } while (0)
struct XcdBarrier { unsigned* bar; unsigned x; volatile LAS unsigned* st; unsigned expect; };
__device__ __forceinline__ XcdBarrier xcd_barrier_post(unsigned* bar, volatile LAS unsigned* st, unsigned expect) {
    XcdBarrier b; b.bar = bar; b.x = xb_xcc_id(); b.st = st; b.expect = expect;
    if (threadIdx.x == 0) (void)xb_add(&bar[XB_XCNT(b.x)], 1u);
    return b;
}
__device__ __forceinline__ void xcd_barrier_complete(unsigned* bar, unsigned x, unsigned G, unsigned& nloc, unsigned& nx) {
    unsigned sum, cnt, mine, sp = 0u;
    for (;;) {
        sum = 0u; cnt = 0u; mine = 0u;
#pragma unroll
        for (unsigned j = 0; j < 16; ++j) { const unsigned c = xb_ld(&bar[XB_XCNT(j)]); sum += c; cnt += (c > 0u) ? 1u : 0u; mine = (j == x) ? c : mine; }
        if (sum == G) break;
        __builtin_amdgcn_s_sleep(1);
        if ((++sp & 255u) == 0u) { if (xb_ld(&bar[XB_TMO])) break; if (sp > XB_SPIN_CAP) { atomicAdd(&bar[XB_TMO], 1u); break; } }
    }
    nloc = mine > 0u ? mine : 1u; nx = cnt > 0u ? cnt : 1u;
}
__device__ __forceinline__ void xcd_barrier(const XcdBarrier& b) {
    asm volatile("s_waitcnt vmcnt(0)" ::: "memory");
    __syncthreads();
    if (threadIdx.x == 0) {
        unsigned* bar = b.bar;
        __builtin_amdgcn_s_waitcnt(0);
        unsigned nloc = b.st[0], nx = b.st[1];
        if (nloc == 0u) { xcd_barrier_complete(bar, b.x, b.expect, nloc, nx); b.st[0] = nloc; b.st[1] = nx; }
        const unsigned old = xb_add(&bar[XB_XSUB(b.x)], 1u);
        const unsigned gen = old / nloc;
        if (old + 1u == (gen + 1u) * nloc) {
            __builtin_amdgcn_fence(__ATOMIC_RELEASE, "agent");
            asm volatile("s_waitcnt vmcnt(0)" ::: "memory");
            const unsigned og = xb_add(&bar[XB_TOP], 1u);
            const unsigned tg = og / nx;
            if (og + 1u == (tg + 1u) * nx) xb_add(&bar[XB_TOPGEN], 1u);
            else XB_SPIN(xb_ld(&bar[XB_TOPGEN]) == tg, bar);
            __builtin_amdgcn_fence(__ATOMIC_ACQUIRE, "agent");
            xb_add(&bar[XB_XGEN(b.x)], 1u);
            asm volatile("s_waitcnt vmcnt(0)" ::: "memory");
        } else {
            XB_SPIN(xb_ld(&bar[XB_XGEN(b.x)]) == gen, bar);
            __builtin_amdgcn_fence(__ATOMIC_ACQUIRE, "agent");
            asm volatile("s_waitcnt vmcnt(0)" ::: "memory");
        }
    }
    __syncthreads();
}

struct Frame {
    LAS unsigned char* lds;
    int tid, lane, wave, vcu, G;
};

#define DPP_ADD(v, ctrl) ((v) + __builtin_bit_cast(float, __builtin_amdgcn_update_dpp(0, __builtin_bit_cast(int, (v)), (ctrl), 0xf, 0xf, true)))
__device__ __forceinline__ float wave_sum(float v) {
    v = DPP_ADD(v, 0xB1);
    v = DPP_ADD(v, 0x4E);
    v = DPP_ADD(v, 0x141);
    v = DPP_ADD(v, 0x140);
    const int vi = __builtin_bit_cast(int, v);
    const float r0 = __builtin_bit_cast(float, __builtin_amdgcn_readlane(vi, 0)), r1 = __builtin_bit_cast(float, __builtin_amdgcn_readlane(vi, 16));
    const float r2 = __builtin_bit_cast(float, __builtin_amdgcn_readlane(vi, 32)), r3 = __builtin_bit_cast(float, __builtin_amdgcn_readlane(vi, 48));
    return (r0 + r1) + (r2 + r3);
}

__device__ __forceinline__ void p0_transpose_item(const float* W, int N, bf16_t* WT, int K, int k0, int n0, int drow0, LAS float* scr, int lane) {
#pragma unroll 8
    for (int i = 0; i < 32; ++i) { const int kk = 2 * i + (lane >> 5); scr[kk * 33 + (lane & 31)] = __builtin_nontemporal_load(W + (size_t)(k0 + kk) * N + n0 + (lane & 31)); }
    LDS_WAIT(); asm volatile("" ::: "memory");
    const int c = lane & 7;
#pragma unroll
    for (int j = 0; j < 4; ++j) { const int n = (lane >> 3) + 8 * j; const LAS float* s = scr + (8 * c) * 33 + n;
        u32x4 o; o.x = cvt_pk_bf16(s[0 * 33], s[1 * 33]); o.y = cvt_pk_bf16(s[2 * 33], s[3 * 33]); o.z = cvt_pk_bf16(s[4 * 33], s[5 * 33]); o.w = cvt_pk_bf16(s[6 * 33], s[7 * 33]);
        *(u32x4*)(WT + (size_t)(drow0 + n) * K + k0 + 8 * c) = o; }
    LDS_WAIT(); asm volatile("" ::: "memory");
}
__device__ __forceinline__ int win_dest_row(int n0) {
    const int s = n0 >> 10, ch = n0 & 1023;
    switch (s) {
        case 0: return 256 * (ch >> 7) + (ch & 127);
        case 1: return 5120 + ch;
        case 2: return 256 * (ch >> 7) + 128 + (ch & 127);
        case 3: return 2048 + ch;
        case 4: return 3072 + ch;
        case 5: return 6144 + ch;
        default: return 4096 + ch;
    }
}
__device__ __forceinline__ void p0_weights(const Frame& F, const float* w_in, const float* w_out, bf16_t* WIN, bf16_t* WOUT, int l, int gw, int NGW) {
    LAS float* scr = (LAS float*)(F.lds + F.wave * 16384);
    constexpr int I_IN = (D / 64) * (DIN / 32), I_OUT = (D / 64) * (D / 32), I_L = I_IN + I_OUT;
    for (int it = gw; it < I_L; it += NGW) {
        int r = it;
        if (r < I_IN) { const int kb = r / (DIN / 32), nb = r % (DIN / 32);
            p0_transpose_item(w_in + (size_t)l * D * DIN, DIN, WIN + (size_t)l * DIN * D, D, 64 * kb, 32 * nb, win_dest_row(32 * nb), scr, F.lane); }
        else { r -= I_IN; const int kb = r / (D / 32), nb = r % (D / 32);
            p0_transpose_item(w_out + (size_t)l * D * D, D, WOUT + (size_t)l * D * D, D, 64 * kb, 32 * nb, 32 * nb, scr, F.lane); }
    }
}
__device__ __forceinline__ void p0_prologue(const Frame& F, const float* c_in, const float* w_ada, const float* b_ada, const float* w_in, const float* w_out, const float* w_sp,
                                            float* MOD, bf16_t* WIN, bf16_t* WOUT, bf16_t* WSB) {
    LAS float* sc = (LAS float*)F.lds;
    LAS float* red = (LAS float*)(F.lds + 16384);
    constexpr int NCH = 48, NIT = NMOD / NCH;
    for (int it = F.vcu; it < DEPTH * NIT; it += F.G) {
        const int l = it / NIT, n0 = (it % NIT) * NCH;
        const int ln = F.lane < NCH ? F.lane : NCH - 1;
        const float* W = w_ada + (size_t)l * D * NMOD + n0 + ln;
        const int k0 = F.wave * 256;
        float cv[8], wq[16];
#pragma unroll
        for (int q = 0; q < 8; ++q) cv[q] = c_in[F.tid + 512 * q];
#pragma unroll
        for (int u = 0; u < 16; ++u) wq[u] = __builtin_nontemporal_load(W + (size_t)(k0 + u) * NMOD);
#pragma unroll
        for (int q = 0; q < 8; ++q) sc[F.tid + 512 * q] = silu_f(cv[q]);
        __syncthreads();
        float a0 = 0.f, a1 = 0.f;
#pragma unroll
        for (int u = 0; u < 16; ++u) { a0 += sc[k0 + u] * wq[u]; a1 += sc[D + k0 + u] * wq[u]; }
#pragma unroll 16
        for (int k = 16; k < 256; ++k) { const float w = __builtin_nontemporal_load(W + (size_t)(k0 + k) * NMOD); a0 += sc[k0 + k] * w; a1 += sc[D + k0 + k] * w; }
        red[(F.wave * 2 + 0) * 64 + F.lane] = a0; red[(F.wave * 2 + 1) * 64 + F.lane] = a1;
        __syncthreads();
        if (F.tid < 128 && (F.tid & 63) < NCH) { const int b = F.tid >> 6, lc = F.tid & 63; float s = 0.f;
#pragma unroll
            for (int w = 0; w < 8; ++w) s += red[(w * 2 + b) * 64 + lc];
            MOD[(size_t)(l * BATCH + b) * NMOD + n0 + lc] = s + b_ada[(size_t)l * NMOD + n0 + lc]; }
        __syncthreads();
    }
    p0_weights(F, w_in, w_out, WIN, WOUT, 0, F.vcu * 8 + F.wave, F.G * 8);
    const int gw = F.vcu * 8 + F.wave, NGW = F.G * 8;
    for (int i = (gw * 64 + F.lane) * 4; i < DEPTH * NG * 128 * 128; i += NGW * 64 * 4) { const f32x4 v = *(const f32x4*)(w_sp + i); u32x2 o; o.x = cvt_pk_bf16(v[0], v[1]); o.y = cvt_pk_bf16(v[2], v[3]); *(u32x2*)(WSB + i) = o; }
}

__device__ __forceinline__ void lds_sync() { asm volatile("s_waitcnt lgkmcnt(0)" ::: "memory"); __builtin_amdgcn_s_barrier(); asm volatile("" ::: "memory"); }
struct LnStage { const bf16_t* y; const float* g; const float* b; };
__device__ __forceinline__ void ln_row_norm(f32x4 (&v)[8], float& rstd) {
    float s = 0.f;
#pragma unroll
    for (int j = 0; j < 8; ++j) s += (v[j][0] + v[j][1]) + (v[j][2] + v[j][3]);
    const float mean = wave_sum(s) * (1.f / D); float s2 = 0.f;
#pragma unroll
    for (int j = 0; j < 8; ++j) { v[j] = v[j] - mean; s2 += (v[j][0] * v[j][0] + v[j][1] * v[j][1]) + (v[j][2] * v[j][2] + v[j][3] * v[j][3]); }
    rstd = __builtin_amdgcn_rsqf(wave_sum(s2) * (1.f / D) + LN_EPS);
}
__device__ __forceinline__ void ln_phase(const Frame& F, const float* src, const LnStage sa, const LnStage sb, float* xout, bool has_h, const float* modn, bf16_t* H) {
    LAS float* tga = (LAS float*)F.lds;
    LAS float* tba = tga + D; LAS float* tgb = tba + D; LAS float* tbb = tgb + D; LAS float* ts = tbb + D; LAS float* th = ts + D;
    for (int rb = F.vcu; rb < M / 64; rb += F.G) {
        const int bat = (rb * 64) / T;
        f32x4 vA[8], vB[8]; u32x2 yaA[8], ybA[8], yaB[8], ybB[8];
        auto load_row = [&](f32x4 (&v)[8], u32x2 (&ya)[8], u32x2 (&yb)[8], int i) __attribute__((always_inline)) {
            const size_t row = (size_t)rb * 64 + F.wave * 8 + i;
            const f32x4* xr = (const f32x4*)(src + row * D) + F.lane;
#pragma unroll
            for (int j = 0; j < 8; ++j) v[j] = __builtin_nontemporal_load(xr + 64 * j);
            if (sa.y) { const u32x2* yr = (const u32x2*)(sa.y + row * D) + F.lane;
#pragma unroll
                for (int j = 0; j < 8; ++j) ya[j] = yr[64 * j]; }
            if (sb.y) { const u32x2* yr = (const u32x2*)(sb.y + row * D) + F.lane;
#pragma unroll
                for (int j = 0; j < 8; ++j) yb[j] = yr[64 * j]; }
        };
        auto do_row = [&](f32x4 (&v)[8], u32x2 (&ya)[8], u32x2 (&yb)[8], int i) __attribute__((always_inline)) {
            const size_t row = (size_t)rb * 64 + F.wave * 8 + i;
            const LAS float* tl = tga + 4 * F.lane; asm volatile("" : "+v"(tl));
            if (sa.y) {
#pragma unroll
                for (int j = 0; j < 8; ++j) v[j] = v[j] * DN_ALPHA + (f32x4){bf_lo(ya[j].x), bf_hi(ya[j].x), bf_lo(ya[j].y), bf_hi(ya[j].y)};
                float rstd; ln_row_norm(v, rstd);
#pragma unroll
                for (int j = 0; j < 8; ++j) v[j] = v[j] * rstd * *(const LAS f32x4*)(tl + 256 * j) + *(const LAS f32x4*)(tl + D + 256 * j);
            }
            if (sb.y) {
#pragma unroll
                for (int j = 0; j < 8; ++j) v[j] = v[j] * DN_ALPHA + (f32x4){bf_lo(yb[j].x), bf_hi(yb[j].x), bf_lo(yb[j].y), bf_hi(yb[j].y)};
                float rstd; ln_row_norm(v, rstd);
#pragma unroll
                for (int j = 0; j < 8; ++j) v[j] = v[j] * rstd * *(const LAS f32x4*)(tl + 2 * D + 256 * j) + *(const LAS f32x4*)(tl + 3 * D + 256 * j);
            }
            if (xout) { f32x4* xo = (f32x4*)(xout + row * D) + F.lane;
#pragma unroll
                for (int j = 0; j < 8; ++j) __builtin_nontemporal_store(v[j], xo + 64 * j); }
            if (has_h) {
                float rstd; ln_row_norm(v, rstd);
                u32x2* ho = (u32x2*)(H + row * D) + F.lane;
#pragma unroll
                for (int j = 0; j < 8; ++j) { const f32x4 o = v[j] * rstd * *(const LAS f32x4*)(tl + 4 * D + 256 * j) + *(const LAS f32x4*)(tl + 5 * D + 256 * j);
                    u32x2 w; w.x = cvt_pk_bf16(o[0], o[1]); w.y = cvt_pk_bf16(o[2], o[3]); ho[64 * j] = w; }
            }
        };
        __syncthreads();
        {
            float tv[4][6];
#pragma unroll
            for (int q = 0; q < 4; ++q) { const int i = F.tid + 512 * q;
                if (sa.y) { tv[q][0] = sa.g[i]; tv[q][1] = sa.b[i]; }
                if (sb.y) { tv[q][2] = sb.g[i]; tv[q][3] = sb.b[i]; }
                if (has_h) { tv[q][4] = modn[(size_t)bat * NMOD + i]; tv[q][5] = modn[(size_t)bat * NMOD + D + i]; } }
            load_row(vA, yaA, ybA, 0);
#pragma unroll
            for (int q = 0; q < 4; ++q) { const int i = F.tid + 512 * q;
                if (sa.y) { tga[i] = tv[q][0]; tba[i] = tv[q][1]; }
                if (sb.y) { tgb[i] = tv[q][2]; tbb[i] = tv[q][3]; }
                if (has_h) { th[i] = tv[q][4]; ts[i] = 1.0f + tv[q][5]; } }
        }
        lds_sync();
        for (int i = 0; i < 6; i += 2) { load_row(vB, yaB, ybB, i + 1); do_row(vA, yaA, ybA, i); load_row(vA, yaA, ybA, i + 2); do_row(vB, yaB, ybB, i + 1); }
        load_row(vB, yaB, ybB, 7); do_row(vA, yaA, ybA, 6); do_row(vB, yaB, ybB, 7);
    }
    __syncthreads();
}

struct AttnPtrs { const float* rpb; const bf16_t *Qb, *Kb, *VT, *ZB; bf16_t* YC; };
constexpr int AK_OFF = 0, AV_OFF = 73728, ATT_BIAS_OFF = 147456;
static_assert(ATT_BIAS_OFF + 15 * 32 * 4 <= LDSCTL_OFF, "attention LDS map");
static_assert(DEPTH == 2, "the LN phases chain exactly two DeepNorm stages");
__device__ __forceinline__ int kswz(int key) { return ((key >> 1) & 1) | (((key >> 3) & 3) << 1); }
__device__ __forceinline__ int rstart(int r) { return min(max(r - 4, 0), 120); }
struct AttnPre { u32x4 kv[9], vv[9]; };
template <bool VPART>
__device__ __forceinline__ void attn_issue(const Frame& F, const AttnPtrs& P, int item, AttnPre& A) {
    const int bh = item >> 3, r0 = 16 * (item & 7);
    const bf16_t* g = (VPART ? P.VT : P.Kb) + (size_t)bh * T * 64 + F.tid * 8;
    const int lo = rstart(r0);
#pragma unroll
    for (int i = 0; i < 9; ++i) { const int kr = min(lo + i, T / 64 - 1); const u32x4 w = *(const u32x4*)(g + (size_t)kr * 4096); if (VPART) A.vv[i] = w; else A.kv[i] = w; }
}

constexpr int SG_LDP = 136;
constexpr int SG_W_OFF = 0, SG_VT_OFF = 34816, SG_GY_OFF = 69632, SG_RED_OFF = 104448, SG_STAT_OFF = SG_RED_OFF + 8192;
template <bool B> struct BoolTag { static constexpr bool value = B; };
__device__ __forceinline__ void sgu_phase(const Frame& F, int l, const float* sgu_g, const float* sgu_b, const float* b_sp, const bf16_t* WSB, const bf16_t* VGT, const bf16_t* GA, bf16_t* YC, const AttnPtrs& AP, AttnPre& A) {
    LAS bf16_t* wl = (LAS bf16_t*)(F.lds + SG_W_OFF);
    LAS bf16_t* vt = (LAS bf16_t*)(F.lds + SG_VT_OFF);
    LAS bf16_t* gy = (LAS bf16_t*)(F.lds + SG_GY_OFF);
    LAS float* red = (LAS float*)(F.lds + SG_RED_OFF);
    LAS float* stat = (LAS float*)(F.lds + SG_STAT_OFF);
    const int fr = F.lane & 15, fq = F.lane >> 4;
    const int chunk = F.tid & 15, rq = F.tid >> 4;
    const int hG = F.G / 2, hf = F.vcu / hG, vl = F.vcu % hG, nitems = NG * (T / 128);
    const int per = (nitems + hG - 1) / hG;
    const int s0 = vl * per, n_my = max(0, min(per, nitems - s0));
    u32x4 vw[4], gv[4];
    float gam[4], bet[4];
    LAS float* bl = stat + 256;
    { const int sc = min(s0, nitems - 1), g = sc / (T / 128), bn = hf * (T / 128) + sc % (T / 128);
#pragma unroll
      for (int j = 0; j < 4; ++j) { vw[j] = *(const u32x4*)(VGT + ((size_t)bn * DS + g * 128 + rq + 32 * j) * 128 + 8 * chunk); gv[j] = *(const u32x4*)(GA + ((size_t)bn * 128 + rq + 32 * j) * DS + g * 128 + 8 * chunk); } }
    auto load_group = [&](int g) __attribute__((always_inline)) {
            const bf16_t* Wg = WSB + ((size_t)l * NG + g) * 128 * 128;
            u32x4 wv[4];
#pragma unroll
            for (int j = 0; j < 4; ++j) wv[j] = *(const u32x4*)(Wg + (rq + 32 * j) * 128 + 8 * chunk);
#pragma unroll
            for (int j = 0; j < 4; ++j) { gam[j] = sgu_g[(size_t)l * DS + g * 128 + rq + 32 * j]; bet[j] = sgu_b[(size_t)l * DS + g * 128 + rq + 32 * j]; }
            if (F.tid < 128) bl[F.tid] = b_sp[((size_t)l * NG + g) * 128 + F.tid];
#pragma unroll
            for (int j = 0; j < 4; ++j) *(LAS u32x4*)(wl + (rq + 32 * j) * SG_LDP + 8 * chunk) = wv[j];
    };
    auto item_body = [&](int s, int g, auto last_tag) __attribute__((always_inline)) {
        const int bn = hf * (T / 128) + s % (T / 128);
        const size_t m0 = (size_t)bn * 128;
#pragma unroll
        for (int j = 0; j < 4; ++j) *(LAS u32x4*)(gy + (rq + 32 * j) * SG_LDP + 8 * chunk) = gv[j];
        float x[4][8], s1[8], s2[8];
#pragma unroll
        for (int j = 0; j < 4; ++j) { x[j][0] = bf_lo(vw[j].x); x[j][1] = bf_hi(vw[j].x); x[j][2] = bf_lo(vw[j].y); x[j][3] = bf_hi(vw[j].y); x[j][4] = bf_lo(vw[j].z); x[j][5] = bf_hi(vw[j].z); x[j][6] = bf_lo(vw[j].w); x[j][7] = bf_hi(vw[j].w); }
        if constexpr (decltype(last_tag)::value) attn_issue<false>(F, AP, F.vcu, A);
        else { const int sn = s + 1, gn = sn / (T / 128), bnn = hf * (T / 128) + sn % (T / 128);
#pragma unroll
          for (int j = 0; j < 4; ++j) { vw[j] = *(const u32x4*)(VGT + ((size_t)bnn * DS + gn * 128 + rq + 32 * j) * 128 + 8 * chunk); gv[j] = *(const u32x4*)(GA + ((size_t)bnn * 128 + rq + 32 * j) * DS + gn * 128 + 8 * chunk); } }
#pragma unroll
        for (int e = 0; e < 8; ++e) { s1[e] = (x[0][e] + x[1][e]) + (x[2][e] + x[3][e]); s2[e] = (x[0][e] * x[0][e] + x[1][e] * x[1][e]) + (x[2][e] * x[2][e] + x[3][e] * x[3][e]);
            s1[e] += __shfl_xor(s1[e], 16); s1[e] += __shfl_xor(s1[e], 32); s2[e] += __shfl_xor(s2[e], 16); s2[e] += __shfl_xor(s2[e], 32); }
        if (fq == 0) {
            *(LAS f32x4*)(red + (F.wave * 2 + 0) * 128 + 8 * chunk) = (f32x4){s1[0], s1[1], s1[2], s1[3]}; *(LAS f32x4*)(red + (F.wave * 2 + 0) * 128 + 8 * chunk + 4) = (f32x4){s1[4], s1[5], s1[6], s1[7]};
            *(LAS f32x4*)(red + (F.wave * 2 + 1) * 128 + 8 * chunk) = (f32x4){s2[0], s2[1], s2[2], s2[3]}; *(LAS f32x4*)(red + (F.wave * 2 + 1) * 128 + 8 * chunk + 4) = (f32x4){s2[4], s2[5], s2[6], s2[7]};
        }
        lds_sync();
        if (F.tid < 128) { float a1 = 0.f, a2 = 0.f;
#pragma unroll
            for (int w = 0; w < 8; ++w) { a1 += red[(w * 2 + 0) * 128 + F.tid]; a2 += red[(w * 2 + 1) * 128 + F.tid]; }
            const float mean = a1 * (1.f / 128.f); const float var = fmaxf(a2 * (1.f / 128.f) - mean * mean, 0.f);
            stat[2 * F.tid] = mean; stat[2 * F.tid + 1] = __builtin_amdgcn_rsqf(var + LN_EPS); }
        lds_sync();
        {
            float mu[8], rs[8];
#pragma unroll
            for (int e = 0; e < 8; e += 2) { const f32x4 st4 = *(const LAS f32x4*)(stat + 2 * (8 * chunk + e)); mu[e] = st4[0]; rs[e] = st4[1]; mu[e + 1] = st4[2]; rs[e + 1] = st4[3]; }
#pragma unroll
            for (int j = 0; j < 4; ++j) { u32x4 o;
                o.x = cvt_pk_bf16((x[j][0] - mu[0]) * rs[0] * gam[j] + bet[j], (x[j][1] - mu[1]) * rs[1] * gam[j] + bet[j]);
                o.y = cvt_pk_bf16((x[j][2] - mu[2]) * rs[2] * gam[j] + bet[j], (x[j][3] - mu[3]) * rs[3] * gam[j] + bet[j]);
                o.z = cvt_pk_bf16((x[j][4] - mu[4]) * rs[4] * gam[j] + bet[j], (x[j][5] - mu[5]) * rs[5] * gam[j] + bet[j]);
                o.w = cvt_pk_bf16((x[j][6] - mu[6]) * rs[6] * gam[j] + bet[j], (x[j][7] - mu[7]) * rs[7] * gam[j] + bet[j]);
                *(LAS u32x4*)(vt + (rq + 32 * j) * SG_LDP + 8 * chunk) = o; }
        }
        lds_sync();
        {
            bf16x8 af[4];
#pragma unroll
            for (int ks = 0; ks < 4; ++ks) af[ks] = *(const LAS bf16x8*)(vt + (16 * F.wave + fr) * SG_LDP + 32 * ks + 8 * fq);
#pragma unroll
            for (int nt = 0; nt < 8; ++nt) {
                f32x4 acc = {0.f, 0.f, 0.f, 0.f};
#pragma unroll
                for (int ks = 0; ks < 4; ++ks) { const bf16x8 bfrag = *(const LAS bf16x8*)(wl + (16 * nt + fr) * SG_LDP + 32 * ks + 8 * fq);
                    acc = __builtin_amdgcn_mfma_f32_16x16x32_bf16(af[ks], bfrag, acc, 0, 0, 0); }
                const int p = 16 * nt + fr;
                const float bs = bl[p];
                LAS u32x2* gp = (LAS u32x2*)(gy + p * SG_LDP + 16 * F.wave + 4 * fq);
                const u32x2 gaw = *gp;
                u32x2 o; o.x = cvt_pk_bf16(bf_lo(gaw.x) * (acc[0] + bs), bf_hi(gaw.x) * (acc[1] + bs)); o.y = cvt_pk_bf16(bf_lo(gaw.y) * (acc[2] + bs), bf_hi(gaw.y) * (acc[3] + bs));
                *gp = o;
            }
        }
        lds_sync();
#pragma unroll
        for (int j = 0; j < 4; ++j) { const int p = rq + 32 * j; *(u32x4*)(YC + (m0 + p) * D + g * 128 + 8 * chunk) = *(const LAS u32x4*)(gy + p * SG_LDP + 8 * chunk); }
    };
    int ii = 0, g_cur = -1;
    while (ii < n_my - 1) {
        const int g = (s0 + ii) / (T / 128);
        lds_sync();
        load_group(g); g_cur = g;
        for (bool first = true; ii < n_my - 1 && (s0 + ii) / (T / 128) == g; ++ii, first = false) { if (!first) lds_sync(); item_body(s0 + ii, g, BoolTag<false>{}); }
    }
    if (n_my > 0) { const int s = s0 + n_my - 1, g = s / (T / 128);
        lds_sync();
        if (g != g_cur) load_group(g);
        item_body(s, g, BoolTag<true>{}); }
    else attn_issue<false>(F, AP, F.vcu, A);
    __syncthreads();
}

__device__ __forceinline__ void attn_phase(const Frame& F, const AttnPtrs& P, int l, AttnPre& A) {
    const int kwr = (F.tid >> 3) * 128 + (((F.tid & 7) ^ kswz(F.tid >> 3)) << 4);
    const LAS float* rp = (const LAS float*)(F.lds + ATT_BIAS_OFF);
    for (int item = F.vcu; item < BATCH * NH * 8; item += F.G) {
        const int bh = item >> 3, r0 = 16 * (item & 7), b = bh >> 4, h = bh & 15;
        const size_t hb = (size_t)bh * T;
        attn_issue<true>(F, P, item, A);
        __syncthreads();
        { const int lo = rstart(r0), hi = rstart(r0 + 1) + 8;
#pragma unroll
            for (int i = 0; i < 9; ++i) if (lo + i < hi) { const int slot = (lo + i) % 9;
                *(LAS u32x4*)(F.lds + AK_OFF + slot * 8192 + kwr) = A.kv[i]; *(LAS u32x4*)(F.lds + AV_OFF + slot * 8192 + F.tid * 16) = A.vv[i]; } }
        int lane_ = F.lane; asm volatile("" : "+v"(lane_));
        const int fr = lane_ & 15, fq = lane_ >> 4, cb = F.wave & 3, rsel = F.wave >> 2;
        const int bs = min(max(16 * cb - 8, 0), 32);
        const int qcol = 16 * cb + fr;
        const int wst = min(max(qcol - 8, 0), 48);
        int ci[2][4];
#pragma unroll
        for (int X = 0; X < 2; ++X)
#pragma unroll
            for (int e = 0; e < 4; ++e) { const int kc = bs + 8 * fq + 4 * X + e; ci[X][e] = ((kc >= wst) && (kc < wst + 16)) ? min(max(kc - qcol + 15, 0), 30) : 31; }
        int koff[2][2];
#pragma unroll
        for (int X = 0; X < 2; ++X) { const int key = bs + 8 * (fr >> 2) + 4 * X + (fr & 3);
#pragma unroll
            for (int ks = 0; ks < 2; ++ks) koff[X][ks] = key * 128 + (((ks * 4 + fq) ^ kswz(key)) << 4); }
        const int voff = (((bs >> 3) + fq) * 64 + fr) * 16;
        const bf16_t* Kg = P.Kb + hb * 64 + F.tid * 8;
        const bf16_t* Vg = P.VT + hb * 64 + F.tid * 8;
        bf16_t* yb = P.YC + ((size_t)b * T + qcol) * D + DS + h * 64 + 4 * fq;
        for (int i = F.tid; i < 15 * 32; i += 512) ((LAS float*)(F.lds + ATT_BIAS_OFF))[i] = (i & 31) == 31 ? -1.0e30f : P.rpb[((size_t)l * NH + h) * 15 * 31 + (i >> 5) * 31 + (i & 31)] * 1.4426950408889634f;
        bf16x8 qf[2]; u32x2 zw[4];
        { const size_t tk = hb + (r0 + rsel) * 64 + qcol;
#pragma unroll
            for (int ks = 0; ks < 2; ++ks) qf[ks] = *(const bf16x8*)(P.Qb + tk * 64 + 32 * ks + 8 * fq);
#pragma unroll
            for (int d = 0; d < 4; ++d) zw[d] = *(const u32x2*)(P.ZB + tk * 64 + 16 * d + 4 * fq); }
        u32x2 yw[4];
        __syncthreads();
        for (int st = 0; st < 8; ++st) {
            const int ra = r0 + 2 * st, r = ra + rsel, rs = rstart(r);
            if (st > 0) {
#pragma unroll
                for (int d = 0; d < 4; ++d) *(u32x2*)(yb + (size_t)(r - 2) * 64 * D + 16 * d) = yw[d]; }
            const int nlo = rstart(ra + 1) + 8, nhi = (st < 7) ? rstart(ra + 3) + 7 : -1;
            const int kr0 = min(nlo, T / 64 - 1), kr1 = min(nlo + 1, T / 64 - 1);
            const u32x4 pk0 = *(const u32x4*)(Kg + (size_t)kr0 * 4096), pv0 = *(const u32x4*)(Vg + (size_t)kr0 * 4096);
            const u32x4 pk1 = *(const u32x4*)(Kg + (size_t)kr1 * 4096), pv1 = *(const u32x4*)(Vg + (size_t)kr1 * 4096);
            const size_t tkn = hb + min(r + 2, T / 64 - 1) * 64 + qcol;
            bf16x8 qn[2]; u32x2 zn[4];
#pragma unroll
            for (int ks = 0; ks < 2; ++ks) qn[ks] = *(const bf16x8*)(P.Qb + tkn * 64 + 32 * ks + 8 * fq);
#pragma unroll
            for (int d = 0; d < 4; ++d) zn[d] = *(const u32x2*)(P.ZB + tkn * 64 + 16 * d + 4 * fq);
            float s[8][2][4];
            float mx = -3.0e38f;
#pragma unroll
            for (int i = 0; i < 8; ++i) {
                const LAS float* rpi = rp + (rs + i - r + 7) * 32;
                const LAS unsigned char* kb = F.lds + AK_OFF + ((rs + i) % 9) * 8192;
#pragma unroll
                for (int X = 0; X < 2; ++X) {
                    f32x4 c = {rpi[ci[X][0]], rpi[ci[X][1]], rpi[ci[X][2]], rpi[ci[X][3]]};
#pragma unroll
                    for (int ks = 0; ks < 2; ++ks) c = __builtin_amdgcn_mfma_f32_16x16x32_bf16(*(const LAS bf16x8*)(kb + koff[X][ks]), qf[ks], c, 0, 0, 0);
                    s[i][X][0] = c[0]; s[i][X][1] = c[1]; s[i][X][2] = c[2]; s[i][X][3] = c[3];
                    mx = fmaxf(fmaxf(mx, c[0]), c[1]); mx = fmaxf(fmaxf(mx, c[2]), c[3]);
                }
            }
            mx = fmaxf(mx, __shfl_xor(mx, 16)); mx = fmaxf(mx, __shfl_xor(mx, 32));
#pragma unroll
            for (int i = 0; i < 8; ++i)
#pragma unroll
                for (int X = 0; X < 2; ++X)
#pragma unroll
                    for (int e = 0; e < 4; ++e) s[i][X][e] = __builtin_amdgcn_exp2f(s[i][X][e] - mx);
            f32x4 o[4], osum = {0.f, 0.f, 0.f, 0.f};
#pragma unroll
            for (int d = 0; d < 4; ++d) o[d] = (f32x4){0.f, 0.f, 0.f, 0.f};
            const bf16x8 ones = {0x3F80, 0x3F80, 0x3F80, 0x3F80, 0x3F80, 0x3F80, 0x3F80, 0x3F80};
#pragma unroll
            for (int i = 0; i < 8; ++i) {
                union { u32x4 u; bf16x8 v; } pb;
                pb.u.x = cvt_pk_bf16(s[i][0][0], s[i][0][1]); pb.u.y = cvt_pk_bf16(s[i][0][2], s[i][0][3]); pb.u.z = cvt_pk_bf16(s[i][1][0], s[i][1][1]); pb.u.w = cvt_pk_bf16(s[i][1][2], s[i][1][3]);
                const LAS unsigned char* vb = F.lds + AV_OFF + ((rs + i) % 9) * 8192 + voff;
#pragma unroll
                for (int d = 0; d < 4; ++d) o[d] = __builtin_amdgcn_mfma_f32_16x16x32_bf16(*(const LAS bf16x8*)(vb + d * 256), pb.v, o[d], 0, 0, 0);
                osum = __builtin_amdgcn_mfma_f32_16x16x32_bf16(ones, pb.v, osum, 0, 0, 0);
            }
            const float sum = osum[0];
            const float inv = 1.0f / sum;
#pragma unroll
            for (int d = 0; d < 4; ++d) {
                yw[d].x = cvt_pk_bf16(o[d][0] * inv * bf_lo(zw[d].x), o[d][1] * inv * bf_hi(zw[d].x)); yw[d].y = cvt_pk_bf16(o[d][2] * inv * bf_lo(zw[d].y), o[d][3] * inv * bf_hi(zw[d].y)); }
            __syncthreads();
            if (nlo <= nhi) { const int slot = nlo % 9; *(LAS u32x4*)(F.lds + AK_OFF + slot * 8192 + kwr) = pk0; *(LAS u32x4*)(F.lds + AV_OFF + slot * 8192 + F.tid * 16) = pv0; }
            if (nlo + 1 <= nhi) { const int slot = (nlo + 1) % 9; *(LAS u32x4*)(F.lds + AK_OFF + slot * 8192 + kwr) = pk1; *(LAS u32x4*)(F.lds + AV_OFF + slot * 8192 + F.tid * 16) = pv1; }
            __syncthreads();
            qf[0] = qn[0]; qf[1] = qn[1];
#pragma unroll
            for (int d = 0; d < 4; ++d) zw[d] = zn[d];
        }
#pragma unroll
        for (int d = 0; d < 4; ++d) *(u32x2*)(yb + (size_t)(r0 + 14 + rsel) * 64 * D + 16 * d) = yw[d];
        if (item + F.G < BATCH * NH * 8) attn_issue<false>(F, P, item + F.G, A);
    }
    __syncthreads();
}

struct Args { const float* in[13]; float* out; unsigned char* ws; int ph_lo, ph_hi; };
constexpr int N_PHASES = 2 + 4 * DEPTH;

typedef const __attribute__((address_space(4))) Args* ArgsP;
__device__ __forceinline__ ArgsP fresh_args() { ArgsP p = (ArgsP)__builtin_amdgcn_kernarg_segment_ptr(); asm volatile("" : "+s"(p)); return p; }
#ifndef MK_MASK
#define MK_MASK 63
#endif
#ifndef MK_REP
#define MK_REP 0
#endif
__global__ void __launch_bounds__(512, 2) mk_fwd(Args args) {
    extern __shared__ __attribute__((aligned(16))) unsigned char lds[];
    { LAS unsigned* z = (LAS unsigned*)((LAS unsigned char*)lds + LDSCTL_OFF); for (int u = threadIdx.x; u < (LDS_BYTES - LDSCTL_OFF) / 4; u += 512) z[u] = 0u; }
    __syncthreads();
    const int lo = args.ph_lo, hi = args.ph_hi;
    const unsigned half_ = ((blockIdx.x & 7u) >> 2) & 1u;
    XcdBarrier bar, barh; bar.bar = (unsigned*)(args.ws + WS_CTL) + CW_BAR; bar.x = 0; bar.st = nullptr; bar.expect = gridDim.x; barh = bar;
    if (hi - lo > 1) {
        bar = xcd_barrier_post((unsigned*)(args.ws + WS_CTL) + CW_BAR, (volatile LAS unsigned*)((LAS unsigned char*)lds + MISC_OFF) + 8, gridDim.x);
        barh = xcd_barrier_post((unsigned*)(args.ws + WS_CTL) + CW_BAR + (1 + half_) * XCD_BAR_WORDS, (volatile LAS unsigned*)((LAS unsigned char*)lds + MISC_OFF) + 10, gridDim.x / 2);
    }
    const bool split_ok = (gridDim.x % 16) == 0;

    for (int ph = lo; ph < hi; ++ph) {
      const int kind_ = ph == 0 ? 1 : (ph == 1 ? 2 : (((ph - 2) & 3) == 0 ? 4 : (((ph - 2) & 3) == 1 ? 64 : (((ph - 2) & 3) == 2 ? 32 : 2))));
      const int nrep_ = (MK_REP & kind_) ? 2 : 1;
      for (int rep_ = 0; rep_ < nrep_; ++rep_) {
        ArgsP ap = fresh_args();
        unsigned char* ws = ap->ws;
        int tid_ = threadIdx.x, bx = blockIdx.x, G_ = gridDim.x;
        asm volatile("" : "+v"(tid_)); asm volatile("" : "+s"(bx), "+s"(G_));
        Frame F; F.lds = (LAS unsigned char*)lds; F.tid = tid_; F.lane = tid_ & 63; F.wave = __builtin_amdgcn_readfirstlane(tid_ >> 6);
        F.G = G_; F.vcu = (G_ % 8 == 0) ? (bx % 8) * (G_ / 8) + bx / 8 : bx;
        if (ph == 0) {
            if (MK_MASK & 1) p0_prologue(F, ap->in[1], ap->in[2], ap->in[3], ap->in[4], ap->in[10], ap->in[7], (float*)(ws + WS_MOD), (bf16_t*)(ws + WS_WIN), (bf16_t*)(ws + WS_WOUT), (bf16_t*)(ws + WS_WSB));
        } else if (ph == 1) {
            if (split_ok && half_ == 1u) {
                __syncthreads();
                p0_weights(F, ap->in[4], ap->in[10], (bf16_t*)(ws + WS_WIN), (bf16_t*)(ws + WS_WOUT), 1, (F.vcu - F.G / 2) * 8 + F.wave, (F.G / 2) * 8);
                __syncthreads();
            } else if (!split_ok) { __syncthreads(); p0_weights(F, ap->in[4], ap->in[10], (bf16_t*)(ws + WS_WIN), (bf16_t*)(ws + WS_WOUT), 1, F.vcu * 8 + F.wave, F.G * 8); __syncthreads(); }
            if (MK_MASK & 2) ln_phase(F, ap->in[0], LnStage{nullptr, nullptr, nullptr}, LnStage{nullptr, nullptr, nullptr}, nullptr, true, (const float*)(ws + WS_MOD), (bf16_t*)(ws + WS_H));
        } else {
            const int l = (ph - 2) >> 2, k = (ph - 2) & 3;
            if (k == 0) { if (MK_MASK & 4) {
                const bf16_t* H = (const bf16_t*)(ws + WS_H); const bf16_t* W = (const bf16_t*)(ws + WS_WIN) + (size_t)l * DIN * D;
                pg8::Gemm g{H, W, W + (size_t)5120 * D, H, D};
                pg8::ProjOrder S; S.init(F.G, bx);
                pg8::EpiProj E{(bf16_t*)(ws + WS_GA), (bf16_t*)(ws + WS_VG), (bf16_t*)(ws + WS_Q), (bf16_t*)(ws + WS_VT)};
                pg8::gemm_phase<pg8::EpiProj, pg8::ProjOrder>(F.lds, F.tid, g, S, E); }
            } else if (k == 1) {
                const AttnPtrs P{ap->in[9], (const bf16_t*)(ws + WS_Q), (const bf16_t*)(ws + WS_K), (const bf16_t*)(ws + WS_VT), (const bf16_t*)(ws + WS_ZB), (bf16_t*)(ws + WS_H)};
                AttnPre pre;
                sgu_phase(F, l, ap->in[5], ap->in[6], ap->in[8], (const bf16_t*)(ws + WS_WSB), (const bf16_t*)(ws + WS_VG), (const bf16_t*)(ws + WS_GA), (bf16_t*)(ws + WS_H), P, pre);
                attn_phase(F, P, l, pre);
            } else if (k == 2) { if (MK_MASK & 32) {
                pg8::Gemm g{(const bf16_t*)(ws + WS_H), (const bf16_t*)(ws + WS_WOUT) + (size_t)l * D * D, nullptr, nullptr, D};
                pg8::StaticOrder S; S.init(M, D, F.G, bx);
                LAS float* g1 = (LAS float*)(F.lds + pg8::STAGE_BYTES);
                const float* gsrc = (const float*)(ws + WS_MOD) + (size_t)l * BATCH * NMOD + 2 * D;
                const int gi0 = F.tid, gi1 = 512 + F.tid;
                pg8::EpiOut E{g1, (bf16_t*)(ws + (l == 0 ? WS_Y0 : WS_Y)), *(const f32x4*)(gsrc + (size_t)(gi0 / (D / 4)) * NMOD + (gi0 % (D / 4)) * 4), *(const f32x4*)(gsrc + (size_t)(gi1 / (D / 4)) * NMOD + (gi1 % (D / 4)) * 4)};
                pg8::gemm_phase<pg8::EpiOut, pg8::StaticOrder>(F.lds, F.tid, g, S, E); }
            } else {
                const LnStage s0{(const bf16_t*)(ws + WS_Y0), ap->in[11], ap->in[12]};
                if (l == 0) { if (MK_MASK & 2) ln_phase(F, ap->in[0], s0, LnStage{nullptr, nullptr, nullptr}, nullptr, true, (const float*)(ws + WS_MOD) + (size_t)BATCH * NMOD, (bf16_t*)(ws + WS_H)); }
                else { const LnStage s1{(const bf16_t*)(ws + WS_Y), ap->in[11] + D, ap->in[12] + D};
                    if (MK_MASK & 2) ln_phase(F, ap->in[0], s0, s1, ap->out, false, nullptr, nullptr); }
            }
        }
        if (ph + 1 < hi || rep_ + 1 < nrep_) {
            if (ph == 0 || !split_ok) xcd_barrier(bar);
            else {
                if (ph == 5 && half_ == 0u && threadIdx.x == 0) {
                    unsigned* hc = (unsigned*)(ws + WS_CTL) + CW_HANDOFF; unsigned sp = 0;
                    while (xb_ld(hc) < gridDim.x / 2) { __builtin_amdgcn_s_sleep(2); if (++sp > (1u << 22)) break; }
                }
                xcd_barrier(barh);
                if (ph == 1 && half_ == 1u && threadIdx.x == 0 && rep_ == 0) xb_add((unsigned*)(ws + WS_CTL) + CW_HANDOFF, 1u);
            }
        }
      }
    }
}

extern "C" void kernel_launch(void* const* d_in, const int* in_sizes, int n_in, void* d_out, int out_size, void* d_ws, size_t ws_size, hipStream_t stream) {
    static int grid = 0;
    if (grid == 0) {
        if (n_in != 13 || out_size != M * D || ws_size < WS_END) { fprintf(stderr, "kernel_launch: unexpected shapes (n_in %d, out %d, ws %zu)\n", n_in, out_size, ws_size); grid = -1; return; }
        int dev = 0, cus = 0, per_cu = 0;
        if (hipGetDevice(&dev) != hipSuccess || hipDeviceGetAttribute(&cus, hipDeviceAttributeMultiprocessorCount, dev) != hipSuccess) { grid = -1; return; }
        if (hipFuncSetAttribute((const void*)mk_fwd, hipFuncAttributeMaxDynamicSharedMemorySize, LDS_BYTES) != hipSuccess) { fprintf(stderr, "kernel_launch: hipFuncSetAttribute failed\n"); grid = -1; return; }
        if (hipOccupancyMaxActiveBlocksPerMultiprocessor(&per_cu, (const void*)mk_fwd, 512, LDS_BYTES) != hipSuccess || per_cu < 1) { fprintf(stderr, "kernel_launch: occupancy query reports %d blocks per CU\n", per_cu); per_cu = 1; }
        (void)hipGetLastError();
        grid = cus;
    }
    if (grid < 0) return;
    (void)hipMemsetAsync((char*)d_ws + WS_CTL, 0, CTL_ZERO_BYTES, stream);
    Args a{};
    for (int i = 0; i < 13; ++i) a.in[i] = (const float*)d_in[i];
    a.out = (float*)d_out; a.ws = (unsigned char*)d_ws;
    if (MK_N_LAUNCHES == 1) { a.ph_lo = 0; a.ph_hi = N_PHASES; hipLaunchKernelGGL(mk_fwd, dim3(grid), dim3(512), LDS_BYTES, stream, a); }
    else { for (int p = 0; p < N_PHASES; ++p) { a.ph_lo = p; a.ph_hi = p + 1; hipLaunchKernelGGL(mk_fwd, dim3(grid), dim3(512), LDS_BYTES, stream, a); } }
}
```
